# Optimizing an MI355X kernel written in HIP

```python
import math
import jax, jax.numpy as jnp
from jax import lax
import numpy as np

D_MODEL = 1024
BATCH = 2
SEQ = 16384
DEPTH = 4

GRID_W = 64
CTX_LEN = 256
NORM_EPS = 1e-6

SSD_HEADS = 6
SSD_HEAD_DIM = 64
SSD_WIDTH = SSD_HEADS * SSD_HEAD_DIM
SSD_GROUPS = 2
SSD_STATE = 128
SSD_CONV = 5
SSD_CHUNK = 128
SSD_XBC = SSD_WIDTH + 2 * SSD_GROUPS * SSD_STATE

MLA_HEADS = 6
MLA_Q_RANK = 192
MLA_KV_RANK = 128
MLA_NOPE = 64
MLA_ROPE = 32
MLA_V = 64
MLA_WIDTH = MLA_HEADS * MLA_V
MLA_Q_BLOCK = 128
MLA_SCALE = (MLA_NOPE + MLA_ROPE) ** -0.5
ROPE_BASE = 10000.0

RWKV_HEADS = 4
RWKV_HEAD_DIM = 64
RWKV_WIDTH = RWKV_HEADS * RWKV_HEAD_DIM
RWKV_W_LORA = 64
RWKV_A_LORA = 64
RWKV_G_LORA = 128
RWKV_SHIFT = 3
RWKV_LN_EPS = 64e-5
RWKV_SPLITS = [RWKV_WIDTH, RWKV_WIDTH, RWKV_WIDTH, 2 * RWKV_W_LORA, 2 * RWKV_A_LORA, RWKV_G_LORA]
RWKV_COLS = sum(RWKV_SPLITS)

MIX_WIDTH = SSD_WIDTH + MLA_WIDTH + RWKV_WIDTH
IN_SPLITS = [SSD_WIDTH, SSD_XBC, 2 * SSD_HEADS, MLA_Q_RANK, MLA_KV_RANK, MLA_ROPE, RWKV_COLS]
IN_WIDTH = sum(IN_SPLITS)

MOE_GROUPS = 8
MOE_PER_GROUP = 8
MOE_EXPERTS = MOE_GROUPS * MOE_PER_GROUP
MOE_TOP_K = 2
MOE_HIDDEN = 512
MOE_BLOCK = 128

kernel_name = 'hybrid_ssd_mla_rwkv7_hmoe_prefix_dit'


def rms_norm(x, w, eps=NORM_EPS):
    xf = x.astype(jnp.float32)
    y = xf * lax.rsqrt(jnp.mean(xf * xf, axis=-1, keepdims=True) + eps)
    return (y * w.astype(jnp.float32)).astype(x.dtype)


def split_cols(u, sizes):
    return jnp.split(u, np.cumsum(sizes)[:-1].tolist(), axis=-1)


def centred_depthwise_conv(x, w):
    width = w.shape[0]
    n = x.shape[1]
    half = width // 2
    xp = jnp.pad(x, ((0, 0), (half, half), (0, 0)))
    out = xp[:, 0:n] * w[0]
    for j in range(1, width):
        out = out + xp[:, j:j + n] * w[j]
    return out


def axial_angles(rows, cols):
    half = MLA_ROPE // 2
    inv = ROPE_BASE ** (-jnp.arange(0, half, 2, dtype=jnp.float32) / half)
    return rows[:, None] * inv, cols[:, None] * inv


def rotate_pairs(x, ang):
    m = x.shape[-1] // 2
    x1, x2 = x[..., :m], x[..., m:]
    cos = jnp.cos(ang).astype(x.dtype)
    sin = jnp.sin(ang).astype(x.dtype)
    return jnp.concatenate([x1 * cos - x2 * sin, x1 * sin + x2 * cos], axis=-1)


def axial_rope(x, ang_r, ang_c):
    half = x.shape[-1] // 2
    return jnp.concatenate([rotate_pairs(x[..., :half], ang_r), rotate_pairs(x[..., half:], ang_c)], axis=-1)


def ssd_scan(xdt, la, bm, cm, h0):
    n, length, heads, p = xdt.shape
    groups, s = bm.shape[2], bm.shape[3]
    r = heads // groups
    q = SSD_CHUNK
    nc = length // q
    dtype = xdt.dtype
    x = xdt.reshape(n, nc, q, groups, r, p)
    a = la.astype(jnp.float32).reshape(n, nc, q, groups, r)
    b = bm.reshape(n, nc, q, groups, s)
    cc = cm.reshape(n, nc, q, groups, s)
    acs = jnp.cumsum(a, axis=2)
    lower = jnp.tril(jnp.ones((q, q), bool))
    seg = acs[:, :, :, None] - acs[:, :, None, :]
    decay = jnp.exp(jnp.where(lower[:, :, None, None], seg, -jnp.inf)).astype(dtype)
    cb = jnp.einsum('nctgs,ncugs->nctug', cc, b)
    y_diag = jnp.einsum('nctugr,ncugrp->nctgrp', cb[..., None] * decay, x)
    to_end = jnp.exp(acs[:, :, -1:] - acs).astype(dtype)
    states = jnp.einsum('ncugs,ncugrp->ncgrps', b, x * to_end[..., None])
    chunk_decay = jnp.exp(acs[:, :, -1]).astype(dtype)

    def step(h, inp):
        st, dc = inp
        return h * dc[..., None, None] + st, h

    h_last, h_in = lax.scan(step, h0.reshape(n, groups, r, p, s),
                            (jnp.moveaxis(states, 1, 0), jnp.moveaxis(chunk_decay, 1, 0)))
    h_in = jnp.moveaxis(h_in, 0, 1)
    y_off = jnp.einsum('nctgs,ncgrps->nctgrp', cc, h_in) * jnp.exp(acs).astype(dtype)[..., None]
    return (y_diag + y_off).reshape(n, length, heads, p), h_last.reshape(n, heads, p, s)


def ssd_stream(z, xbc, dt_raw, h0, lp):
    bsz, n, _ = xbc.shape
    xbc = jax.nn.silu(centred_depthwise_conv(xbc, lp['ssd_conv_w']) + lp['ssd_conv_b'])
    xs, bm, cm = split_cols(xbc, [SSD_WIDTH, SSD_GROUPS * SSD_STATE, SSD_GROUPS * SSD_STATE])
    xs = xs.reshape(bsz, n, SSD_HEADS, SSD_HEAD_DIM)
    bm = bm.reshape(bsz, n, SSD_GROUPS, SSD_STATE)
    cm = cm.reshape(bsz, n, SSD_GROUPS, SSD_STATE)
    dt = jax.nn.softplus(dt_raw.reshape(bsz, n, 2, SSD_HEADS).astype(jnp.float32)
                         + lp['ssd_dt_bias'].astype(jnp.float32))
    a = -jnp.exp(lp['ssd_a_log'].astype(jnp.float32))
    dt2 = jnp.concatenate([dt[:, :, 0], jnp.flip(dt[:, :, 1], 1)], axis=0)
    la = dt2 * jnp.repeat(a, bsz, axis=0)[:, None, :]

    def both(t):
        return jnp.concatenate([t, jnp.flip(t, 1)], axis=0)

    xdt = both(xs) * dt2[..., None].astype(xs.dtype)
    y2, h_last = ssd_scan(xdt, la, both(bm), both(cm), h0)
    y = y2[:bsz] + jnp.flip(y2[bsz:], 1) + lp['ssd_d'][:, None] * xs
    out = rms_norm(y.reshape(bsz, n, SSD_WIDTH) * jax.nn.silu(z), lp['ssd_norm_w'])
    return out, h_last


def mla_project(qd, kvd, lp):
    bsz, n, _ = qd.shape
    q = (rms_norm(qd, lp['mla_q_norm_w']) @ lp['mla_w_uq']).reshape(bsz, n, MLA_HEADS, MLA_NOPE + MLA_ROPE)
    kv = (rms_norm(kvd, lp['mla_kv_norm_w']) @ lp['mla_w_ukv']).reshape(bsz, n, MLA_HEADS, MLA_NOPE + MLA_V)
    return q[..., :MLA_NOPE], q[..., MLA_NOPE:], kv[..., :MLA_NOPE], kv[..., MLA_NOPE:]


def mla_attend(qn, qr, kn, kr, v):
    s = (jnp.einsum('bqhd,bkhd->bhqk', qn, kn, preferred_element_type=jnp.float32)
         + jnp.einsum('bqhr,bkr->bhqk', qr, kr, preferred_element_type=jnp.float32)) * MLA_SCALE
    p = jax.nn.softmax(s, axis=-1).astype(v.dtype)
    return jnp.einsum('bhqk,bkhd->bqhd', p, v)


def head_l2norm(t):
    shp = t.shape
    tf = t.astype(jnp.float32).reshape(*shp[:-1], RWKV_HEADS, RWKV_HEAD_DIM)
    tf = tf / jnp.maximum(jnp.sqrt(jnp.sum(tf * tf, axis=-1, keepdims=True)), 1e-12)
    return tf.reshape(shp).astype(t.dtype)


def rwkv_scan(s0, r, w, k, v, a, b):
    def step(s, inp):
        r_t, w_t, k_t, v_t, a_t, b_t = inp
        sa = jnp.sum(s * a_t[..., None, :], axis=-1)
        s = s * w_t[..., None, :] + sa[..., None] * b_t[..., None, :] + v_t[..., None] * k_t[..., None, :]
        return s, jnp.sum(s * r_t[..., None, :], axis=-1)
    return lax.scan(step, s0, (r, w, k, v, a, b))


def rwkv_stream(u, s0, lp):
    bsz, n, _ = u.shape
    u = centred_depthwise_conv(u, lp['rwkv_shift_w'])
    r, k, v, wd, ad, gd = split_cols(u, RWKV_SPLITS)
    wd = wd.reshape(bsz, n, 2, RWKV_W_LORA)
    ad = ad.reshape(bsz, n, 2, RWKV_A_LORA)
    wl = -jax.nn.softplus(-(lp['rwkv_w0'] + jnp.einsum('bldr,drc->bldc', jnp.tanh(wd), lp['rwkv_w2']))) - 0.5
    decay = jnp.exp(-jnp.exp(wl.astype(jnp.float32)))
    a = jax.nn.sigmoid(lp['rwkv_a0'] + jnp.einsum('bldr,drc->bldc', ad, lp['rwkv_a2']))
    g = jax.nn.sigmoid(gd) @ lp['rwkv_g2']
    kk = head_l2norm(k * lp['rwkv_k_k'])
    kd = k[:, :, None] * (1 + (a - 1) * lp['rwkv_k_a'])
    bd = kk[:, :, None] * a

    def stack(t_f, t_b):
        s = jnp.stack([t_f, jnp.flip(t_b, 1)], 0).reshape(2, bsz, n, RWKV_HEADS, RWKV_HEAD_DIM)
        return jnp.transpose(s, (2, 0, 1, 3, 4)).astype(s0.dtype)

    s_last, y = rwkv_scan(s0, stack(r, r), stack(decay[:, :, 0], decay[:, :, 1]),
                          stack(kd[:, :, 0], kd[:, :, 1]), stack(v, v), stack(-kk, -kk),
                          stack(bd[:, :, 0], bd[:, :, 1]))
    y = jnp.transpose(y[:, 0] + jnp.flip(y[:, 1], 0), (1, 0, 2, 3)).astype(jnp.float32)
    mu = jnp.mean(y, axis=-1, keepdims=True)
    var = jnp.mean(jnp.square(y - mu), axis=-1, keepdims=True)
    yn = ((y - mu) * lax.rsqrt(var + RWKV_LN_EPS)).reshape(bsz, n, RWKV_WIDTH)
    yn = (yn * lp['rwkv_ln_w'].astype(jnp.float32) + lp['rwkv_ln_b'].astype(jnp.float32)).astype(u.dtype)
    rk = lp['rwkv_r_k'].reshape(RWKV_WIDTH)
    bonus = jnp.sum((r[:, :, None] * kd * rk).reshape(bsz, n, 2, RWKV_HEADS, RWKV_HEAD_DIM), axis=(2, 4))
    bonus = (bonus[..., None] * v.reshape(bsz, n, RWKV_HEADS, RWKV_HEAD_DIM)).reshape(bsz, n, RWKV_WIDTH)
    return (yn + bonus) * g, s_last


def token_mixers(h, hc, lp, ang_r, ang_c, with_ctx_out):
    bsz, n, _ = h.shape
    n_ctx = hc.shape[1]
    z, xbc, dtr, qd, kvd, kr, rw = split_cols(h @ lp['w_in'], IN_SPLITS)
    zc, xbcc, dtrc, qdc, kvdc, krc, rwc = split_cols(hc @ lp['w_in'], IN_SPLITS)
    h0 = jnp.zeros((2 * bsz, SSD_HEADS, SSD_HEAD_DIM, SSD_STATE), h.dtype)
    ssd_c, h_ctx = ssd_stream(zc, xbcc, dtrc, h0, lp)
    ssd_l, _ = ssd_stream(z, xbc, dtr, h_ctx, lp)
    qn, qr, kn, v = mla_project(qd, kvd, lp)
    qr = axial_rope(qr, ang_r[:, None], ang_c[:, None])
    kr = axial_rope(kr, ang_r, ang_c)
    qnc, qrc, knc, vc = mla_project(qdc, kvdc, lp)
    kn_all = jnp.concatenate([knc, kn], axis=1)
    kr_all = jnp.concatenate([krc, kr], axis=1)
    v_all = jnp.concatenate([vc, v], axis=1)
    nb = n // MLA_Q_BLOCK

    def to_blocks(t):
        return jnp.moveaxis(t.reshape(bsz, nb, MLA_Q_BLOCK, *t.shape[2:]), 1, 0)

    o = lax.map(lambda qb: mla_attend(qb[0], qb[1], kn_all, kr_all, v_all), (to_blocks(qn), to_blocks(qr)))
    mla_l = jnp.moveaxis(o, 0, 1).reshape(bsz, n, MLA_WIDTH)
    s0 = jnp.zeros((2, bsz, RWKV_HEADS, RWKV_HEAD_DIM, RWKV_HEAD_DIM), h.dtype)
    rw_c, s_ctx = rwkv_stream(rwc, s0, lp)
    rw_l, _ = rwkv_stream(rw, s_ctx, lp)
    y = jnp.concatenate([ssd_l, mla_l, rw_l], axis=-1) @ lp['w_out']
    if not with_ctx_out:
        return y, None
    mla_c = mla_attend(qnc, qrc, knc, krc, vc).reshape(bsz, n_ctx, MLA_WIDTH)
    yc = jnp.concatenate([ssd_c, mla_c, rw_c], axis=-1) @ lp['w_out']
    return y, yc


def hier_moe(h, lp):
    t, d = h.shape
    gl = (h @ lp['moe_w_rg'] + lp['moe_b_rg']).astype(jnp.float32)
    pg = jax.nn.softmax(gl, axis=-1)
    grp = jnp.argmax(gl, axis=-1)
    el = (h @ lp['moe_w_re'] + lp['moe_b_re']).astype(jnp.float32).reshape(t, MOE_GROUPS, MOE_PER_GROUP)
    el = jnp.take_along_axis(el, grp[:, None, None], axis=1)[:, 0]
    top_p, top_i = lax.top_k(jax.nn.softmax(el, axis=-1), MOE_TOP_K)
    gate = jnp.take_along_axis(pg, grp[:, None], axis=1) * top_p / jnp.sum(top_p, axis=-1, keepdims=True)
    eid = (grp[:, None] * MOE_PER_GROUP + top_i).astype(jnp.int32)
    m = t * MOE_TOP_K
    flat_e = eid.reshape(m)
    flat_tok = jnp.repeat(jnp.arange(t, dtype=jnp.int32), MOE_TOP_K)
    order = jnp.argsort(flat_e)
    e_sorted = flat_e[order]
    tok_sorted = flat_tok[order]
    counts = jnp.bincount(flat_e, length=MOE_EXPERTS)
    padded = (counts + MOE_BLOCK - 1) // MOE_BLOCK * MOE_BLOCK
    start = jnp.cumsum(counts) - counts
    pend = jnp.cumsum(padded)
    pstart = pend - padded
    dest = pstart[e_sorted] + jnp.arange(m, dtype=jnp.int32) - start[e_sorted]
    n_blocks = (m + MOE_EXPERTS * (MOE_BLOCK - 1) + MOE_BLOCK - 1) // MOE_BLOCK
    row_tok = jnp.full((n_blocks * MOE_BLOCK,), t, jnp.int32).at[dest].set(tok_sorted)
    h_pad = jnp.concatenate([h, jnp.zeros((1, d), h.dtype)], axis=0)
    xb = h_pad[row_tok].reshape(n_blocks, MOE_BLOCK, d)
    block_e = jnp.minimum(jnp.searchsorted(pend, jnp.arange(n_blocks, dtype=jnp.int32) * MOE_BLOCK, side='right'),
                          MOE_EXPERTS - 1)
    w1, w3, w2 = lp['moe_w1'], lp['moe_w3'], lp['moe_w2']

    def expert_block(args):
        xblk, e = args
        return (jax.nn.silu(xblk @ w1[e]) * (xblk @ w3[e])) @ w2[e]

    yb = lax.map(expert_block, (xb, block_e)).reshape(n_blocks * MOE_BLOCK, d)
    contrib = yb[dest] * gate.reshape(m)[order][:, None].astype(h.dtype)
    return jax.ops.segment_sum(contrib, tok_sorted, num_segments=t)


def hybrid_layer(x, xc, c, c_ctx, lp, ang_r, ang_c, last):
    bsz, n, d = x.shape
    mod = jax.nn.silu(c) @ lp['mod_w'] + lp['mod_b']
    mod_c = jax.nn.silu(c_ctx) @ lp['mod_w'] + lp['mod_b']
    sh1, sc1, g1, sh2, sc2, g2 = [mm[:, None] for mm in jnp.split(mod, 6, axis=-1)]
    csh1, csc1, cg1, csh2, csc2, cg2 = jnp.split(mod_c, 6, axis=-1)
    h = rms_norm(x, lp['norm1_w']) * (1 + sc1) + sh1
    hc = rms_norm(xc, lp['norm1_w']) * (1 + csc1) + csh1
    y, yc = token_mixers(h, hc, lp, ang_r, ang_c, not last)
    x = x + g1 * y
    h2 = (rms_norm(x, lp['norm2_w']) * (1 + sc2) + sh2).reshape(bsz * n, d)
    if last:
        return x + g2 * hier_moe(h2, lp).reshape(bsz, n, d), xc
    xc = xc + cg1 * yc
    hc2 = (rms_norm(xc, lp['norm2_w']) * (1 + csc2) + csh2).reshape(-1, d)
    f = hier_moe(jnp.concatenate([h2, hc2], axis=0), lp)
    x = x + g2 * f[:bsz * n].reshape(bsz, n, d)
    xc = xc + cg2 * f[bsz * n:].reshape(xc.shape)
    return x, xc


def setup_inputs(seed: int = 0) -> dict:
    keys = list(jax.random.split(jax.random.key(seed), 48))

    def nrm(shape, scale=1.0):
        return scale * jax.random.normal(keys.pop(), shape, jnp.float32)

    def unif(shape, lo, hi):
        return jax.random.uniform(keys.pop(), shape, jnp.float32, lo, hi)

    nl, d = DEPTH, D_MODEL
    dt0 = jnp.exp(unif((nl, 2, SSD_HEADS), math.log(1e-3), math.log(1e-1)))
    shift_base = jnp.asarray([0.2, 0.6, 0.2], jnp.float32)[None, :, None]
    return {
        'x': nrm((BATCH, SEQ, d)),
        'c': nrm((BATCH, d)),
        'ctx': nrm((BATCH, CTX_LEN, d)),
        'c_ctx': nrm((d,)),
        'mod_w': nrm((nl, d, 6 * d), 0.5 * d ** -0.5),
        'mod_b': nrm((nl, 6 * d), 0.02),
        'norm1_w': 1.0 + nrm((nl, d), 0.02),
        'norm2_w': 1.0 + nrm((nl, d), 0.02),
        'w_in': nrm((nl, d, IN_WIDTH), d ** -0.5),
        'ssd_conv_w': nrm((nl, SSD_CONV, SSD_XBC), SSD_CONV ** -0.5),
        'ssd_conv_b': nrm((nl, SSD_XBC), 0.02),
        'ssd_dt_bias': dt0 + jnp.log(-jnp.expm1(-dt0)),
        'ssd_a_log': jnp.log(unif((nl, 2, SSD_HEADS), 1.0, 16.0)),
        'ssd_d': 1.0 + nrm((nl, SSD_HEADS), 0.1),
        'ssd_norm_w': 1.0 + nrm((nl, SSD_WIDTH), 0.02),
        'mla_q_norm_w': 1.0 + nrm((nl, MLA_Q_RANK), 0.02),
        'mla_w_uq': nrm((nl, MLA_Q_RANK, MLA_HEADS * (MLA_NOPE + MLA_ROPE)), MLA_Q_RANK ** -0.5),
        'mla_kv_norm_w': 1.0 + nrm((nl, MLA_KV_RANK), 0.02),
        'mla_w_ukv': nrm((nl, MLA_KV_RANK, MLA_HEADS * (MLA_NOPE + MLA_V)), MLA_KV_RANK ** -0.5),
        'rwkv_shift_w': shift_base + nrm((nl, RWKV_SHIFT, RWKV_COLS), 0.05),
        'rwkv_w0': unif((nl, 2, RWKV_WIDTH), -6.0, 1.0),
        'rwkv_w2': nrm((nl, 2, RWKV_W_LORA, RWKV_WIDTH), 0.1 * RWKV_W_LORA ** -0.5),
        'rwkv_a0': nrm((nl, 2, RWKV_WIDTH), 0.1),
        'rwkv_a2': nrm((nl, 2, RWKV_A_LORA, RWKV_WIDTH), 0.1 * RWKV_A_LORA ** -0.5),
        'rwkv_g2': nrm((nl, RWKV_G_LORA, RWKV_WIDTH), RWKV_G_LORA ** -0.5),
        'rwkv_k_k': 0.85 + nrm((nl, RWKV_WIDTH), 0.02),
        'rwkv_k_a': 1.0 + nrm((nl, RWKV_WIDTH), 0.02),
        'rwkv_r_k': nrm((nl, RWKV_HEADS, RWKV_HEAD_DIM), 0.1),
        'rwkv_ln_w': 1.0 + nrm((nl, RWKV_WIDTH), 0.02),
        'rwkv_ln_b': nrm((nl, RWKV_WIDTH), 0.02),
        'w_out': nrm((nl, MIX_WIDTH, d), MIX_WIDTH ** -0.5),
        'moe_w_rg': nrm((nl, d, MOE_GROUPS), d ** -0.5),
        'moe_b_rg': nrm((nl, MOE_GROUPS), 0.01),
        'moe_w_re': nrm((nl, d, MOE_EXPERTS), d ** -0.5),
        'moe_b_re': nrm((nl, MOE_EXPERTS), 0.01),
        'moe_w1': nrm((nl, MOE_EXPERTS, d, MOE_HIDDEN), d ** -0.5),
        'moe_w3': nrm((nl, MOE_EXPERTS, d, MOE_HIDDEN), d ** -0.5),
        'moe_w2': nrm((nl, MOE_EXPERTS, MOE_HIDDEN, d), MOE_HIDDEN ** -0.5),
        'final_norm_w': 1.0 + nrm((d,), 0.02),
    }


def reference(x, c, ctx, c_ctx, mod_w, mod_b, norm1_w, norm2_w, w_in, ssd_conv_w, ssd_conv_b, ssd_dt_bias,
              ssd_a_log, ssd_d, ssd_norm_w, mla_q_norm_w, mla_w_uq, mla_kv_norm_w, mla_w_ukv, rwkv_shift_w,
              rwkv_w0, rwkv_w2, rwkv_a0, rwkv_a2, rwkv_g2, rwkv_k_k, rwkv_k_a, rwkv_r_k, rwkv_ln_w, rwkv_ln_b,
              w_out, moe_w_rg, moe_b_rg, moe_w_re, moe_b_re, moe_w1, moe_w3, moe_w2, final_norm_w):
    n = x.shape[1]
    n_rows = n // GRID_W
    rows = jnp.repeat(jnp.arange(n_rows, dtype=jnp.float32), GRID_W)
    cols = jnp.tile(jnp.arange(GRID_W, dtype=jnp.float32), n_rows)
    ang_r, ang_c = axial_angles(rows, cols)
    xc = ctx
    for i in range(DEPTH):
        lp = {
            'mod_w': mod_w[i], 'mod_b': mod_b[i], 'norm1_w': norm1_w[i], 'norm2_w': norm2_w[i],
            'w_in': w_in[i], 'ssd_conv_w': ssd_conv_w[i], 'ssd_conv_b': ssd_conv_b[i],
            'ssd_dt_bias': ssd_dt_bias[i], 'ssd_a_log': ssd_a_log[i], 'ssd_d': ssd_d[i],
            'ssd_norm_w': ssd_norm_w[i], 'mla_q_norm_w': mla_q_norm_w[i], 'mla_w_uq': mla_w_uq[i],
            'mla_kv_norm_w': mla_kv_norm_w[i], 'mla_w_ukv': mla_w_ukv[i], 'rwkv_shift_w': rwkv_shift_w[i],
            'rwkv_w0': rwkv_w0[i], 'rwkv_w2': rwkv_w2[i], 'rwkv_a0': rwkv_a0[i], 'rwkv_a2': rwkv_a2[i],
            'rwkv_g2': rwkv_g2[i], 'rwkv_k_k': rwkv_k_k[i], 'rwkv_k_a': rwkv_k_a[i], 'rwkv_r_k': rwkv_r_k[i],
            'rwkv_ln_w': rwkv_ln_w[i], 'rwkv_ln_b': rwkv_ln_b[i], 'w_out': w_out[i],
            'moe_w_rg': moe_w_rg[i], 'moe_b_rg': moe_b_rg[i], 'moe_w_re': moe_w_re[i], 'moe_b_re': moe_b_re[i],
            'moe_w1': moe_w1[i], 'moe_w3': moe_w3[i], 'moe_w2': moe_w2[i],
        }
        x, xc = hybrid_layer(x, xc, c, c_ctx, lp, ang_r, ang_c, i == DEPTH - 1)
    return rms_norm(x, final_norm_w)
```

```cpp
#include <hip/hip_runtime.h>
#include <cstdio>
#include <cstdint>

#ifndef RW_UT
#define RW_UT 1
#endif
#ifndef MK_MULTI
#define MK_MULTI 0
#endif

typedef unsigned short bf16_t;
typedef short bf16x8 __attribute__((ext_vector_type(8)));
typedef short s16x4 __attribute__((ext_vector_type(4)));
typedef float f32x4 __attribute__((ext_vector_type(4)));
typedef float f32x16 __attribute__((ext_vector_type(16)));
typedef unsigned u32x4 __attribute__((ext_vector_type(4)));
typedef unsigned u32x2 __attribute__((ext_vector_type(2)));

constexpr int DM = 1024, NBATCH = 2, SEQ = 16384, DEPTH = 4, CTXL = 256;
constexpr int NLAT = NBATCH * SEQ;
constexpr int NCTX = NBATCH * CTXL;
constexpr int NTOK = NLAT + NCTX;
constexpr int KEYS = CTXL + SEQ;
constexpr int IN_W = 2796;
constexpr int UW = 2816;
constexpr int U_Z = 0, U_XBC = 384, U_QD = 1280, U_KVD = 1472, U_KR = 1600, U_DT = 1632, U_RW = 1664;
constexpr int UPW = 1536;
constexpr int UPK = 384;
constexpr int NTHREADS = 512;
constexpr int LDS_BYTES = 147456;
constexpr int LDS_MISC = LDS_BYTES - 256;
constexpr float NORM_EPS = 1e-6f;

constexpr size_t al256(size_t x) { return (x + 255) / 256 * 256; }
constexpr size_t WS_BAR   = 0;
constexpr size_t WS_MISC  = 16384;
constexpr size_t WS_MODS  = 32768;
constexpr size_t WS_WRT   = WS_MODS + al256((size_t)4 * 3 * 6144 * 4);
constexpr size_t WS_WRH   = WS_WRT + al256((size_t)4 * 72 * 1024 * 4);
constexpr size_t WS_WIN   = WS_WRH + (size_t)4 * 2 * 80 * 1024 * 2;
constexpr size_t WS_WOUT  = WS_WIN + (size_t)4 * UW * 1024 * 2;
constexpr size_t WS_WUP   = WS_WOUT + (size_t)4 * 1024 * 1024 * 2;
constexpr size_t WS_WLORA = WS_WUP + (size_t)4 * UPW * UPK * 2;
constexpr size_t WS_W13   = WS_WLORA + (size_t)4 * 98304 * 2;
constexpr size_t WS_W2    = WS_W13 + (size_t)64 * 1024 * 1024 * 2;
constexpr size_t WS_X     = WS_W2 + (size_t)64 * 1024 * 512 * 2;
constexpr size_t WS_H     = WS_X + (size_t)NTOK * 1024 * 4;
constexpr size_t WS_U     = WS_H + (size_t)NTOK * 1024 * 2;
constexpr size_t WS_MIX   = WS_U + (size_t)NTOK * UW * 2;
constexpr size_t WS_R0    = WS_MIX + (size_t)NTOK * 1024 * 2;
constexpr size_t WS_QKVUP = WS_R0;
constexpr size_t WS_Q     = WS_QKVUP + (size_t)NTOK * UPW * 2;
constexpr size_t WS_K     = WS_Q + (size_t)NTOK * 576 * 2;
constexpr size_t WS_V     = WS_K + (size_t)2 * 6 * KEYS * 96 * 2;
constexpr size_t WS_SST   = WS_V + (size_t)2 * 6 * KEYS * 64 * 2;
constexpr size_t WS_SDEC  = WS_SST + (size_t)2 * 2 * 130 * 6 * 128 * 64 * 4;
constexpr size_t WS_YS    = WS_SDEC + al256((size_t)2 * 2 * 130 * 8 * 4);
constexpr size_t WS_RWP   = WS_YS + (size_t)2 * NTOK * 384 * 4;
constexpr size_t WS_RPQ   = WS_RWP + (size_t)NTOK * 11 * 256 * 4;
constexpr size_t WS_RS0   = WS_RPQ + (size_t)2 * 2 * 260 * 4 * 2 * 4096 * 4;
constexpr size_t WS_YR    = WS_RS0 + (size_t)2 * 2 * 260 * 4 * 4096 * 4;
constexpr size_t WS_RY    = WS_YR + (size_t)2 * NTOK * 256 * 4;
constexpr size_t WS_SSTB  = WS_RY + (size_t)2 * 2 * 260 * 4 * 2 * 4096 * 4;
constexpr size_t WS_MIXEND= WS_SSTB + (size_t)2 * 2 * 130 * 6 * 64 * 128 * 2;
constexpr int MOE_MAXROWS = 83200;
constexpr size_t WS_EID   = WS_R0;
constexpr size_t WS_POS   = WS_EID + al256((size_t)NTOK * 2 * 4);
constexpr size_t WS_GATE  = WS_POS + al256((size_t)NTOK * 2 * 4);
constexpr size_t WS_SLOT  = WS_GATE + al256((size_t)NTOK * 2 * 4);
constexpr size_t WS_HG    = WS_SLOT + al256((size_t)NTOK * 2 * 4);
constexpr size_t WS_HMID  = WS_HG + (size_t)MOE_MAXROWS * 1024 * 2;
constexpr size_t WS_YEXP  = WS_HMID + (size_t)MOE_MAXROWS * 512 * 2;
constexpr size_t WS_MOEEND= WS_YEXP + (size_t)MOE_MAXROWS * 1024 * 2;
constexpr size_t WS_END   = WS_MIXEND > WS_MOEEND ? WS_MIXEND : WS_MOEEND;

struct Params {
    const float *x, *c, *ctx, *c_ctx, *mod_w, *mod_b, *norm1_w, *norm2_w, *w_in, *ssd_conv_w, *ssd_conv_b, *ssd_dt_bias,
        *ssd_a_log, *ssd_d, *ssd_norm_w, *mla_q_norm_w, *mla_w_uq, *mla_kv_norm_w, *mla_w_ukv, *rwkv_shift_w,
        *rwkv_w0, *rwkv_w2, *rwkv_a0, *rwkv_a2, *rwkv_g2, *rwkv_k_k, *rwkv_k_a, *rwkv_r_k, *rwkv_ln_w, *rwkv_ln_b,
        *w_out, *moe_w_rg, *moe_b_rg, *moe_w_re, *moe_b_re, *moe_w1, *moe_w3, *moe_w2, *final_norm_w;
    float* out;
    unsigned char* ws;
    long long ph_lo, ph_hi;
};

#define LAS __attribute__((address_space(3)))
extern __shared__ __attribute__((aligned(16))) unsigned char smem[];

__device__ __forceinline__ float bf2f(bf16_t v) { return __uint_as_float(((unsigned)v) << 16); }
__device__ __forceinline__ bf16_t f2bf(float f) { unsigned u = __float_as_uint(f); u += 0x7fffu + ((u >> 16) & 1u); return (bf16_t)(u >> 16); }
__device__ __forceinline__ unsigned cvtpk_bf16(float lo, float hi) { unsigned r; asm volatile("v_cvt_pk_bf16_f32 %0, %1, %2" : "=v"(r) : "v"(lo), "v"(hi)); return r; }
__device__ __forceinline__ f32x4 ld4bf(const bf16_t* p) { const u32x2 u = *(const u32x2*)p; f32x4 v = {__uint_as_float(u[0] << 16), __uint_as_float(u[0] & 0xffff0000u), __uint_as_float(u[1] << 16), __uint_as_float(u[1] & 0xffff0000u)}; return v; }
__device__ __forceinline__ void st4bf(bf16_t* p, const f32x4& v) { u32x2 o = {cvtpk_bf16(v[0], v[1]), cvtpk_bf16(v[2], v[3])}; *(u32x2*)p = o; }
__device__ __forceinline__ unsigned pack2bf(float lo, float hi) { return (unsigned)f2bf(lo) | ((unsigned)f2bf(hi) << 16); }
__device__ __forceinline__ float dpp_add(float v, const int ctrl_sel) {
    int r;
    if (ctrl_sel == 0) r = __builtin_amdgcn_update_dpp(0, __float_as_int(v), 0xB1, 0xF, 0xF, true);
    else if (ctrl_sel == 1) r = __builtin_amdgcn_update_dpp(0, __float_as_int(v), 0x4E, 0xF, 0xF, true);
    else if (ctrl_sel == 2) r = __builtin_amdgcn_update_dpp(0, __float_as_int(v), 0x141, 0xF, 0xF, true);
    else r = __builtin_amdgcn_update_dpp(0, __float_as_int(v), 0x140, 0xF, 0xF, true);
    return v + __int_as_float(r);
}
__device__ __forceinline__ float row16_sum(float v) { v = dpp_add(v, 0); v = dpp_add(v, 1); v = dpp_add(v, 2); v = dpp_add(v, 3); return v; }
__device__ __forceinline__ float wave_sum(float v) {
    v = row16_sum(v);
    v += __int_as_float(__builtin_amdgcn_ds_swizzle(__float_as_int(v), 0x401F));
    { auto rr = __builtin_amdgcn_permlane32_swap(__float_as_uint(v), __float_as_uint(v), false, false);
      v = __uint_as_float(rr[0]) + __uint_as_float(rr[1]); }
    return v;
}
__device__ __forceinline__ float wave_scan_incl(float v) {
    v += __int_as_float(__builtin_amdgcn_update_dpp(0, __float_as_int(v), 0x111, 0xF, 0xF, true));
    v += __int_as_float(__builtin_amdgcn_update_dpp(0, __float_as_int(v), 0x112, 0xF, 0xF, true));
    v += __int_as_float(__builtin_amdgcn_update_dpp(0, __float_as_int(v), 0x114, 0xF, 0xF, true));
    v += __int_as_float(__builtin_amdgcn_update_dpp(0, __float_as_int(v), 0x118, 0xF, 0xF, true));
    v += __int_as_float(__builtin_amdgcn_update_dpp(0, __float_as_int(v), 0x142, 0xA, 0xF, false));
    v += __int_as_float(__builtin_amdgcn_update_dpp(0, __float_as_int(v), 0x143, 0xC, 0xF, false));
    return v;
}
__device__ __forceinline__ float silu_f(float x) { return x * __builtin_amdgcn_rcpf(1.f + __expf(-x)); }
__device__ __forceinline__ float sigmoid_f(float x) { return __builtin_amdgcn_rcpf(1.f + __expf(-x)); }
__device__ __forceinline__ float softplus_f(float x) { return x > 15.f ? x : __logf(1.f + __expf(x)); }
__device__ __forceinline__ float tanh_f(float x) { const float e = __expf(-2.f * fabsf(x)); const float t = (1.f - e) * __builtin_amdgcn_rcpf(1.f + e); return x < 0.f ? -t : t; }
__device__ __forceinline__ int tidx() { int t = threadIdx.x; asm volatile("" : "+v"(t)); return t; }
__device__ __forceinline__ int bidx() { int b = blockIdx.x; asm volatile("" : "+s"(b)); return b; }
__device__ __forceinline__ int wave_id() { return __builtin_amdgcn_readfirstlane(tidx() >> 6); }

__device__ __forceinline__ int row_set(int row) { return row < NLAT ? (row >> 14) : 2; }
__device__ __forceinline__ void row_seq(int row, int& base, int& pos, int& len) {
    if (row < NLAT) { base = row & ~16383; pos = row & 16383; len = SEQ; }
    else { const int r = row - NLAT; base = NLAT + (r & ~255); pos = r & 255; len = CTXL; }
}

#define XB_TMO      128
#define XB_XCNT(j)  (256  + 64 * (j))
#define XB_XSUB(j)  (1280 + 64 * (j))
#define XB_XGEN(j)  (2304 + 64 * (j))
#define XB_TOP      3328
#define XB_TOPGEN   3392
#define XCD_BAR_WORDS 3456
#define XB_SPIN_CAP (1u << 18)

__device__ __forceinline__ unsigned xb_ld(unsigned* p)              { return __hip_atomic_load(p, __ATOMIC_RELAXED, __HIP_MEMORY_SCOPE_AGENT); }
__device__ __forceinline__ unsigned xb_add(unsigned* p, unsigned v) { return __hip_atomic_fetch_add(p, v, __ATOMIC_RELAXED, __HIP_MEMORY_SCOPE_AGENT); }
__device__ __forceinline__ unsigned xb_xcc_id() { return (unsigned)__builtin_amdgcn_s_getreg((3 << 11) | 20) & 0xFu; }
#define XB_SPIN(cond, bar) do { unsigned _sp = 0; while (cond) { __builtin_amdgcn_s_sleep(1); \
    if ((++_sp & 255u) == 0u) { if (xb_ld(&(bar)[XB_TMO])) break; if (_sp > XB_SPIN_CAP) { atomicAdd(&(bar)[XB_TMO], 1u); break; } } } } while (0)

struct XcdBarrier { unsigned* bar; unsigned x; volatile LAS unsigned* st; };

__device__ __forceinline__ XcdBarrier xcd_barrier_post(unsigned* bar, volatile LAS unsigned* st) {
    XcdBarrier b; b.bar = bar; b.x = xb_xcc_id(); b.st = st;
    if (threadIdx.x == 0) (void)xb_add(&bar[XB_XCNT(b.x)], 1u);
    return b;
}
__device__ __forceinline__ void xcd_barrier_complete(unsigned* bar, unsigned x, unsigned& nloc, unsigned& nx) {
    const unsigned G = gridDim.x * gridDim.y * gridDim.z;
    unsigned sum, cnt, mine, sp = 0u;
    for (;;) {
        sum = 0u; cnt = 0u; mine = 0u;
#pragma unroll
        for (unsigned j = 0; j < 16; ++j) { const unsigned c = xb_ld(&bar[XB_XCNT(j)]); sum += c; cnt += (c > 0u) ? 1u : 0u; mine = (j == x) ? c : mine; }
        if (sum == G) break;
        __builtin_amdgcn_s_sleep(1);
        if ((++sp & 255u) == 0u) { if (xb_ld(&bar[XB_TMO])) break; if (sp > XB_SPIN_CAP) { atomicAdd(&bar[XB_TMO], 1u); break; } }
    }
    nloc = mine > 0u ? mine : 1u; nx = cnt > 0u ? cnt : 1u;
}
__device__ __forceinline__ void xcd_barrier(const XcdBarrier& b) {
    asm volatile("s_waitcnt vmcnt(0)" ::: "memory");
    __syncthreads();
    if (threadIdx.x == 0) {
        unsigned* bar = b.bar; unsigned bx = b.x;
        asm volatile("" : "+s"(bar), "+s"(bx));
        __builtin_amdgcn_s_waitcnt(0);
        unsigned nloc = b.st[0], nx = b.st[1];
        if (nloc == 0u) { xcd_barrier_complete(bar, bx, nloc, nx); b.st[0] = nloc; b.st[1] = nx; }
        const unsigned old = xb_add(&bar[XB_XSUB(bx)], 1u);
        const unsigned gen = old / nloc;
        if (old + 1u == (gen + 1u) * nloc) {
            __builtin_amdgcn_fence(__ATOMIC_RELEASE, "agent");
            asm volatile("s_waitcnt vmcnt(0)" ::: "memory");
            const unsigned og = xb_add(&bar[XB_TOP], 1u);
            const unsigned tg = og / nx;
            if (og + 1u == (tg + 1u) * nx) xb_add(&bar[XB_TOPGEN], 1u);
            else XB_SPIN(xb_ld(&bar[XB_TOPGEN]) == tg, bar);
            __builtin_amdgcn_fence(__ATOMIC_ACQUIRE, "agent");
            xb_add(&bar[XB_XGEN(bx)], 1u);
            asm volatile("s_waitcnt vmcnt(0)" ::: "memory");
        } else {
            XB_SPIN(xb_ld(&bar[XB_XGEN(bx)]) == gen, bar);
            __builtin_amdgcn_fence(__ATOMIC_ACQUIRE, "agent");
            asm volatile("s_waitcnt vmcnt(0)" ::: "memory");
        }
    }
    __syncthreads();
}

#ifdef PROBE_KIND
__device__ __forceinline__ int qrep(int kind) { int r = (kind == PROBE_KIND) ? 2 : 1; asm volatile("" : "+s"(r)); return r; }
#define QREP(kind) for (int rep_ = 0, nrep_ = qrep(kind); rep_ < nrep_; ++rep_)
#define QSYNC __syncthreads();
#else
#define QREP(kind)
#define QSYNC
#endif
constexpr int G_BK = 64, G_HALF = 128, G_HT = G_HALF * G_BK;

__device__ __forceinline__ int lds_byte(int r, int c) { const int st = (r >> 4) * 2 + (c >> 5), rr = r & 15, cc = c & 31, ob = rr * 64 + cc * 2; return st * 1024 + (ob ^ (((ob >> 9) & 1) << 5)); }
__device__ __forceinline__ void stage_rc(int b, int& R, int& C) { const int st = b / 1024, sb = b % 1024, swz = sb ^ (((sb >> 9) & 1) << 5); R = (st >> 1) * 16 + swz / 64; C = (st & 1) * 32 + (swz % 64) / 2; }

#define G_SA(b, h) (shm + ((b) * 2 + (h)) * G_HT)
#define G_SB(b, h) (shm + (4 + (b) * 2 + (h)) * G_HT)
#define G_GLDS(src, dst) __builtin_amdgcn_global_load_lds((const unsigned*)(src), (LAS unsigned*)(dst), 16, 0, 0)
#define G_STAGE_A(P, h, kt) do { const bf16_t* _s = A + arow.half_off(h) + (size_t)(kt) * G_BK; \
    G_GLDS(_s + ao[0], (char*)(P) + tid16); G_GLDS(_s + ao[1], (char*)(P) + tid16 + 8192); } while (0)
#define G_STAGE_B(P, h, kt) do { const bf16_t* _s = Bt + (size_t)(h) * G_HALF * LDB + (size_t)(kt) * G_BK; \
    G_GLDS(_s + bo[0], (char*)(P) + tid16); G_GLDS(_s + bo[1], (char*)(P) + tid16 + 8192); } while (0)
#define G_LDA(dst, b, h) _Pragma("unroll") for (int m = 0; m < 4; ++m) _Pragma("unroll") for (int k = 0; k < 2; ++k) \
    dst[m][k] = *reinterpret_cast<const bf16x8*>((const char*)G_SA(b, h) + lds_byte(wr * 64 + m * 16 + fr, k * 32 + fq * 8))
#define G_LDB(dst, b, h) _Pragma("unroll") for (int n = 0; n < 2; ++n) _Pragma("unroll") for (int k = 0; k < 2; ++k) \
    dst[n][k] = *reinterpret_cast<const bf16x8*>((const char*)G_SB(b, h) + lds_byte(wc * 32 + n * 16 + fr, k * 32 + fq * 8))
#define G_MMA(ai, bj, At, Bf) do { __builtin_amdgcn_s_setprio(1); \
    _Pragma("unroll") for (int m = 0; m < 4; ++m) _Pragma("unroll") for (int n = 0; n < 2; ++n) _Pragma("unroll") for (int k = 0; k < 2; ++k) \
      acc[ai][bj][m][n] = __builtin_amdgcn_mfma_f32_16x16x32_bf16(Bf[n][k], At[m][k], acc[ai][bj][m][n], 0, 0, 0); \
    __builtin_amdgcn_s_setprio(0); } while (0)
#define G_WAIT_V(n) asm volatile("s_waitcnt vmcnt(" #n ")" ::: "memory")
#define G_WAIT_L(n) asm volatile("s_waitcnt lgkmcnt(" #n ")" ::: "memory")
#define G_BAR __builtin_amdgcn_s_barrier()
#define G_SCHED __builtin_amdgcn_sched_barrier(0)

template <int K, int LDB, class ARow, class Epi>
__device__ __forceinline__ void gemm256(const bf16_t* __restrict__ A, const ARow& arow, const bf16_t* __restrict__ Bt, const Epi& epi) {
    bf16_t* shm = (bf16_t*)smem;
    int tz0 = tidx();
    const int tid16 = tz0 * 16;
    unsigned ao[2], bo[2];
    {
        int R0, C0, R1, C1; stage_rc(tid16, R0, C0); stage_rc(tid16 + 8192, R1, C1);
        ao[0] = arow.lane_off(R0) + C0; ao[1] = arow.lane_off(R1) + C1;
        bo[0] = (unsigned)(R0 * LDB + C0); bo[1] = (unsigned)(R1 * LDB + C1);
    }
    int wid = tz0 >> 6, lane = tz0 & 63, wr = wid >> 2, wc = wid & 3, fr = lane & 15, fq = lane >> 4;
    f32x4 acc[2][2][4][2];
#pragma unroll
    for (int a = 0; a < 2; ++a)
#pragma unroll
        for (int b = 0; b < 2; ++b)
#pragma unroll
            for (int m = 0; m < 4; ++m)
#pragma unroll
                for (int n = 0; n < 2; ++n) acc[a][b][m][n] = (f32x4){0.f, 0.f, 0.f, 0.f};
    bf16x8 At[4][2], B0[2][2], B1[2][2];
    constexpr int nt = K / G_BK;
    G_STAGE_B(G_SB(0, 0), 0, 0); G_STAGE_A(G_SA(0, 0), 0, 0);
    G_STAGE_B(G_SB(0, 1), 1, 0); G_STAGE_A(G_SA(0, 1), 1, 0);
    if (wr == 1) G_BAR;
    G_WAIT_V(4); G_BAR;
    G_STAGE_B(G_SB(1, 0), 0, 1); G_STAGE_A(G_SA(1, 0), 0, 1); G_STAGE_B(G_SB(1, 1), 1, 1);
    G_WAIT_V(6); G_BAR;
    for (int t = 0; t < nt - 2; t += 2) {
        G_LDB(B0, 0, 0); G_SCHED; G_LDA(At, 0, 0); G_STAGE_A(G_SA(1, 1), 1, t + 1);
        G_WAIT_L(8); G_BAR; G_WAIT_L(0); G_MMA(0, 0, At, B0); G_BAR; G_SCHED;
        G_LDB(B1, 0, 1); G_STAGE_B(G_SB(0, 0), 0, t + 2);
        G_BAR; G_WAIT_L(0); G_MMA(0, 1, At, B1); G_BAR;
        G_LDA(At, 0, 1); G_STAGE_A(G_SA(0, 0), 0, t + 2);
        G_BAR; G_WAIT_L(0); G_MMA(1, 0, At, B0); G_BAR; G_SCHED;
        G_STAGE_B(G_SB(0, 1), 1, t + 2);
        G_WAIT_V(6); G_BAR; G_MMA(1, 1, At, B1); G_BAR;
        G_LDB(B0, 1, 0); G_SCHED; G_LDA(At, 1, 0); G_STAGE_A(G_SA(0, 1), 1, t + 2);
        G_WAIT_L(8); G_BAR; G_WAIT_L(0); G_MMA(0, 0, At, B0); G_BAR; G_SCHED;
        G_LDB(B1, 1, 1); G_STAGE_B(G_SB(1, 0), 0, t + 3);
        G_BAR; G_WAIT_L(0); G_MMA(0, 1, At, B1); G_BAR;
        G_LDA(At, 1, 1); G_STAGE_A(G_SA(1, 0), 0, t + 3);
        G_BAR; G_WAIT_L(0); G_MMA(1, 0, At, B0); G_BAR; G_SCHED;
        G_STAGE_B(G_SB(1, 1), 1, t + 3);
        G_WAIT_V(6); G_BAR; G_MMA(1, 1, At, B1); G_BAR;
    }
    { int tz = tidx(); asm volatile("" : "+v"(tz)); wid = tz >> 6; lane = tz & 63; wr = wid >> 2; wc = wid & 3; fr = lane & 15; fq = lane >> 4; }
    { G_LDB(B0, 0, 0); G_WAIT_V(0); G_LDA(At, 0, 0); G_STAGE_A(G_SA(1, 1), 1, nt - 1);
      G_BAR; G_WAIT_L(0); G_MMA(0, 0, At, B0); G_BAR;
      G_LDB(B1, 0, 1); G_BAR; G_WAIT_L(0); G_MMA(0, 1, At, B1); G_BAR;
      G_LDA(At, 0, 1); G_WAIT_V(4); G_BAR; G_WAIT_L(0); G_MMA(1, 0, At, B0); G_MMA(1, 1, At, B1); G_BAR; }
    { G_LDB(B0, 1, 0); G_LDA(At, 1, 0); G_WAIT_V(2); G_BAR; G_WAIT_L(0); G_MMA(0, 0, At, B0); G_BAR;
      G_LDB(B1, 1, 1); G_WAIT_V(0); G_BAR; G_WAIT_L(0); G_MMA(0, 1, At, B1); G_BAR;
      G_LDA(At, 1, 1); G_BAR; G_WAIT_L(0); G_MMA(1, 0, At, B0); G_MMA(1, 1, At, B1); G_BAR; }
    if (wr == 0) G_BAR;
    epi(acc, wr, wc, fr, fq);
}

__device__ __forceinline__ int xcd_remap(int L, int nwg) { const int q = nwg / 8, r = nwg % 8, xcd = L % 8, off = L / 8; return (xcd < r ? xcd * (q + 1) : r * (q + 1) + (xcd - r) * q) + off; }
__device__ __forceinline__ void tile_of(int wgid, int nM, int nN, int& pm, int& pn) { const int nig = 8 * nN, gid = wgid / nig, fm = gid * 8, gsz = (nM - fm) < 8 ? (nM - fm) : 8; pm = fm + ((wgid % nig) % gsz); pn = (wgid % nig) / gsz; }

template <int K, int LDA, int LDB, class Units>
__device__ __forceinline__ void gemm_stream(const bf16_t* __restrict__ A, const Units& U) {
    bf16_t* shm = (bf16_t*)smem;
    typename Units::Info cur, nxt;
    if (!U.get(0, cur)) return;
    __syncthreads();
    int tz0 = tidx();
    const int tid16 = tz0 * 16;
    unsigned va[2], vb[2];
    { int R0, C0, R1, C1; stage_rc(tid16, R0, C0); stage_rc(tid16 + 8192, R1, C1);
      va[0] = (unsigned)(R0 * LDA + C0); va[1] = (unsigned)(R1 * LDA + C1); vb[0] = (unsigned)(R0 * LDB + C0); vb[1] = (unsigned)(R1 * LDB + C1); }
    const int wr = __builtin_amdgcn_readfirstlane(tz0 >> 8);
    int aoff, boff;
    { const int wid = tz0 >> 6, lane = tz0 & 63, wc = wid & 3, fr = lane & 15, fq = lane >> 4; aoff = lds_byte((wid >> 2) * 64 + fr, fq * 8); boff = lds_byte(wc * 32 + fr, fq * 8); }
#define GS_LDA(dst, b, h) _Pragma("unroll") for (int m = 0; m < 4; ++m) _Pragma("unroll") for (int k = 0; k < 2; ++k) \
    dst[m][k] = *reinterpret_cast<const bf16x8*>((const char*)G_SA(b, h) + aoff + m * 2048 + k * 1024)
#define GS_LDB(dst, b, h) _Pragma("unroll") for (int n = 0; n < 2; ++n) _Pragma("unroll") for (int k = 0; k < 2; ++k) \
    dst[n][k] = *reinterpret_cast<const bf16x8*>((const char*)G_SB(b, h) + boff + n * 2048 + k * 1024)
#define GS_STAGE_A(P, base, h) do { const bf16_t* _s = (base) + (size_t)(h) * G_HALF * LDA; G_GLDS(_s + va[0], (char*)(P) + tid16); G_GLDS(_s + va[1], (char*)(P) + tid16 + 8192); } while (0)
#define GS_STAGE_B(P, base, h) do { const bf16_t* _s = (base) + (size_t)(h) * G_HALF * LDB; G_GLDS(_s + vb[0], (char*)(P) + tid16); G_GLDS(_s + vb[1], (char*)(P) + tid16 + 8192); } while (0)
    f32x4 acc[2][2][4][2];
#pragma unroll
    for (int a = 0; a < 2; ++a)
#pragma unroll
        for (int b = 0; b < 2; ++b)
#pragma unroll
            for (int m = 0; m < 4; ++m)
#pragma unroll
                for (int n = 0; n < 2; ++n) acc[a][b][m][n] = (f32x4){0.f, 0.f, 0.f, 0.f};
    bf16x8 At[4][2], B0[2][2], B1[2][2];
    constexpr int nt = K / G_BK;
    const bf16_t* cA = A + cur.a; const bf16_t* cB = cur.b;
    GS_STAGE_B(G_SB(0, 0), cB, 0); GS_STAGE_A(G_SA(0, 0), cA, 0); GS_STAGE_B(G_SB(0, 1), cB, 1); GS_STAGE_A(G_SA(0, 1), cA, 1);
    if (wr == 1) G_BAR;
    G_WAIT_V(4); G_BAR;
    GS_STAGE_B(G_SB(1, 0), cB + G_BK, 0); GS_STAGE_A(G_SA(1, 0), cA + G_BK, 0); GS_STAGE_B(G_SB(1, 1), cB + G_BK, 1);
    G_WAIT_V(6); G_BAR;
    for (int ui = 0;; ++ui) {
        const bool has_next = U.get(ui + 1, nxt);
        const bf16_t* nA = has_next ? A + nxt.a : cA; const bf16_t* nB = has_next ? nxt.b : cB;
        for (int t = 0; t < nt; t += 2) {
            const bool last = (t == nt - 2);
            const bf16_t* a1 = cA + (size_t)(t + 1) * G_BK;
            const bf16_t* a2 = last ? nA : cA + (size_t)(t + 2) * G_BK; const bf16_t* b2 = last ? nB : cB + (size_t)(t + 2) * G_BK;
            const bf16_t* a3 = a2 + G_BK; const bf16_t* b3 = b2 + G_BK;
            GS_LDB(B0, 0, 0); G_SCHED; GS_LDA(At, 0, 0); GS_STAGE_A(G_SA(1, 1), a1, 1);
            G_WAIT_L(8); G_BAR; G_WAIT_L(0); G_MMA(0, 0, At, B0); G_BAR; G_SCHED;
            GS_LDB(B1, 0, 1); GS_STAGE_B(G_SB(0, 0), b2, 0);
            G_BAR; G_WAIT_L(0); G_MMA(0, 1, At, B1); G_BAR;
            GS_LDA(At, 0, 1); GS_STAGE_A(G_SA(0, 0), a2, 0);
            G_BAR; G_WAIT_L(0); G_MMA(1, 0, At, B0); G_BAR; G_SCHED;
            GS_STAGE_B(G_SB(0, 1), b2, 1);
            G_WAIT_V(6); G_BAR; G_MMA(1, 1, At, B1); G_BAR;
            GS_LDB(B0, 1, 0); G_SCHED; GS_LDA(At, 1, 0); GS_STAGE_A(G_SA(0, 1), a2, 1);
            G_WAIT_L(8); G_BAR; G_WAIT_L(0); G_MMA(0, 0, At, B0); G_BAR; G_SCHED;
            GS_LDB(B1, 1, 1); GS_STAGE_B(G_SB(1, 0), b3, 0);
            G_BAR; G_WAIT_L(0); G_MMA(0, 1, At, B1); G_BAR;
            GS_LDA(At, 1, 1); GS_STAGE_A(G_SA(1, 0), a3, 0);
            G_BAR; G_WAIT_L(0); G_MMA(1, 0, At, B0); G_BAR; G_SCHED;
            GS_STAGE_B(G_SB(1, 1), b3, 1);
            G_WAIT_V(6); G_BAR; G_MMA(1, 1, At, B1); G_BAR;
        }
        { const int tz = tidx(), wid = tz >> 6, lane = tz & 63; U.epi(acc, cur, wid >> 2, wid & 3, lane & 15, lane >> 4); }
        if (!has_next) break;
#pragma unroll
        for (int a = 0; a < 2; ++a)
#pragma unroll
            for (int b = 0; b < 2; ++b)
#pragma unroll
                for (int m = 0; m < 4; ++m)
#pragma unroll
                    for (int n = 0; n < 2; ++n) acc[a][b][m][n] = (f32x4){0.f, 0.f, 0.f, 0.f};
        cur = nxt; cA = nA; cB = nB;
    }
    G_WAIT_V(0);
    if (wr == 0) G_BAR;
    G_BAR;
#undef GS_STAGE_A
#undef GS_STAGE_B
#undef GS_LDA
#undef GS_LDB
}
namespace att {
constexpr int DQ = 96, DV = 64, NW = 8, QBLK = 32, KVBLK = 64;
constexpr float SCALE = 0.10206207261596575f;
constexpr float THR = 8.f;
constexpr int LDQ = 576, LDK = 96, LDV = 64, LDO = 1024;
constexpr int SHM_V = KVBLK * DV * 2;
constexpr int SHM_K = KVBLK * 128 * 2;
constexpr int NBUF = 3;
constexpr int SHM_ATTN = NBUF * SHM_V + NBUF * SHM_K + NW * 64 * 4;
#define KSWZ(row, colB) ((row) * 256 + ((colB) ^ (((row) & 7) << 4)))
#define SBAR() __builtin_amdgcn_sched_barrier(0)
__device__ __forceinline__ int crow(int r, int hi) { return (r & 3) + 8 * (r >> 2) + 4 * hi; }
__device__ __forceinline__ unsigned cvtpk(float lo, float hi) { unsigned r; asm volatile("v_cvt_pk_bf16_f32 %0, %1, %2" : "=v"(r) : "v"(lo), "v"(hi)); return r; }

constexpr float THRL = 11.5f;
__device__ __forceinline__ float bf16_exact(float x) { return __uint_as_float(cvtpk_bf16(x, 0.f) << 16); }
template <bool FIRST>
__device__ __forceinline__ void partialSM(f32x16& p0, f32x16& p1, float& m_reg, float& alpha) {
  float pmax = p0[0];
#pragma unroll
  for (int r = 1; r < 16; ++r) pmax = fmaxf(pmax, p0[r]);
#pragma unroll
  for (int r = 0; r < 16; ++r) pmax = fmaxf(pmax, p1[r]);
  { auto rr = __builtin_amdgcn_permlane32_swap(__float_as_uint(pmax), __float_as_uint(pmax), false, false);
    pmax = fmaxf(__uint_as_float(rr[0]), __uint_as_float(rr[1])); }
  if (!FIRST && __builtin_expect(__all(pmax <= THRL), 1)) { alpha = 1.f; }
  else {
    const float mn = FIRST ? bf16_exact(pmax) : bf16_exact(m_reg + fmaxf(pmax, 0.f));
    const float delta = mn - m_reg;
    alpha = __builtin_amdgcn_exp2f(-delta); m_reg = mn;
#pragma unroll
    for (int r = 0; r < 16; ++r) { p0[r] -= delta; p1[r] -= delta; }
  }
#pragma unroll
  for (int r = 0; r < 16; ++r) p0[r] = __builtin_amdgcn_exp2f(p0[r]);
}
__device__ __forceinline__ void finishSM(f32x16& p0, f32x16& p1, float alpha, float& l_reg, bf16x8& pa0, bf16x8& pa1, bf16x8& pa2, bf16x8& pa3) {
#pragma unroll
  for (int r = 0; r < 16; ++r) p1[r] = __builtin_amdgcn_exp2f(p1[r]);
  float ps = 0;
#pragma unroll
  for (int r = 0; r < 16; ++r) ps += p0[r];
#pragma unroll
  for (int r = 0; r < 16; ++r) ps += p1[r];
  { auto rr = __builtin_amdgcn_permlane32_swap(__float_as_uint(ps), __float_as_uint(ps), false, false);
    ps = __uint_as_float(rr[0]) + __uint_as_float(rr[1]); }
  l_reg = l_reg * alpha + ps;
#define PK4(P, BASE, OUT) do { unsigned a0 = cvtpk(P[BASE + 0], P[BASE + 1]), a1 = cvtpk(P[BASE + 2], P[BASE + 3]);   \
    unsigned b0 = cvtpk(P[BASE + 4], P[BASE + 5]), b1 = cvtpk(P[BASE + 6], P[BASE + 7]);                              \
    auto r0 = __builtin_amdgcn_permlane32_swap(a0, b0, false, false); auto r1 = __builtin_amdgcn_permlane32_swap(a1, b1, false, false); \
    u32x4 w = {r0[0], r1[0], r0[1], r1[1]}; OUT = *reinterpret_cast<bf16x8*>(&w); } while (0)
  PK4(p0, 0, pa0); PK4(p0, 8, pa1); PK4(p1, 0, pa2); PK4(p1, 8, pa3);
#undef PK4
}
__device__ __forceinline__ void qkt(f32x16& p0, f32x16& p1, const char* Ks, const bf16x8* qr, bf16x8 kaug, bf16x8 qaug, int r32, int hi) {
  p0 = f32x16{}; p1 = f32x16{};
#pragma unroll
  for (int d0 = 0; d0 < 6; ++d0) { int cb = (d0 * 16 + hi * 8) * 2;
    bf16x8 b0 = *reinterpret_cast<const bf16x8*>(Ks + KSWZ(r32, cb));
    bf16x8 b1 = *reinterpret_cast<const bf16x8*>(Ks + KSWZ(32 + r32, cb));
    p0 = __builtin_amdgcn_mfma_f32_32x32x16_bf16(b0, qr[d0], p0, 0, 0, 0);
    p1 = __builtin_amdgcn_mfma_f32_32x32x16_bf16(b1, qr[d0], p1, 0, 0, 0); }
  p0 = __builtin_amdgcn_mfma_f32_32x32x16_bf16(kaug, qaug, p0, 0, 0, 0);
  p1 = __builtin_amdgcn_mfma_f32_32x32x16_bf16(kaug, qaug, p1, 0, 0, 0);
}
__device__ __forceinline__ int v_st(int k, int c) { const int kk = (k & ~0xC) | ((k & 4) << 1) | ((k & 8) >> 1); return ((kk >> 3) * 2 + (c >> 5)) * 512 + ((kk & 7) * 32 + (c & 31)) * 2; }
__device__ __forceinline__ int v_rd_base(int lane) { return ((lane & 3) << 3) | (((lane >> 2) & 3) << 6) | (((lane >> 4) & 1) << 5) | (((lane >> 5) & 1) << 8); }
constexpr int v_rd_off(int d0, int ks, int half) { return d0 * 512 + ks * 2048 + half * 1024; }
template <int OFF> __device__ __forceinline__ s16x4 tr_read(int vb) {
  s16x4 r; asm volatile("ds_read_b64_tr_b16 %0, %1 offset:%2" : "=&v"(r) : "v"(vb), "i"(OFF) : "memory"); return r;
}
template <int D0> __device__ __forceinline__ void pv_one(f32x16& od, int vb, bf16x8 pa0, bf16x8 pa1, bf16x8 pa2, bf16x8 pa3) {
  const s16x4 l0 = tr_read<v_rd_off(D0, 0, 0)>(vb), h0 = tr_read<v_rd_off(D0, 0, 1)>(vb), l1 = tr_read<v_rd_off(D0, 1, 0)>(vb), h1 = tr_read<v_rd_off(D0, 1, 1)>(vb);
  const s16x4 l2 = tr_read<v_rd_off(D0, 2, 0)>(vb), h2 = tr_read<v_rd_off(D0, 2, 1)>(vb), l3 = tr_read<v_rd_off(D0, 3, 0)>(vb), h3 = tr_read<v_rd_off(D0, 3, 1)>(vb);
  asm volatile("s_waitcnt lgkmcnt(0)" ::: "memory"); SBAR();
#define PK(L, H) (bf16x8){L[0], L[1], L[2], L[3], H[0], H[1], H[2], H[3]}
  od = __builtin_amdgcn_mfma_f32_32x32x16_bf16(pa0, PK(l0, h0), od, 0, 0, 0);
  od = __builtin_amdgcn_mfma_f32_32x32x16_bf16(pa1, PK(l1, h1), od, 0, 0, 0);
  od = __builtin_amdgcn_mfma_f32_32x32x16_bf16(pa2, PK(l2, h2), od, 0, 0, 0);
  od = __builtin_amdgcn_mfma_f32_32x32x16_bf16(pa3, PK(l3, h3), od, 0, 0, 0);
#undef PK
}
__device__ __forceinline__ void pv_d0(f32x16* o, int vb, bf16x8 pa0, bf16x8 pa1, bf16x8 pa2, bf16x8 pa3) {
  pv_one<0>(o[0], vb, pa0, pa1, pa2, pa3); pv_one<1>(o[1], vb, pa0, pa1, pa2, pa3);
}

__device__ __forceinline__ void attn_body(const bf16_t* __restrict__ Qb, const bf16_t* __restrict__ Kh, const bf16_t* __restrict__ Vh, bf16_t* __restrict__ Ob, int seq, char* lds, const int samet = 0) {
  const int tid = tidx(), wid = tid >> 6, lane = tid & 63, r32 = lane & 31, hi = lane >> 5;
  char* V_lds = lds; char* K_lds = lds + NBUF * SHM_V;
  float* ws = (float*)(lds + NBUF * SHM_V + NBUF * SHM_K) + wid * 64; float* li_l = ws; float* al_l = ws + 32;
  float m_reg = 0.f, l_reg = 0.f; f32x16 o[2] = {}; bf16x8 qr[6];
  const bf16_t* Qw = Qb + (long)(wid * QBLK + r32) * LDQ + hi * 8;
#pragma unroll
  for (int d0 = 0; d0 < 6; ++d0) qr[d0] = *reinterpret_cast<const bf16x8*>(Qw + d0 * 16);
  bf16x8 kaug = {0, 0, 0, 0, 0, 0, 0, 0}; if (hi == 0) kaug[0] = 0x3F80;
  bf16x8 qaug = {0, 0, 0, 0, 0, 0, 0, 0};
#define QAUG() do { if (hi == 0) qaug[0] = (short)(cvtpk(-m_reg, 0.f) & 0xffffu); } while (0)
  const int kc0 = tid, kc1 = 512 + (tid & 255);
  const int kr0 = kc0 / 12, kcc0 = kc0 % 12, kr1 = kc1 / 12, kcc1 = kc1 % 12;
  const int vr = tid >> 3, vcc = tid & 7;
  const int kst0 = KSWZ(kr0, kcc0 * 16), kst1 = KSWZ(kr1, kcc1 * 16), vst = v_st(vr, vcc * 8);
  const int vb0 = (int)(uintptr_t)(LAS char*)V_lds + v_rd_base(lane);
  struct { bf16x8 vs0, ks0, ks1; } sr_[2];
#define SLOAD(i, k0_) do { const int k0 = samet ? 0 : (k0_); sr_[i].vs0 = *reinterpret_cast<const bf16x8*>(&Vh[(long)((k0) + vr) * LDV + vcc * 8]); \
    sr_[i].ks0 = *reinterpret_cast<const bf16x8*>(&Kh[(long)((k0) + kr0) * LDK + kcc0 * 8]); \
    sr_[i].ks1 = *reinterpret_cast<const bf16x8*>(&Kh[(long)((k0) + kr1) * LDK + kcc1 * 8]); } while (0)
#define SWRITE(b, i) do { *(bf16x8*)(V_lds + (b) * SHM_V + vst) = sr_[i].vs0; \
    *(bf16x8*)(K_lds + (b) * SHM_K + kst0) = sr_[i].ks0; *(bf16x8*)(K_lds + (b) * SHM_K + kst1) = sr_[i].ks1; } while (0)
#define SWAIT() asm volatile("s_waitcnt vmcnt(3)" ::: "memory")
#define RESC(a) do { if (__any((a) < 1.f)) { if (hi == 0) al_l[r32] = (a); asm volatile("s_waitcnt lgkmcnt(0)" ::: "memory"); \
    _Pragma("unroll") for (int r = 0; r < 16; ++r) { const float f_ = al_l[crow(r, hi)]; o[0][r] *= f_; o[1][r] *= f_; } QAUG(); } } while (0)
  f32x16 pA0, pA1, pB0, pB1; float alA, alB; bf16x8 pa0, pa1, pa2, pa3; const int NT = seq / KVBLK;
  constexpr int SE = 0, SO = 1;
  SLOAD(SE, 0); asm volatile("s_waitcnt vmcnt(0)" ::: "memory"); SWRITE(0, SE); __syncthreads();
  qkt(pA0, pA1, K_lds, qr, kaug, qaug, r32, hi); partialSM<true>(pA0, pA1, m_reg, alA); QAUG(); alA = 1.f;
  SLOAD(SO, KVBLK); if (2 < NT) SLOAD(SE, 2 * KVBLK);
  SWAIT(); SWRITE(1, SO); __syncthreads();
  int bp = 0, bc = 1, bn = 2;
  for (int j = 1; j + 1 < NT; j += 2) {
    SBAR(); qkt(pB0, pB1, K_lds + bc * SHM_K, qr, kaug, qaug, r32, hi);
    finishSM(pA0, pA1, alA, l_reg, pa0, pa1, pa2, pa3); SBAR();
    SLOAD(SO, (j + 2) * KVBLK); SBAR();
    pv_d0(o, vb0 + bp * SHM_V, pa0, pa1, pa2, pa3); partialSM<false>(pB0, pB1, m_reg, alB);
    SWAIT(); SWRITE(bn, SE);
    RESC(alB); __syncthreads();
    bp = bc; bc = bn; bn = bn == 2 ? 0 : bn + 1;
    SBAR(); qkt(pA0, pA1, K_lds + bc * SHM_K, qr, kaug, qaug, r32, hi);
    finishSM(pB0, pB1, alB, l_reg, pa0, pa1, pa2, pa3); SBAR();
    if (j + 3 < NT) SLOAD(SE, (j + 3) * KVBLK); SBAR();
    pv_d0(o, vb0 + bp * SHM_V, pa0, pa1, pa2, pa3); partialSM<false>(pA0, pA1, m_reg, alA);
    SWAIT(); SWRITE(bn, SO);
    RESC(alA); __syncthreads();
    bp = bc; bc = bn; bn = bn == 2 ? 0 : bn + 1;
  }
  SBAR(); qkt(pB0, pB1, K_lds + bc * SHM_K, qr, kaug, qaug, r32, hi);
  finishSM(pA0, pA1, alA, l_reg, pa0, pa1, pa2, pa3); SBAR();
  pv_d0(o, vb0 + bp * SHM_V, pa0, pa1, pa2, pa3); partialSM<false>(pB0, pB1, m_reg, alB);
  RESC(alB);
  finishSM(pB0, pB1, alB, l_reg, pa0, pa1, pa2, pa3); SBAR();
  pv_d0(o, vb0 + bc * SHM_V, pa0, pa1, pa2, pa3);
  if (hi == 0) li_l[r32] = l_reg; asm volatile("s_waitcnt lgkmcnt(0)" ::: "memory");
  float rli[16];
#pragma unroll
  for (int r = 0; r < 16; ++r) rli[r] = __builtin_amdgcn_rcpf(li_l[crow(r, hi)]);
  bf16_t* Ow = Ob + (long)(wid * QBLK) * LDO;
#pragma unroll
  for (int r = 0; r < 16; ++r) { int orow = crow(r, hi);
#pragma unroll
    for (int d0 = 0; d0 < 2; ++d0) Ow[(long)orow * LDO + d0 * 32 + r32] = f2bf(o[d0][r] * rli[r]); }
  __syncthreads();
#undef QAUG
#undef SLOAD
#undef SWRITE
#undef SWAIT
#undef RESC
}
}
template <class ColMap>
__device__ __forceinline__ void tr_tile(const ColMap& cm, int n0, int k0, int ksrc  , bf16_t* __restrict__ dst, long ldo) {
    float* tile = (float*)smem;
    const int tid = tidx();
    __syncthreads();
    {
        const int n = tid & 63; long ld; const float* base = cm(n0 + n, ld);
#pragma unroll
        for (int i = 0; i < 8; ++i) { const int k = (tid >> 6) + 8 * i;
            tile[k * 65 + n] = (base != nullptr && (k0 + k) < ksrc) ? base[(long)(k0 + k) * ld] : 0.f; }
    }
    __syncthreads();
    {
        const int n = tid >> 3, ks = (tid & 7) * 8;
        u32x4 w;
        w[0] = pack2bf(tile[(ks + 0) * 65 + n], tile[(ks + 1) * 65 + n]); w[1] = pack2bf(tile[(ks + 2) * 65 + n], tile[(ks + 3) * 65 + n]);
        w[2] = pack2bf(tile[(ks + 4) * 65 + n], tile[(ks + 5) * 65 + n]); w[3] = pack2bf(tile[(ks + 6) * 65 + n], tile[(ks + 7) * 65 + n]);
        *reinterpret_cast<u32x4*>(dst + (long)(n0 + n) * ldo + k0 + ks) = w;
    }
}

struct CmWin { const float* w; __device__ __forceinline__ const float* operator()(int n, long& ld) const {
    ld = IN_W; int s;
    if (n < 1280) s = n; else if (n < 1472) s = n - 1280 + 1292; else if (n < 1600) s = n - 1472 + 1484; else if (n < 1632) s = n - 1600 + 1612;
    else if (n < 1644) s = n - 1632 + 1280; else if (n < 1664) s = -1; else s = n - 1664 + 1644;
    return s < 0 ? nullptr : w + s; } };
struct CmPlain { const float* w; long ldw; __device__ __forceinline__ const float* operator()(int n, long& ld) const { ld = ldw; return w + n; } };
struct CmW13 { const float *w1, *w3; __device__ __forceinline__ const float* operator()(int n, long& ld) const {
    ld = 512; const int pn = n >> 8, half = (n >> 7) & 1, c = n & 127; return (half ? w3 : w1) + pn * 128 + c; } };

__device__ __forceinline__ void ph_prologue(const Params& p) {
    const int bid = bidx(), nb = gridDim.x, tid = tidx();
    unsigned char* ws = p.ws;
    {
        const int nIn = 4 * 44 * 16, nOut = 4 * 16 * 16;
        for (int u = bid; u < nIn + nOut; u += nb) {
            if (u < nIn) { const int L = u / (44 * 16), r = u % (44 * 16), nt = r / 16, kt = r % 16;
                CmWin cm{p.w_in + (size_t)L * 1024 * IN_W};
                tr_tile(cm, nt * 64, kt * 64, 1024, (bf16_t*)(ws + WS_WIN) + (size_t)L * UW * 1024, 1024);
            } else { const int v = u - nIn, L = v / 256, r = v % 256, nt = r / 16, kt = r % 16;
                CmPlain cm{p.w_out + (size_t)L * 1024 * 1024, 1024};
                tr_tile(cm, nt * 64, kt * 64, 1024, (bf16_t*)(ws + WS_WOUT) + (size_t)L * 1024 * 1024, 1024);
            }
        }
    }
    {
        bf16_t* wup = (bf16_t*)(ws + WS_WUP);
        const long total = (long)4 * UPW * UPK;
        for (long i = (long)bid * NTHREADS + tid; i < total; i += (long)nb * NTHREADS) {
            const int L = (int)(i / (UPW * UPK)), r = (int)(i % (UPW * UPK)), n = r / UPK, k = r % UPK;
            float v = 0.f;
            if (n < 576) { if (k < 192) v = p.mla_q_norm_w[L * 192 + k] * p.mla_w_uq[((size_t)L * 192 + k) * 576 + n]; }
            else if (n >= 768) { if (k >= 192 && k < 320) v = p.mla_kv_norm_w[L * 128 + (k - 192)] * p.mla_w_ukv[((size_t)L * 128 + (k - 192)) * 768 + (n - 768)]; }
            wup[i] = f2bf(v);
        }
    }
    {
        bf16_t* wl = (bf16_t*)(ws + WS_WLORA);
        const long total = (long)4 * 98304;
        for (long i = (long)bid * NTHREADS + tid; i < total; i += (long)nb * NTHREADS) {
            const int L = (int)(i / 98304), r = (int)(i % 98304); float v;
            if (r < 32768) { const int d = r / 16384, n = (r / 64) % 256, k = r % 64; v = p.rwkv_w2[(((size_t)L * 2 + d) * 64 + k) * 256 + n]; }
            else if (r < 65536) { const int q = r - 32768, d = q / 16384, n = (q / 64) % 256, k = q % 64; v = p.rwkv_a2[(((size_t)L * 2 + d) * 64 + k) * 256 + n]; }
            else { const int q = r - 65536, n = q / 128, k = q % 128; v = p.rwkv_g2[((size_t)L * 128 + k) * 256 + n]; }
            wl[i] = f2bf(v);
        }
    }
    {
        float* wrt = (float*)(ws + WS_WRT);
        const long total = (long)4 * 72 * 1024;
        for (long i = (long)bid * NTHREADS + tid; i < total; i += (long)nb * NTHREADS) {
            const int L = (int)(i / (72 * 1024)), r = (int)(i % (72 * 1024)), o = r / 1024, k = r % 1024;
            wrt[i] = o < 8 ? p.moe_w_rg[((size_t)L * 1024 + k) * 8 + o] : p.moe_w_re[((size_t)L * 1024 + k) * 64 + (o - 8)];
        }
    }
    {
        bf16_t* wr = (bf16_t*)(ws + WS_WRH);
        const long total = (long)4 * 80 * 1024;
        for (long i = (long)bid * NTHREADS + tid; i < total; i += (long)nb * NTHREADS) {
            const int L = (int)(i / (80 * 1024)), r = (int)(i % (80 * 1024)), o = r / 1024, k = r % 1024;
            const float v = o < 8 ? p.moe_w_rg[((size_t)L * 1024 + k) * 8 + o] : (o < 72 ? p.moe_w_re[((size_t)L * 1024 + k) * 64 + (o - 8)] : 0.f);
            const bf16_t hi = f2bf(v);
            wr[((size_t)L * 2 + 0) * 80 * 1024 + r] = hi; wr[((size_t)L * 2 + 1) * 80 * 1024 + r] = f2bf(v - bf2f(hi));
        }
    }
    {
        float* cs = (float*)smem;
        __syncthreads();
        for (int i = tid; i < 3 * 1024; i += NTHREADS) { const int s = i >> 10, k = i & 1023; const float v = s < 2 ? p.c[s * 1024 + k] : p.c_ctx[k]; cs[i] = silu_f(v); }
        __syncthreads();
        float* mods = (float*)(ws + WS_MODS);
        float* red = cs + 3 * 1024;
        const int lane = tid & 63, wid = tid >> 6;
        for (int task = bid; task < 4 * 96; task += nb) {
            const int L = task / 96, col = (task % 96) * 64 + lane;
            const float* w = p.mod_w + (size_t)L * 1024 * 6144 + (size_t)(128 * wid) * 6144 + col;
            const float* c0 = cs + 128 * wid;
            float a0 = 0.f, a1 = 0.f, a2 = 0.f;
#pragma unroll 16
            for (int k = 0; k < 128; ++k) { const float wv = w[(size_t)k * 6144]; a0 = fmaf(c0[k], wv, a0); a1 = fmaf(c0[1024 + k], wv, a1); a2 = fmaf(c0[2048 + k], wv, a2); }
            red[(wid * 3 + 0) * 64 + lane] = a0; red[(wid * 3 + 1) * 64 + lane] = a1; red[(wid * 3 + 2) * 64 + lane] = a2;
            __syncthreads();
            if (tid < 192) { const int s3 = tid >> 6; float acc = p.mod_b[L * 6144 + (task % 96) * 64 + lane];
#pragma unroll
                for (int w8 = 0; w8 < 8; ++w8) acc += red[(w8 * 3 + s3) * 64 + lane];
                mods[(L * 3 + s3) * 6144 + (task % 96) * 64 + lane] = acc; }
            __syncthreads();
        }
        __syncthreads();
    }
    {
        bf16_t* Xb = (bf16_t*)(ws + WS_X);
        const f32x4* x4 = (const f32x4*)p.x; const f32x4* c4 = (const f32x4*)p.ctx;
        const long nl = (long)NLAT * 256, nt = (long)NTOK * 256;
        for (long i = (long)bid * NTHREADS + tid; i < nt; i += (long)nb * NTHREADS) st4bf(Xb + i * 4, i < nl ? x4[i] : c4[i - nl]);
    }
}

__device__ __forceinline__ void tr_tile256(const float* __restrict__ srcA, const float* __restrict__ srcB, long ldsrc, bf16_t* __restrict__ dst, long ldo) {
    unsigned* tl = (unsigned*)smem;
    const int tid = tidx(), lane = tid & 63, w = tid >> 6;
    __syncthreads();
    f32x4 v0[4], v1[4];
    const float* sp = (lane < 32 ? srcA + lane * 4 : srcB + (lane - 32) * 4);
#pragma unroll
    for (int it = 0; it < 4; ++it) { const int kp = w + 8 * it;
        v0[it] = *(const f32x4*)(sp + (long)(2 * kp) * ldsrc); v1[it] = *(const f32x4*)(sp + (long)(2 * kp + 1) * ldsrc); }
#pragma unroll
    for (int it = 0; it < 4; ++it) { const int kp = w + 8 * it;
#pragma unroll
        for (int i = 0; i < 4; ++i) tl[(4 * lane + i) * 33 + kp] = cvtpk_bf16(v0[it][i], v1[it][i]); }
    __syncthreads();
#pragma unroll
    for (int it = 0; it < 4; ++it) { const int n = (tid >> 3) + 64 * it, ks = tid & 7;
        u32x4 o; o[0] = tl[n * 33 + ks * 4 + 0]; o[1] = tl[n * 33 + ks * 4 + 1]; o[2] = tl[n * 33 + ks * 4 + 2]; o[3] = tl[n * 33 + ks * 4 + 3];
        *(u32x4*)(dst + (long)n * ldo + ks * 8) = o; }
}
constexpr int MOE_CV_N13 = 64 * 4 * 16, MOE_CV_N2 = 64 * 4 * 8;
__device__ __forceinline__ void moe_convert_tile(const Params& p, int L, int u) {
    unsigned char* ws = p.ws;
    constexpr int n13 = MOE_CV_N13;
    {
        if (u < n13) { const int e = u / 64, r = u % 64, pn = r / 16, kt = r % 16;
            const size_t eo = ((size_t)L * 64 + e) * 1024 * 512 + (size_t)kt * 64 * 512 + pn * 128;
            tr_tile256(p.moe_w1 + eo, p.moe_w3 + eo, 512, (bf16_t*)(ws + WS_W13) + ((size_t)e * 1024 + pn * 256) * 1024 + kt * 64, 1024);
        } else { const int v = u - n13, e = v / 32, r = v % 32, nt = r / 8, kt = r % 8;
            const float* sb = p.moe_w2 + ((size_t)L * 64 + e) * 512 * 1024 + (size_t)kt * 64 * 1024 + nt * 256;
            tr_tile256(sb, sb + 128, 1024, (bf16_t*)(ws + WS_W2) + ((size_t)e * 1024 + nt * 256) * 512 + kt * 64, 512);
        }
    }
}
__device__ __forceinline__ void ph_norm1(const Params& p, int L) {
    unsigned char* ws = p.ws;
    bf16_t* X = (bf16_t*)(ws + WS_X); bf16_t* H = (bf16_t*)(ws + WS_H);
    const float* mods = (const float*)(ws + WS_MODS);
    const int* SLOT = (const int*)(ws + WS_SLOT); const float* GATE = (const float*)(ws + WS_GATE); const bf16_t* YE = (const bf16_t*)(ws + WS_YEXP);
    const int lane = tidx() & 63, gw = bidx() * 8 + wave_id(), nw = gridDim.x * 8;
    if (bidx() == 0) { ((int*)(ws + WS_MISC))[tidx()] = 0; ((int*)(ws + WS_MISC))[512 + tidx()] = 0; }
    const float* n1w = p.norm1_w + L * 1024;
    float* par = (float*)smem;
    __syncthreads();
    for (int i = tidx(); i < 3 * 1024; i += NTHREADS) { const int set = i >> 10, c = i & 1023; const float* md = mods + (L * 3 + set) * 6144;
        par[(set * 3 + 0) * 1024 + c] = n1w[c] * (1.f + md[1024 + c]); par[(set * 3 + 1) * 1024 + c] = md[c];
        par[(set * 3 + 2) * 1024 + c] = L > 0 ? mods[((L - 1) * 3 + set) * 6144 + 5 * 1024 + c] : 0.f; }
    __syncthreads();
    constexpr int RB = 2;
    for (int r0 = gw * RB; r0 < NTOK; r0 += nw * RB) {
        f32x4 v[RB][4];
#pragma unroll
        for (int q = 0; q < RB; ++q)
#pragma unroll
            for (int i = 0; i < 4; ++i) v[q][i] = ld4bf(X + (size_t)(r0 + q) * 1024 + i * 256 + lane * 4);
        if (L > 0) {
            int s0[RB], s1[RB]; float ga[RB], gb[RB];
#pragma unroll
            for (int q = 0; q < RB; ++q) { s0[q] = SLOT[(r0 + q) * 2]; s1[q] = SLOT[(r0 + q) * 2 + 1]; ga[q] = GATE[(r0 + q) * 2]; gb[q] = GATE[(r0 + q) * 2 + 1]; }
            u32x2 ya[RB][4], yb[RB][4];
#pragma unroll
            for (int q = 0; q < RB; ++q)
#pragma unroll
                for (int i = 0; i < 4; ++i) { const int col = i * 256 + lane * 4; ya[q][i] = *(const u32x2*)(YE + (size_t)s0[q] * 1024 + col); yb[q][i] = *(const u32x2*)(YE + (size_t)s1[q] * 1024 + col); }
#pragma unroll
            for (int q = 0; q < RB; ++q) { const float* g2 = par + (row_set(r0 + q) * 3 + 2) * 1024;
#pragma unroll
                for (int i = 0; i < 4; ++i) { const int col = i * 256 + lane * 4; const f32x4 gg = *(const f32x4*)(g2 + col);
                    v[q][i][0] += gg[0] * (ga[q] * __uint_as_float(ya[q][i][0] << 16) + gb[q] * __uint_as_float(yb[q][i][0] << 16));
                    v[q][i][1] += gg[1] * (ga[q] * __uint_as_float(ya[q][i][0] & 0xffff0000u) + gb[q] * __uint_as_float(yb[q][i][0] & 0xffff0000u));
                    v[q][i][2] += gg[2] * (ga[q] * __uint_as_float(ya[q][i][1] << 16) + gb[q] * __uint_as_float(yb[q][i][1] << 16));
                    v[q][i][3] += gg[3] * (ga[q] * __uint_as_float(ya[q][i][1] & 0xffff0000u) + gb[q] * __uint_as_float(yb[q][i][1] & 0xffff0000u));
                    st4bf(X + (size_t)(r0 + q) * 1024 + col, v[q][i]); } }
        }
#pragma unroll
        for (int q = 0; q < RB; ++q) { const int row = r0 + q, set = row_set(row);
            float ss = 0.f;
#pragma unroll
            for (int i = 0; i < 4; ++i) ss += v[q][i][0] * v[q][i][0] + v[q][i][1] * v[q][i][1] + v[q][i][2] * v[q][i][2] + v[q][i][3] * v[q][i][3];
            ss = wave_sum(ss);
            const float rs = rsqrtf(ss * (1.f / 1024.f) + NORM_EPS);
            const float* pa = par + (set * 3) * 1024;
#pragma unroll
            for (int i = 0; i < 4; ++i) { const int col = i * 256 + lane * 4;
                const f32x4 w = *(const f32x4*)(pa + col), sh = *(const f32x4*)(pa + 1024 + col);
                u32x2 o;
                o[0] = cvtpk_bf16(v[q][i][0] * rs * w[0] + sh[0], v[q][i][1] * rs * w[1] + sh[1]);
                o[1] = cvtpk_bf16(v[q][i][2] * rs * w[2] + sh[2], v[q][i][3] * rs * w[3] + sh[3]);
                *(u32x2*)(H + (size_t)row * 1024 + col) = o; } }
    }
}

template <int LD> struct ARowLin { size_t base;
    __device__ __forceinline__ size_t half_off(int h) const { return base + (size_t)h * G_HALF * LD; }
    __device__ __forceinline__ unsigned lane_off(int r) const { return (unsigned)(r * LD); } };

#define EPI_FENCE() asm volatile("" ::: "memory")
struct EpiBf16Store {
    bf16_t* O; long ld;
    __device__ __forceinline__ void operator()(const f32x4 (&acc)[2][2][4][2], int wr, int wc, int fr, int fq) const {
#pragma unroll
        for (int ai = 0; ai < 2; ++ai)
#pragma unroll
            for (int m = 0; m < 4; ++m) { bf16_t* rp = O + (long)(ai * 128 + wr * 64 + m * 16 + fr) * ld + wc * 32 + fq * 4;
#pragma unroll
                for (int bj = 0; bj < 2; ++bj)
#pragma unroll
                    for (int n = 0; n < 2; ++n) { const f32x4 a = acc[ai][bj][m][n]; u32x2 o; o[0] = cvtpk_bf16(a[0], a[1]); o[1] = cvtpk_bf16(a[2], a[3]);
                        *(u32x2*)(rp + bj * 128 + n * 16) = o; }
                EPI_FENCE(); }
    }
};
struct EpiResid {
    bf16_t* X; const float* mods_g; int row0, col0;
    __device__ __forceinline__ void operator()(const f32x4 (&acc)[2][2][4][2], int wr, int wc, int fr, int fq) const {
        const float* gp = mods_g + row_set(row0) * 6144 + col0 + wc * 32 + fq * 4;
#pragma unroll
        for (int bj = 0; bj < 2; ++bj)
#pragma unroll
            for (int n = 0; n < 2; ++n) { const f32x4 g = *(const f32x4*)(gp + bj * 128 + n * 16);
#pragma unroll
                for (int ai = 0; ai < 2; ++ai)
#pragma unroll
                    for (int m = 0; m < 4; ++m) { const int row = row0 + ai * 128 + wr * 64 + m * 16 + fr;
                        bf16_t* rp = X + (size_t)row * 1024 + col0 + wc * 32 + fq * 4 + bj * 128 + n * 16;
                        f32x4 x = ld4bf(rp); x += g * acc[ai][bj][m][n]; st4bf(rp, x); }
                EPI_FENCE(); }
    }
};
struct EpiSwiglu {
    bf16_t* O;
    __device__ __forceinline__ void operator()(const f32x4 (&acc)[2][2][4][2], int wr, int wc, int fr, int fq) const {
#pragma unroll
        for (int ai = 0; ai < 2; ++ai)
#pragma unroll
            for (int m = 0; m < 4; ++m) { bf16_t* rp = O + (long)(ai * 128 + wr * 64 + m * 16 + fr) * 512 + wc * 32 + fq * 4;
#pragma unroll
                for (int n = 0; n < 2; ++n) { const f32x4 a = acc[ai][0][m][n], b = acc[ai][1][m][n]; u32x2 o;
                    o[0] = cvtpk_bf16(silu_f(a[0]) * b[0], silu_f(a[1]) * b[1]); o[1] = cvtpk_bf16(silu_f(a[2]) * b[2], silu_f(a[3]) * b[3]);
                    *(u32x2*)(rp + n * 16) = o; }
                EPI_FENCE(); }
    }
};

struct UnitsIn { const bf16_t* W; bf16_t* U; int bid, nb;
    struct Info { size_t a; const bf16_t* b; bf16_t* o; };
    __device__ __forceinline__ bool get(int i, Info& u) const { const int t = bid + i * nb; if (t >= 130 * 11) return false; int pm, pn; tile_of(xcd_remap(t, 130 * 11), 130, 11, pm, pn);
        u.a = (size_t)pm * 256 * 1024; u.b = W + (size_t)pn * 256 * 1024; u.o = U + (size_t)pm * 256 * UW + pn * 256; return true; }
    __device__ __forceinline__ void epi(const f32x4 (&acc)[2][2][4][2], const Info& u, int wr, int wc, int fr, int fq) const { EpiBf16Store e{u.o, UW}; e(acc, wr, wc, fr, fq); } };
__device__ __forceinline__ void ph_gemm_in(const Params& p, int L) {
    unsigned char* ws = p.ws;
    UnitsIn un{(const bf16_t*)(ws + WS_WIN) + (size_t)L * UW * 1024, (bf16_t*)(ws + WS_U), bidx(), (int)gridDim.x};
    gemm_stream<1024, 1024, 1024>((const bf16_t*)(ws + WS_H), un);
}
struct UnitsOut { const bf16_t* W; bf16_t* X; const float* mg; int bid, nb, ntile;
    struct Info { size_t a; const bf16_t* b; int row0, col0; };
    __device__ __forceinline__ bool get(int i, Info& u) const { const int t = bid + i * nb; if (t >= ntile) return false; int pm, pn; tile_of(xcd_remap(t, ntile), ntile / 4, 4, pm, pn);
        u.a = (size_t)pm * 256 * 1024; u.b = W + (size_t)pn * 256 * 1024; u.row0 = pm * 256; u.col0 = pn * 256; return true; }
    __device__ __forceinline__ void epi(const f32x4 (&acc)[2][2][4][2], const Info& u, int wr, int wc, int fr, int fq) const { EpiResid e{X, mg, u.row0, u.col0}; e(acc, wr, wc, fr, fq); } };
__device__ __forceinline__ void ph_gemm_out(const Params& p, int L) {
    unsigned char* ws = p.ws;
    UnitsOut un{(const bf16_t*)(ws + WS_WOUT) + (size_t)L * 1024 * 1024, (bf16_t*)(ws + WS_X), (const float*)(ws + WS_MODS) + L * 3 * 6144 + 2 * 1024, bidx(), (int)gridDim.x,
                (L == DEPTH - 1 ? 128 : 130) * 4};
    gemm_stream<1024, 1024, 1024>((const bf16_t*)(ws + WS_MIX), un);
}

constexpr float QSC = 0.10206207261596575f * 1.4426950408889634f;
struct MlaRow { u32x4 nv, c0, c1, c2; };
__device__ __forceinline__ void mla_load(MlaRow& o, const bf16_t* U, const bf16_t* QU, int row, int lane) {
    o.nv = *(const u32x4*)(U + (size_t)row * UW + U_QD + 8 * (lane < 44 ? lane : 43));
    const bf16_t* qu = QU + (size_t)row * UPW + 8 * lane;
    o.c0 = *(const u32x4*)qu; o.c1 = *(const u32x4*)(qu + 512); o.c2 = *(const u32x4*)(qu + 1024);
}
__device__ __forceinline__ void mla_unpack(const u32x4& v, float (&f)[8]) {
#pragma unroll
    for (int i = 0; i < 4; ++i) { f[2 * i] = __uint_as_float(v[i] << 16); f[2 * i + 1] = __uint_as_float(v[i] & 0xffff0000u); } }
__device__ __forceinline__ u32x4 mla_pack(const float (&f)[8]) { u32x4 r = {cvtpk_bf16(f[0], f[1]), cvtpk_bf16(f[2], f[3]), cvtpk_bf16(f[4], f[5]), cvtpk_bf16(f[6], f[7])}; return r; }
__device__ __forceinline__ u32x4 mla_partner(const u32x4& v) { u32x4 r;
#pragma unroll
    for (int i = 0; i < 4; ++i) r[i] = (unsigned)__builtin_amdgcn_update_dpp(0, (int)v[i], 0xB1, 0xF, 0xF, true);
    return r; }
__device__ __forceinline__ u32x4 mla_rot(const u32x4& own, const u32x4& par, const float (&cs)[8], const float (&sn)[8], float scale) {
    float x[8], y[8], o[8]; mla_unpack(own, x); mla_unpack(par, y);
#pragma unroll
    for (int i = 0; i < 8; ++i) o[i] = (x[i] * cs[i] + y[i] * sn[i]) * scale;
    return mla_pack(o); }
__device__ __forceinline__ u32x4 mla_scale(const u32x4& v, float scale) { float x[8]; mla_unpack(v, x);
#pragma unroll
    for (int i = 0; i < 8; ++i) x[i] *= scale;
    return mla_pack(x); }
__device__ __forceinline__ void ph_mla_prep_rows(const Params& p, int row_lo, int row_hi, int wave_lin, int nwaves) {
    unsigned char* ws = p.ws;
    const bf16_t* U = (const bf16_t*)(ws + WS_U); const bf16_t* QU = (const bf16_t*)(ws + WS_QKVUP);
    bf16_t* Q = (bf16_t*)(ws + WS_Q); bf16_t* Kb = (bf16_t*)(ws + WS_K); bf16_t* Vb = (bf16_t*)(ws + WS_V);
    const int lane = tidx() & 63;
    const int l12 = lane % 12;
    const bool rope0 = l12 >= 8, rope1 = (lane >> 2) == 1, ropek = (lane >> 2) == 10;
    const int ropeg = rope0 ? (l12 - 8) >> 1 : (lane & 3) >> 1;
    const float sgn = (lane & 1) ? 1.f : -1.f;
    int row = row_lo + wave_lin;
    if (row >= row_hi) return;
    MlaRow cur; mla_load(cur, U, QU, row, lane);
    for (; row < row_hi; row += nwaves) {
        MlaRow nxt; { const int rn = row + nwaves < row_hi ? row + nwaves : row; mla_load(nxt, U, QU, rn, lane); }
        float ss = 0.f;
        { float f[8]; mla_unpack(cur.nv, f);
#pragma unroll
          for (int i = 0; i < 8; ++i) ss += f[i] * f[i]; }
        const float sq = wave_sum(lane < 24 ? ss : 0.f), sk = wave_sum((lane >= 24 && lane < 40) ? ss : 0.f);
        const float rq = rsqrtf(sq * (1.f / 192.f) + NORM_EPS), rk = rsqrtf(sk * (1.f / 128.f) + NORM_EPS);
        int b, pos; bool lat;
        if (row < NLAT) { b = row >> 14; pos = row & 16383; lat = true; } else { const int r = row - NLAT; b = r >> 8; pos = r & 255; lat = false; }
        const int kpos = lat ? CTXL + pos : pos;
        const float ax = (float)(ropeg ? (pos & 63) : (pos >> 6));
        float cs[8], sn[8];
        { const float inv[8] = {1.f, 0.31622776601683794f, 0.1f, 0.03162277660168379f, 0.01f, 0.003162277660168379f, 0.001f, 0.00031622776601683794f};
#pragma unroll
          for (int i = 0; i < 8; ++i) { const float rev = ax * inv[i] * 0.15915494309189535f;
              cs[i] = lat ? __builtin_amdgcn_cosf(rev) : 1.f; sn[i] = lat ? sgn * __builtin_amdgcn_sinf(rev) : 0.f; } }
        { const u32x4 par = mla_partner(cur.c0);
          const u32x4 o = rope0 ? mla_rot(cur.c0, par, cs, sn, rq * QSC) : mla_scale(cur.c0, rq * QSC);
          *(u32x4*)(Q + (size_t)row * 576 + 8 * lane) = o; }
        { const u32x4 par = mla_partner(cur.c1);
          if (lane < 8) { const u32x4 o = rope1 ? mla_rot(cur.c1, par, cs, sn, rq * QSC) : mla_scale(cur.c1, rq * QSC);
              *(u32x4*)(Q + (size_t)row * 576 + 512 + 8 * lane) = o; } }
        if (lane >= 32) { const int c = lane - 32, hd = c >> 4, cc = c & 15; const size_t base = (size_t)(b * 6 + hd) * KEYS + kpos;
            bf16_t* dst = cc < 8 ? Kb + base * 96 + 8 * cc : Vb + base * 64 + 8 * (cc - 8);
            *(u32x4*)dst = mla_scale(cur.c1, rk); }
        { const int c = lane + 32, hd = c >> 4, cc = c & 15; const size_t base = (size_t)(b * 6 + hd) * KEYS + kpos;
            bf16_t* dst = cc < 8 ? Kb + base * 96 + 8 * cc : Vb + base * 64 + 8 * (cc - 8);
            *(u32x4*)dst = mla_scale(cur.c2, rk); }
        { const u32x4 par = mla_partner(cur.nv);
          if (ropek) { const u32x4 o = mla_rot(cur.nv, par, cs, sn, 1.f);
#pragma unroll
              for (int hd = 0; hd < 6; ++hd) *(u32x4*)(Kb + ((size_t)(b * 6 + hd) * KEYS + kpos) * 96 + 64 + 8 * (lane & 3)) = o; } }
        cur = nxt;
    }
}
constexpr int SSD_UNITS = 2 * 130;
constexpr int SSD_RS = 136;
constexpr int SSD_XT = 0;
constexpr int SSD_B  = SSD_XT + 192 * SSD_RS * 2;
constexpr int SSD_C  = SSD_B + 128 * SSD_RS * 2;
constexpr int SSD_V  = SSD_C + 128 * SSD_RS * 2;
static_assert(SSD_V + 6 * 3 * 128 * 4 <= LDS_MISC, "SSD LDS map");

__device__ __forceinline__ void ssd_unit_rows(int unit, int& b, int& row0, int& qf, int& qb) {
    b = unit / 130; const int c = unit % 130;
    if (c < 2) { row0 = NLAT + b * CTXL + c * 128; qf = c; qb = 1 - c; }
    else { row0 = b * SEQ + (c - 2) * 128; qf = c; qb = 2 + 127 - (c - 2); }
}

template <int PASS>
__device__ __forceinline__ void ssd_stage(const Params& p, int L, int row0, int grp) {
    const bf16_t* U = (const bf16_t*)(p.ws + WS_U);
    bf16_t* XT = (bf16_t*)(smem + SSD_XT); bf16_t* Bl = (bf16_t*)(smem + SSD_B); bf16_t* Cl = (bf16_t*)(smem + SSD_C); float* Vv = (float*)(smem + SSD_V);
    const int tid = tidx();
    int sbase, spos0, slen; row_seq(row0, sbase, spos0, slen);
    if (tid < 448) {
        const int cp = tid % 224, rh = tid / 224, c2 = cp * 2;
        const int src = c2 < 192 ? grp * 192 + c2 : (c2 < 320 ? 384 + grp * 128 + (c2 - 192) : 640 + grp * 128 + (c2 - 320));
        if (PASS == 3 || c2 < 320) {
            const float* cw = p.ssd_conv_w + (size_t)L * 5 * 896 + src; const float* cb = p.ssd_conv_b + L * 896 + src;
            float w0[5], w1[5];
#pragma unroll
            for (int j = 0; j < 5; ++j) { w0[j] = cw[j * 896]; w1[j] = cw[j * 896 + 1]; }
            const float b0 = cb[0], b1 = cb[1];
            const int pos_lo = spos0 + rh * 64;
            const bf16_t* ub = U + (size_t)sbase * UW + U_XBC + src;
            unsigned xr[68];
#pragma unroll
            for (int j = 0; j < 68; ++j) { const int ps = pos_lo - 2 + j; xr[j] = (ps >= 0 && ps < slen) ? *(const unsigned*)(ub + (size_t)ps * UW) : 0u; }
#pragma unroll
            for (int i4 = 0; i4 < 64; i4 += 4) {
                float q0[4], q1[4];
#pragma unroll
                for (int ii = 0; ii < 4; ++ii) { const int i = i4 + ii;
                    float s0 = b0, s1 = b1;
#pragma unroll
                    for (int j = 0; j < 5; ++j) { s0 = fmaf(w0[j], __uint_as_float(xr[i + j] << 16), s0); s1 = fmaf(w1[j], __uint_as_float(xr[i + j] & 0xffff0000u), s1); }
                    q0[ii] = silu_f(s0); q1[ii] = silu_f(s1); }
                const int s = rh * 64 + i4;
                if (c2 < 192 || (PASS == 1 && c2 < 320)) {
                    bf16_t* T = c2 < 192 ? XT + c2 * SSD_RS + s : Bl + (c2 - 192) * SSD_RS + s;
                    u32x2 a = {cvtpk_bf16(q0[0], q0[1]), cvtpk_bf16(q0[2], q0[3])}, b = {cvtpk_bf16(q1[0], q1[1]), cvtpk_bf16(q1[2], q1[3])};
                    *(u32x2*)T = a; *(u32x2*)(T + SSD_RS) = b;
                } else {
                    bf16_t* T = c2 < 320 ? Bl + s * SSD_RS + (c2 - 192) : Cl + s * SSD_RS + (c2 - 320);
#pragma unroll
                    for (int ii = 0; ii < 4; ++ii) *(unsigned*)(T + ii * SSD_RS) = cvtpk_bf16(q0[ii], q1[ii]);
                }
            }
        }
    } else {
        float raw[12];
#pragma unroll
        for (int j = 0; j < 12; ++j) { const int e = tid - 448 + 64 * j, d = e / 384, hh = (e / 128) % 3, s = e % 128; raw[j] = bf2f(U[(size_t)(row0 + s) * UW + U_DT + d * 6 + grp * 3 + hh]); }
#pragma unroll
        for (int j = 0; j < 12; ++j) { const int e = tid - 448 + 64 * j, d = e / 384, hh = (e / 128) % 3, s = e % 128;
            Vv[(d * 3 + hh) * 128 + s] = softplus_f(raw[j] + p.ssd_dt_bias[(L * 2 + d) * 6 + grp * 3 + hh]); }
    }
    __syncthreads();
    if (tid < 384) {
        const int wv = tid >> 6, l = tid & 63, d = wv / 3, hh = wv % 3, h = grp * 3 + hh;
        const float a = -__expf(p.ssd_a_log[(L * 2 + d) * 6 + h]);
        const float* dt = Vv + (d * 3 + hh) * 128; float* cs = Vv + ((2 + d) * 3 + hh) * 128;
        const int s0 = d ? 127 - 2 * l : 2 * l, s1 = d ? 126 - 2 * l : 2 * l + 1;
        const float v0 = dt[s0] * a, v1 = dt[s1] * a;
        const float incl = wave_scan_incl(v0 + v1), excl = incl - (v0 + v1);
        cs[s0] = excl + v0; cs[s1] = incl;
    }
    __syncthreads();
    if (PASS == 1) {
        for (int e = tid; e < 2 * 3 * 128; e += NTHREADS) { const int d = e / 384, hh = (e / 128) % 3, s = e % 128;
            const float* cs = Vv + ((2 + d) * 3 + hh) * 128; const float tot = d ? cs[0] : cs[127];
            Vv[((4 + d) * 3 + hh) * 128 + s] = Vv[(d * 3 + hh) * 128 + s] * __expf(tot - cs[s]); }
        __syncthreads();
    }
}

__device__ void ssd_pass1_unit(const Params& p, int L, int unit) {
    float* SST = (float*)(p.ws + WS_SST); float* SDEC = (float*)(p.ws + WS_SDEC);
    const bf16_t* XT = (const bf16_t*)(smem + SSD_XT); const bf16_t* BT = (const bf16_t*)(smem + SSD_B); const float* Vv = (const float*)(smem + SSD_V);
    int b, row0, qf, qb; ssd_unit_rows(unit, b, row0, qf, qb);
    for (int grp = 0; grp < 2; ++grp) {
        __syncthreads();
        ssd_stage<1>(p, L, row0, grp);
        const int tid = tidx(), lane = tid & 63, w = tid >> 6, fr = lane & 15, g = lane >> 4;
        if (tid < 6) { const int d = tid / 3, hh = tid % 3; const float* cs = Vv + ((2 + d) * 3 + hh) * 128;
            SDEC[((size_t)(d * 2 + b) * 130 + (d ? qb : qf)) * 8 + grp * 3 + hh] = __expf(d ? cs[0] : cs[127]); }
#pragma unroll 1
        for (int dh = 0; dh < 6; ++dh) {
            const int d = dh / 3, hh = dh % 3, h = grp * 3 + hh;
            const float* wd = Vv + ((4 + d) * 3 + hh) * 128;
            bf16x8 bfr[4];
#pragma unroll
            for (int ks = 0; ks < 4; ++ks) {
                const u32x4 raw = *(const u32x4*)(BT + (16 * w + fr) * SSD_RS + 32 * ks + 8 * g);
                const f32x4 wa = *(const f32x4*)(wd + 32 * ks + 8 * g), wb = *(const f32x4*)(wd + 32 * ks + 8 * g + 4);
                u32x4 o;
                o[0] = cvtpk_bf16(__uint_as_float(raw[0] << 16) * wa[0], __uint_as_float(raw[0] & 0xffff0000u) * wa[1]);
                o[1] = cvtpk_bf16(__uint_as_float(raw[1] << 16) * wa[2], __uint_as_float(raw[1] & 0xffff0000u) * wa[3]);
                o[2] = cvtpk_bf16(__uint_as_float(raw[2] << 16) * wb[0], __uint_as_float(raw[2] & 0xffff0000u) * wb[1]);
                o[3] = cvtpk_bf16(__uint_as_float(raw[3] << 16) * wb[2], __uint_as_float(raw[3] & 0xffff0000u) * wb[3]);
                bfr[ks] = *reinterpret_cast<bf16x8*>(&o);
            }
            float* so = SST + ((((size_t)(d * 2 + b) * 130 + (d ? qb : qf)) * 6 + h) * 64) * 128 + 16 * w + fr;
#pragma unroll
            for (int mp = 0; mp < 4; ++mp) {
                f32x4 acc = {0.f, 0.f, 0.f, 0.f};
#pragma unroll
                for (int ks = 0; ks < 4; ++ks) {
                    const bf16x8 af = *(const bf16x8*)(XT + (hh * 64 + 16 * mp + fr) * SSD_RS + 32 * ks + 8 * g);
                    acc = __builtin_amdgcn_mfma_f32_16x16x32_bf16(af, bfr[ks], acc, 0, 0, 0);
                }
#pragma unroll
                for (int r = 0; r < 4; ++r) so[(size_t)(16 * mp + 4 * g + r) * 128] = acc[r];
            }
        }
    }
}

__device__ void ssd_scan_range(const Params& p, int thread_lin, int nthreads_total) {
    const float* SST = (const float*)(p.ws + WS_SST); const float* SDEC = (const float*)(p.ws + WS_SDEC); bf16_t* SB = (bf16_t*)(p.ws + WS_SSTB);
    for (int e = thread_lin; e < 2 * 2 * 6 * 128 * 64; e += nthreads_total) {
        const int db = e / (6 * 128 * 64), r = e % (6 * 128 * 64), h = r / (128 * 64);
        const float* sp = SST + (size_t)db * 130 * 6 * 128 * 64 + r; bf16_t* ob = SB + (size_t)db * 130 * 6 * 128 * 64 + r;
        const float* dp = SDEC + (size_t)db * 130 * 8 + h;
        float cur = 0.f;
#pragma unroll 10
        for (int q = 0; q < 130; ++q) {
            const float tmp = sp[(size_t)q * 6 * 128 * 64];
            ob[(size_t)q * 6 * 128 * 64] = f2bf(cur);
            cur = fmaf(cur, dp[q * 8], tmp);
        }
    }
}

__device__ void ssd_pass3_unit(const Params& p, int L, int unit) {
    const bf16_t* SB = (const bf16_t*)(p.ws + WS_SSTB); const bf16_t* U = (const bf16_t*)(p.ws + WS_U); bf16_t* MIX = (bf16_t*)(p.ws + WS_MIX); float* YS = (float*)(p.ws + WS_YS);
    const bf16_t* XT = (const bf16_t*)(smem + SSD_XT); const bf16_t* Bn = (const bf16_t*)(smem + SSD_B); const bf16_t* Cn = (const bf16_t*)(smem + SSD_C);
    const float* Vv = (const float*)(smem + SSD_V);
    int b, row0, qf, qb; ssd_unit_rows(unit, b, row0, qf, qb);
    float ss = 0.f;
#pragma unroll 1
    for (int grp = 0; grp < 2; ++grp) {
        const size_t hs_f = ((((size_t)(0 * 2 + b) * 130 + qf) * 6 + grp * 3) * 64) * 128, hs_b = ((((size_t)(1 * 2 + b) * 130 + qb) * 6 + grp * 3) * 64) * 128;
        u32x4 es[4];
#define SSD_ES_LOAD(hh_) { const int tid_ = tidx(); _Pragma("unroll") for (int i_ = 0; i_ < 4; ++i_) { const int idx_ = tid_ + 512 * i_, rem_ = idx_ & 1023; \
            es[i_] = *(const u32x4*)(SB + ((idx_ >> 10) ? hs_b : hs_f) + (size_t)(hh_) * 64 * 128 + (rem_ >> 4) * 128 + (rem_ & 15) * 8); } }
        SSD_ES_LOAD(0)
        QREP(10) {
        __syncthreads();
        ssd_stage<3>(p, L, row0, grp);
        }
        const int tid = tidx(), lane = tid & 63, w = tid >> 6, fr = lane & 15, g = lane >> 4;
        const int t = 16 * w + fr;
        const int row = row0 + t;
        bf16x8 cf[4];
#pragma unroll
        for (int ks = 0; ks < 4; ++ks) cf[ks] = *(const bf16x8*)(Cn + t * SSD_RS + 32 * ks + 8 * g);
        f32x4 gt[8];
#pragma unroll
        for (int mt = 0; mt < 8; ++mt) { f32x4 a = {0.f, 0.f, 0.f, 0.f};
#pragma unroll
            for (int ks = 0; ks < 4; ++ks) { const bf16x8 af = *(const bf16x8*)(Bn + (16 * mt + fr) * SSD_RS + 32 * ks + 8 * g);
                a = __builtin_amdgcn_mfma_f32_16x16x32_bf16(af, cf[ks], a, 0, 0, 0); }
            gt[mt] = a; }
        bf16_t* HS = (bf16_t*)(smem + SSD_B);
        const float ss_in = ss;
        { ss = ss_in;
#pragma unroll 1
        for (int hh = 0; hh < 3; ++hh) {
            const int h = grp * 3 + hh;
            const float* dt0 = Vv + (0 * 3 + hh) * 128; const float* dt1 = Vv + (1 * 3 + hh) * 128;
            const float* Av = Vv + (2 * 3 + hh) * 128; const float* Rv = Vv + (3 * 3 + hh) * 128;
            const float tA = Av[t], tR = Rv[t];
            __syncthreads();
            { const int tid_ = tidx();
#pragma unroll
              for (int i_ = 0; i_ < 4; ++i_) { const int idx_ = tid_ + 512 * i_, rem_ = idx_ & 1023; *(u32x4*)(HS + ((idx_ >> 10) * 64 + (rem_ >> 4)) * SSD_RS + (rem_ & 15) * 8) = es[i_]; } }
            __syncthreads();
            if (hh < 2) SSD_ES_LOAD(hh + 1)
            u32x2 zq[4];
#pragma unroll
            for (int mp = 0; mp < 4; ++mp) zq[mp] = *(const u32x2*)(U + (size_t)row * UW + U_Z + h * 64 + 16 * mp + 4 * g);
            bf16x8 wf[4];
#pragma unroll
            for (int ks = 0; ks < 4; ++ks) { u32x4 o;
#pragma unroll
                for (int half = 0; half < 2; ++half) { const int mt = 2 * ks + half, s0 = 16 * mt + 4 * g;
                    const f32x4 sA = *(const f32x4*)(Av + s0), sR = *(const f32x4*)(Rv + s0), d0 = *(const f32x4*)(dt0 + s0), d1 = *(const f32x4*)(dt1 + s0);
                    float wv[4];
#pragma unroll
                    for (int r = 0; r < 4; ++r) { const int s = s0 + r;
                        const float ef = __expf(s < t ? tA - sA[r] : tR - sR[r]);
                        const float m = s < t ? d0[r] * ef : (s > t ? d1[r] * ef : d0[r] + d1[r]);
                        wv[r] = gt[mt][r] * m; }
                    o[half * 2 + 0] = cvtpk_bf16(wv[0], wv[1]); o[half * 2 + 1] = cvtpk_bf16(wv[2], wv[3]); }
                wf[ks] = *reinterpret_cast<bf16x8*>(&o); }
            const float eA = __expf(tA), eR = __expf(tR);
            const float dsk = p.ssd_d[L * 6 + h];
#pragma unroll 1
            for (int mp = 0; mp < 4; ++mp) {
                bf16x8 hc[8];
                { const bf16_t* hl = HS + (16 * mp + fr) * SSD_RS + 8 * g;
#pragma unroll
                  for (int ks = 0; ks < 4; ++ks) { hc[2 * ks] = *(const bf16x8*)(hl + 32 * ks); hc[2 * ks + 1] = *(const bf16x8*)(hl + 64 * SSD_RS + 32 * ks); } }
                f32x4 acc = {0.f, 0.f, 0.f, 0.f};
                const bf16_t* xr = XT + (hh * 64 + 16 * mp + fr) * SSD_RS;
#pragma unroll
                for (int ks = 0; ks < 4; ++ks) {
                    const u32x2 lo = *(const u32x2*)(xr + 32 * ks + 4 * g), hi = *(const u32x2*)(xr + 32 * ks + 16 + 4 * g);
                    u32x4 aw = {lo[0], lo[1], hi[0], hi[1]};
                    acc = __builtin_amdgcn_mfma_f32_16x16x32_bf16(*reinterpret_cast<bf16x8*>(&aw), wf[ks], acc, 0, 0, 0); }
                f32x4 zf = {0.f, 0.f, 0.f, 0.f}, zb = {0.f, 0.f, 0.f, 0.f};
#pragma unroll
                for (int ks = 0; ks < 4; ++ks) {
                    zf = __builtin_amdgcn_mfma_f32_16x16x32_bf16(hc[2 * ks], cf[ks], zf, 0, 0, 0);
                    zb = __builtin_amdgcn_mfma_f32_16x16x32_bf16(hc[2 * ks + 1], cf[ks], zb, 0, 0, 0); }
                const int c = h * 64 + 16 * mp + 4 * g;
                const u32x2 zz = mp == 0 ? zq[0] : (mp == 1 ? zq[1] : (mp == 2 ? zq[2] : zq[3]));
                const float zg[4] = {__uint_as_float(zz[0] << 16), __uint_as_float(zz[0] & 0xffff0000u), __uint_as_float(zz[1] << 16), __uint_as_float(zz[1] & 0xffff0000u)};
#pragma unroll
                for (int r = 0; r < 4; ++r) { float v = acc[r] + eA * zf[r] + eR * zb[r] + dsk * bf2f(XT[(hh * 64 + 16 * mp + 4 * g + r) * SSD_RS + t]);
                    v *= silu_f(zg[r]); ss += v * v; acc[r] = v; }
                *(f32x4*)(YS + (size_t)row * 384 + c) = acc;
            }
        }
        }
    }
    {
        const int tid = tidx(), lane = tid & 63, w = tid >> 6, fr = lane & 15, g = lane >> 4;
        const int row = row0 + 16 * w + fr;
        ss += __int_as_float(__builtin_amdgcn_ds_swizzle(__float_as_int(ss), 0x401F));
        { auto rr = __builtin_amdgcn_permlane32_swap(__float_as_uint(ss), __float_as_uint(ss), false, false); ss = __uint_as_float(rr[0]) + __uint_as_float(rr[1]); }
        const float rs = rsqrtf(ss * (1.f / 384.f) + NORM_EPS);
        const float* nw = p.ssd_norm_w + L * 384;
#pragma unroll 12
        for (int i = 0; i < 24; ++i) { const int c = (i >> 2) * 64 + 16 * (i & 3) + 4 * g; const f32x4 wv = *(const f32x4*)(nw + c); const f32x4 v = *(const f32x4*)(YS + (size_t)row * 384 + c);
            u32x2 o; o[0] = cvtpk_bf16(v[0] * rs * wv[0], v[1] * rs * wv[1]); o[1] = cvtpk_bf16(v[2] * rs * wv[2], v[3] * rs * wv[3]);
            *(u32x2*)(MIX + (size_t)row * 1024 + c) = o; }
    }
}
constexpr size_t WS_RWPW = WS_RWP + (size_t)NTOK * 9 * 256 * 2;
constexpr int RW_UNITS_PREP = NTOK / 16;
__device__ __forceinline__ int rw_perm(int c) { return (c & ~63) | ((c & 15) << 2) | ((c >> 4) & 3); }
constexpr int RW_UCS = 1160;
__device__ void rwkv_prep_unit(const Params& p, int L, int unit) {
    unsigned char* ws = p.ws;
    const bf16_t* U = (const bf16_t*)(ws + WS_U); bf16_t* RWPH = (bf16_t*)(ws + WS_RWP); float* RWPW = (float*)(ws + WS_RWPW);
    const bf16_t* WL = (const bf16_t*)(ws + WS_WLORA) + (size_t)L * 98304;
    float* UC = (float*)smem;
    const int tid = tidx(), lane = tid & 63, w = tid >> 6, fr = lane & 15, g = lane >> 4;
    const int row0 = unit * 16;
    int sbase, spos0, slen; row_seq(row0, sbase, spos0, slen);
    {
        const int c2 = tid * 2;
        const float* sw = p.rwkv_shift_w + (size_t)L * 3 * 1152 + c2;
        const float w00 = sw[0], w01 = sw[1], w10 = sw[1152], w11 = sw[1153], w20 = sw[2304], w21 = sw[2305];
        unsigned xr[18];
#pragma unroll
        for (int j = 0; j < 18; ++j) { const int ps = spos0 - 1 + j; xr[j] = (ps >= 0 && ps < slen) ? *(const unsigned*)(U + (size_t)(row0 - 1 + j) * UW + U_RW + c2) : 0u; }
        const int c2b = 1024 + (tid & 63) * 2, rb = 2 * (tid >> 6);
        const float* swb = p.rwkv_shift_w + (size_t)L * 3 * 1152 + c2b;
        const float v00 = swb[0], v01 = swb[1], v10 = swb[1152], v11 = swb[1153], v20 = swb[2304], v21 = swb[2305];
        unsigned yr[4];
#pragma unroll
        for (int j = 0; j < 4; ++j) { const int ps = spos0 + rb - 1 + j; yr[j] = (ps >= 0 && ps < slen) ? *(const unsigned*)(U + (size_t)(row0 + rb - 1 + j) * UW + U_RW + c2b) : 0u; }
#pragma unroll
        for (int i = 0; i < 16; ++i) {
            float o0 = w00 * __uint_as_float(xr[i] << 16) + w10 * __uint_as_float(xr[i + 1] << 16) + w20 * __uint_as_float(xr[i + 2] << 16);
            float o1 = w01 * __uint_as_float(xr[i] & 0xffff0000u) + w11 * __uint_as_float(xr[i + 1] & 0xffff0000u) + w21 * __uint_as_float(xr[i + 2] & 0xffff0000u);
            if (c2 >= 768 && c2 < 896) { o0 = tanh_f(o0); o1 = tanh_f(o1); }
            UC[i * RW_UCS + c2] = o0; UC[i * RW_UCS + c2 + 1] = o1;
        }
#pragma unroll
        for (int i = 0; i < 2; ++i) {
            const float o0 = v00 * __uint_as_float(yr[i] << 16) + v10 * __uint_as_float(yr[i + 1] << 16) + v20 * __uint_as_float(yr[i + 2] << 16);
            const float o1 = v01 * __uint_as_float(yr[i] & 0xffff0000u) + v11 * __uint_as_float(yr[i + 1] & 0xffff0000u) + v21 * __uint_as_float(yr[i + 2] & 0xffff0000u);
            UC[(rb + i) * RW_UCS + c2b] = sigmoid_f(o0); UC[(rb + i) * RW_UCS + c2b + 1] = sigmoid_f(o1);
        }
    }
    __syncthreads();
    const int h = w & 3, half = w >> 2;
    f32x4 aw[2][4], aa[2][4], ag[4];
#pragma unroll
    for (int nt = 0; nt < 4; ++nt) { ag[nt] = (f32x4){0.f, 0.f, 0.f, 0.f};
#pragma unroll
        for (int d = 0; d < 2; ++d) { aw[d][nt] = (f32x4){0.f, 0.f, 0.f, 0.f}; aa[d][nt] = (f32x4){0.f, 0.f, 0.f, 0.f}; } }
    {
        const float* ur = UC + fr * RW_UCS + 8 * g;
        const bf16_t* wb = WL + (size_t)(h * 64 + fr) * 64 + 8 * g;
        const bf16_t* gb = WL + 65536 + (size_t)(h * 64 + fr) * 128 + 8 * g;
#pragma unroll
        for (int d = 0; d < 2; ++d)
#pragma unroll
            for (int ks = 0; ks < 2; ++ks) {
                const f32x4 x0 = *(const f32x4*)(ur + 768 + d * 64 + 32 * ks), x1 = *(const f32x4*)(ur + 768 + d * 64 + 32 * ks + 4);
                const f32x4 y0 = *(const f32x4*)(ur + 896 + d * 64 + 32 * ks), y1 = *(const f32x4*)(ur + 896 + d * 64 + 32 * ks + 4);
                u32x4 xw = {cvtpk_bf16(x0[0], x0[1]), cvtpk_bf16(x0[2], x0[3]), cvtpk_bf16(x1[0], x1[1]), cvtpk_bf16(x1[2], x1[3])};
                u32x4 yw = {cvtpk_bf16(y0[0], y0[1]), cvtpk_bf16(y0[2], y0[3]), cvtpk_bf16(y1[0], y1[1]), cvtpk_bf16(y1[2], y1[3])};
#pragma unroll
                for (int nt = 0; nt < 4; ++nt) {
                    const bf16x8 bw = *(const bf16x8*)(wb + d * 16384 + nt * 1024 + ks * 32), ba = *(const bf16x8*)(wb + 32768 + d * 16384 + nt * 1024 + ks * 32);
                    aw[d][nt] = __builtin_amdgcn_mfma_f32_16x16x32_bf16(*reinterpret_cast<bf16x8*>(&xw), bw, aw[d][nt], 0, 0, 0);
                    aa[d][nt] = __builtin_amdgcn_mfma_f32_16x16x32_bf16(*reinterpret_cast<bf16x8*>(&yw), ba, aa[d][nt], 0, 0, 0); }
            }
#pragma unroll
        for (int ks = 0; ks < 4; ++ks) {
            const f32x4 x0 = *(const f32x4*)(ur + 1024 + 32 * ks), x1 = *(const f32x4*)(ur + 1024 + 32 * ks + 4);
            u32x4 xw = {cvtpk_bf16(x0[0], x0[1]), cvtpk_bf16(x0[2], x0[3]), cvtpk_bf16(x1[0], x1[1]), cvtpk_bf16(x1[2], x1[3])};
#pragma unroll
            for (int nt = 0; nt < 4; ++nt) { const bf16x8 bg = *(const bf16x8*)(gb + nt * 2048 + ks * 32);
                ag[nt] = __builtin_amdgcn_mfma_f32_16x16x32_bf16(*reinterpret_cast<bf16x8*>(&xw), bg, ag[nt], 0, 0, 0); }
        }
    }
    float w0a[4], w0b[4], a0a[4], a0b[4], kkw[4], kaw[4], rkw[4];
#pragma unroll
    for (int nt = 0; nt < 4; ++nt) { const int c = h * 64 + 16 * nt + fr;
        w0a[nt] = p.rwkv_w0[(L * 2 + 0) * 256 + c]; w0b[nt] = p.rwkv_w0[(L * 2 + 1) * 256 + c];
        a0a[nt] = p.rwkv_a0[(L * 2 + 0) * 256 + c]; a0b[nt] = p.rwkv_a0[(L * 2 + 1) * 256 + c];
        kkw[nt] = p.rwkv_k_k[L * 256 + c]; kaw[nt] = p.rwkv_k_a[L * 256 + c]; rkw[nt] = p.rwkv_r_k[L * 256 + c]; }
#pragma unroll
    for (int rr = 0; rr < 2; ++rr) {
        const int reg = 2 * half + rr, t = 4 * g + reg;
        const float* uc = UC + t * RW_UCS + h * 64 + fr;
        float r[4], k[4], v[4], kr[4], as0[4], as1[4], kd0[4], kd1[4];
        float ss = 0.f, bs = 0.f;
#pragma unroll
        for (int nt = 0; nt < 4; ++nt) {
            r[nt] = uc[16 * nt]; k[nt] = uc[256 + 16 * nt]; v[nt] = uc[512 + 16 * nt];
            as0[nt] = sigmoid_f(a0a[nt] + aa[0][nt][reg]); as1[nt] = sigmoid_f(a0b[nt] + aa[1][nt][reg]);
            kr[nt] = k[nt] * kkw[nt]; ss += kr[nt] * kr[nt];
            kd0[nt] = k[nt] * (1.f + (as0[nt] - 1.f) * kaw[nt]); kd1[nt] = k[nt] * (1.f + (as1[nt] - 1.f) * kaw[nt]);
            bs += r[nt] * (kd0[nt] + kd1[nt]) * rkw[nt]; }
        ss = row16_sum(ss); bs = row16_sum(bs);
        const float rn = 1.f / fmaxf(__builtin_amdgcn_sqrtf(ss), 1e-12f);
        bf16_t* orow = RWPH + (size_t)(row0 + t) * 9 * 256;
        bf16_t* op = orow + h * 64 + fr * 4;
        float* opw = RWPW + (size_t)(row0 + t) * 512 + h * 64 + fr * 4;
#define RW_ST4(F, a0_, a1_, a2_, a3_) { u32x2 o_ = {cvtpk_bf16(a0_, a1_), cvtpk_bf16(a2_, a3_)}; *(u32x2*)(op + (F) * 256) = o_; }
        RW_ST4(0, r[0], r[1], r[2], r[3])
        float kn[4];
#pragma unroll
        for (int nt = 0; nt < 4; ++nt) kn[nt] = kr[nt] * rn;
        RW_ST4(2, kn[0], kn[1], kn[2], kn[3])
        RW_ST4(7, kn[0] * as0[0], kn[1] * as0[1], kn[2] * as0[2], kn[3] * as0[3])
        RW_ST4(8, kn[0] * as1[0], kn[1] * as1[1], kn[2] * as1[2], kn[3] * as1[3])
        f32x4 q;
#pragma unroll
        for (int nt = 0; nt < 4; ++nt) { const float wl0 = -softplus_f(-(w0a[nt] + aw[0][nt][reg])) - 0.5f; q[nt] = __expf(-__expf(wl0)); }
        *(f32x4*)(opw + 0 * 256) = q;
#pragma unroll
        for (int nt = 0; nt < 4; ++nt) { const float wl1 = -softplus_f(-(w0b[nt] + aw[1][nt][reg])) - 0.5f; q[nt] = __expf(-__expf(wl1)); }
        *(f32x4*)(opw + 1 * 256) = q;
        RW_ST4(5, kd0[0], kd0[1], kd0[2], kd0[3])
        RW_ST4(6, kd1[0], kd1[1], kd1[2], kd1[3])
#pragma unroll
        for (int nt = 0; nt < 4; ++nt) { bf16_t* o = orow + h * 64 + 16 * nt + fr; o[1 * 256] = f2bf(v[nt]); o[3 * 256] = f2bf(bs * v[nt]); o[4 * 256] = f2bf(ag[nt][reg]); }
    }
}

__device__ __forceinline__ int rw_chunk_row0(int d, int b, int q) {
    if (d == 0) return q < 4 ? NLAT + b * CTXL + q * 64 : b * SEQ + (q - 4) * 64;
    return q < 4 ? NLAT + b * CTXL + (3 - q) * 64 : b * SEQ + (255 - (q - 4)) * 64;
}
constexpr int RW_UNITS = 2 * 2 * 260;

#define RW_FMAC(acc, vec, n, x) asm("v_fmac_f32_dpp %0, %1, %2 row_newbcast:" #n " row_mask:0xf bank_mask:0xf" : "+v"(acc) : "v"(vec), "v"(x))
#define RW_MUL(d, vec, n, x) asm("v_mul_f32_dpp %0, %1, %2 row_newbcast:" #n " row_mask:0xf bank_mask:0xf" : "=v"(d) : "v"(vec), "v"(x))
#define RW_HAZ() asm volatile("s_nop 1" ::: "memory")

#if !RW_UT
__device__ void rwkv_passA_unit(const Params& p, int unit) {
    const float* RWP = (const float*)(p.ws + WS_RWP); float* RPQ = (float*)(p.ws + WS_RPQ); float* RY = (float*)(p.ws + WS_RY);
    const int lane = tidx() & 63, wid = wave_id(), h = wid & 3, kind = wid >> 2;
    const int d = unit / 520, b = (unit / 260) & 1, q = unit % 260;
    const int row0 = rw_chunk_row0(d, b, q);
    float s[64];
#pragma unroll
    for (int k = 0; k < 64; ++k) s[k] = (kind == 0 && k == lane) ? 1.f : 0.f;
    const int rstep = d ? -1 : 1; int row = d ? row0 + 63 : row0;
    const float* lb = RWP + h * 64 + (lane & 15) * 4;
    const size_t cs = ((size_t)(d * 2 + b) * 260 + q) * 4 + h;
    float* yo = RY + (cs * 2 + kind) * 4096 + lane;
    f32x4 wv = *(const f32x4*)(lb + ((size_t)row * 11 + 5 + d) * 256), av = *(const f32x4*)(lb + ((size_t)row * 11 + 2) * 256);
    f32x4 bv = *(const f32x4*)(lb + ((size_t)row * 11 + 9 + d) * 256), kv = *(const f32x4*)(lb + ((size_t)row * 11 + 7 + d) * 256);
    f32x4 rv = *(const f32x4*)(lb + ((size_t)row * 11 + 0) * 256);
    float vv = kind ? RWP[((size_t)row * 11 + 1) * 256 + h * 64 + lane] : 0.f;
    if (kind) {
#pragma unroll 1
        for (int i = 0; i < 64; ++i) {
            row += rstep; const int rn = i < 63 ? row : row - rstep;
            const f32x4 wn = *(const f32x4*)(lb + ((size_t)rn * 11 + 5 + d) * 256), an = *(const f32x4*)(lb + ((size_t)rn * 11 + 2) * 256);
            const f32x4 bn = *(const f32x4*)(lb + ((size_t)rn * 11 + 9 + d) * 256), kn = *(const f32x4*)(lb + ((size_t)rn * 11 + 7 + d) * 256);
            const f32x4 rnv = *(const f32x4*)(lb + ((size_t)rn * 11 + 0) * 256);
            const float vn = RWP[((size_t)rn * 11 + 1) * 256 + h * 64 + lane];
            float sa0 = 0.f, sa1 = 0.f, sa2 = 0.f, sa3 = 0.f, sa4 = 0.f, sa5 = 0.f, sa6 = 0.f, sa7 = 0.f;
            RW_HAZ();
            { const float a_ = av[0]; RW_FMAC(sa0, a_, 0, s[0]); }
            { const float a_ = av[0]; RW_FMAC(sa1, a_, 1, s[1]); }
            { const float a_ = av[0]; RW_FMAC(sa2, a_, 2, s[2]); }
            { const float a_ = av[0]; RW_FMAC(sa3, a_, 3, s[3]); }
            { const float a_ = av[0]; RW_FMAC(sa4, a_, 4, s[4]); }
            { const float a_ = av[0]; RW_FMAC(sa5, a_, 5, s[5]); }
            { const float a_ = av[0]; RW_FMAC(sa6, a_, 6, s[6]); }
            { const float a_ = av[0]; RW_FMAC(sa7, a_, 7, s[7]); }
            { const float a_ = av[0]; RW_FMAC(sa0, a_, 8, s[8]); }
            { const float a_ = av[0]; RW_FMAC(sa1, a_, 9, s[9]); }
            { const float a_ = av[0]; RW_FMAC(sa2, a_, 10, s[10]); }
            { const float a_ = av[0]; RW_FMAC(sa3, a_, 11, s[11]); }
            { const float a_ = av[0]; RW_FMAC(sa4, a_, 12, s[12]); }
            { const float a_ = av[0]; RW_FMAC(sa5, a_, 13, s[13]); }
            { const float a_ = av[0]; RW_FMAC(sa6, a_, 14, s[14]); }
            { const float a_ = av[0]; RW_FMAC(sa7, a_, 15, s[15]); }
            { const float a_ = av[1]; RW_FMAC(sa0, a_, 0, s[16]); }
            { const float a_ = av[1]; RW_FMAC(sa1, a_, 1, s[17]); }
            { const float a_ = av[1]; RW_FMAC(sa2, a_, 2, s[18]); }
            { const float a_ = av[1]; RW_FMAC(sa3, a_, 3, s[19]); }
            { const float a_ = av[1]; RW_FMAC(sa4, a_, 4, s[20]); }
            { const float a_ = av[1]; RW_FMAC(sa5, a_, 5, s[21]); }
            { const float a_ = av[1]; RW_FMAC(sa6, a_, 6, s[22]); }
            { const float a_ = av[1]; RW_FMAC(sa7, a_, 7, s[23]); }
            { const float a_ = av[1]; RW_FMAC(sa0, a_, 8, s[24]); }
            { const float a_ = av[1]; RW_FMAC(sa1, a_, 9, s[25]); }
            { const float a_ = av[1]; RW_FMAC(sa2, a_, 10, s[26]); }
            { const float a_ = av[1]; RW_FMAC(sa3, a_, 11, s[27]); }
            { const float a_ = av[1]; RW_FMAC(sa4, a_, 12, s[28]); }
            { const float a_ = av[1]; RW_FMAC(sa5, a_, 13, s[29]); }
            { const float a_ = av[1]; RW_FMAC(sa6, a_, 14, s[30]); }
            { const float a_ = av[1]; RW_FMAC(sa7, a_, 15, s[31]); }
            { const float a_ = av[2]; RW_FMAC(sa0, a_, 0, s[32]); }
            { const float a_ = av[2]; RW_FMAC(sa1, a_, 1, s[33]); }
            { const float a_ = av[2]; RW_FMAC(sa2, a_, 2, s[34]); }
            { const float a_ = av[2]; RW_FMAC(sa3, a_, 3, s[35]); }
            { const float a_ = av[2]; RW_FMAC(sa4, a_, 4, s[36]); }
            { const float a_ = av[2]; RW_FMAC(sa5, a_, 5, s[37]); }
            { const float a_ = av[2]; RW_FMAC(sa6, a_, 6, s[38]); }
            { const float a_ = av[2]; RW_FMAC(sa7, a_, 7, s[39]); }
            { const float a_ = av[2]; RW_FMAC(sa0, a_, 8, s[40]); }
            { const float a_ = av[2]; RW_FMAC(sa1, a_, 9, s[41]); }
            { const float a_ = av[2]; RW_FMAC(sa2, a_, 10, s[42]); }
            { const float a_ = av[2]; RW_FMAC(sa3, a_, 11, s[43]); }
            { const float a_ = av[2]; RW_FMAC(sa4, a_, 12, s[44]); }
            { const float a_ = av[2]; RW_FMAC(sa5, a_, 13, s[45]); }
            { const float a_ = av[2]; RW_FMAC(sa6, a_, 14, s[46]); }
            { const float a_ = av[2]; RW_FMAC(sa7, a_, 15, s[47]); }
            { const float a_ = av[3]; RW_FMAC(sa0, a_, 0, s[48]); }
            { const float a_ = av[3]; RW_FMAC(sa1, a_, 1, s[49]); }
            { const float a_ = av[3]; RW_FMAC(sa2, a_, 2, s[50]); }
            { const float a_ = av[3]; RW_FMAC(sa3, a_, 3, s[51]); }
            { const float a_ = av[3]; RW_FMAC(sa4, a_, 4, s[52]); }
            { const float a_ = av[3]; RW_FMAC(sa5, a_, 5, s[53]); }
            { const float a_ = av[3]; RW_FMAC(sa6, a_, 6, s[54]); }
            { const float a_ = av[3]; RW_FMAC(sa7, a_, 7, s[55]); }
            { const float a_ = av[3]; RW_FMAC(sa0, a_, 8, s[56]); }
            { const float a_ = av[3]; RW_FMAC(sa1, a_, 9, s[57]); }
            { const float a_ = av[3]; RW_FMAC(sa2, a_, 10, s[58]); }
            { const float a_ = av[3]; RW_FMAC(sa3, a_, 11, s[59]); }
            { const float a_ = av[3]; RW_FMAC(sa4, a_, 12, s[60]); }
            { const float a_ = av[3]; RW_FMAC(sa5, a_, 13, s[61]); }
            { const float a_ = av[3]; RW_FMAC(sa6, a_, 14, s[62]); }
            { const float a_ = av[3]; RW_FMAC(sa7, a_, 15, s[63]); }
            const float sa = -(((sa0 + sa1) + (sa2 + sa3)) + ((sa4 + sa5) + (sa6 + sa7)));
            { const float w_ = wv[0]; float t_; RW_MUL(t_, w_, 0, s[0]); s[0] = t_; }
            { const float w_ = wv[0]; float t_; RW_MUL(t_, w_, 1, s[1]); s[1] = t_; }
            { const float w_ = wv[0]; float t_; RW_MUL(t_, w_, 2, s[2]); s[2] = t_; }
            { const float w_ = wv[0]; float t_; RW_MUL(t_, w_, 3, s[3]); s[3] = t_; }
            { const float w_ = wv[0]; float t_; RW_MUL(t_, w_, 4, s[4]); s[4] = t_; }
            { const float w_ = wv[0]; float t_; RW_MUL(t_, w_, 5, s[5]); s[5] = t_; }
            { const float w_ = wv[0]; float t_; RW_MUL(t_, w_, 6, s[6]); s[6] = t_; }
            { const float w_ = wv[0]; float t_; RW_MUL(t_, w_, 7, s[7]); s[7] = t_; }
            { const float w_ = wv[0]; float t_; RW_MUL(t_, w_, 8, s[8]); s[8] = t_; }
            { const float w_ = wv[0]; float t_; RW_MUL(t_, w_, 9, s[9]); s[9] = t_; }
            { const float w_ = wv[0]; float t_; RW_MUL(t_, w_, 10, s[10]); s[10] = t_; }
            { const float w_ = wv[0]; float t_; RW_MUL(t_, w_, 11, s[11]); s[11] = t_; }
            { const float w_ = wv[0]; float t_; RW_MUL(t_, w_, 12, s[12]); s[12] = t_; }
            { const float w_ = wv[0]; float t_; RW_MUL(t_, w_, 13, s[13]); s[13] = t_; }
            { const float w_ = wv[0]; float t_; RW_MUL(t_, w_, 14, s[14]); s[14] = t_; }
            { const float w_ = wv[0]; float t_; RW_MUL(t_, w_, 15, s[15]); s[15] = t_; }
            { const float w_ = wv[1]; float t_; RW_MUL(t_, w_, 0, s[16]); s[16] = t_; }
            { const float w_ = wv[1]; float t_; RW_MUL(t_, w_, 1, s[17]); s[17] = t_; }
            { const float w_ = wv[1]; float t_; RW_MUL(t_, w_, 2, s[18]); s[18] = t_; }
            { const float w_ = wv[1]; float t_; RW_MUL(t_, w_, 3, s[19]); s[19] = t_; }
            { const float w_ = wv[1]; float t_; RW_MUL(t_, w_, 4, s[20]); s[20] = t_; }
            { const float w_ = wv[1]; float t_; RW_MUL(t_, w_, 5, s[21]); s[21] = t_; }
            { const float w_ = wv[1]; float t_; RW_MUL(t_, w_, 6, s[22]); s[22] = t_; }
            { const float w_ = wv[1]; float t_; RW_MUL(t_, w_, 7, s[23]); s[23] = t_; }
            { const float w_ = wv[1]; float t_; RW_MUL(t_, w_, 8, s[24]); s[24] = t_; }
            { const float w_ = wv[1]; float t_; RW_MUL(t_, w_, 9, s[25]); s[25] = t_; }
            { const float w_ = wv[1]; float t_; RW_MUL(t_, w_, 10, s[26]); s[26] = t_; }
            { const float w_ = wv[1]; float t_; RW_MUL(t_, w_, 11, s[27]); s[27] = t_; }
            { const float w_ = wv[1]; float t_; RW_MUL(t_, w_, 12, s[28]); s[28] = t_; }
            { const float w_ = wv[1]; float t_; RW_MUL(t_, w_, 13, s[29]); s[29] = t_; }
            { const float w_ = wv[1]; float t_; RW_MUL(t_, w_, 14, s[30]); s[30] = t_; }
            { const float w_ = wv[1]; float t_; RW_MUL(t_, w_, 15, s[31]); s[31] = t_; }
            { const float w_ = wv[2]; float t_; RW_MUL(t_, w_, 0, s[32]); s[32] = t_; }
            { const float w_ = wv[2]; float t_; RW_MUL(t_, w_, 1, s[33]); s[33] = t_; }
            { const float w_ = wv[2]; float t_; RW_MUL(t_, w_, 2, s[34]); s[34] = t_; }
            { const float w_ = wv[2]; float t_; RW_MUL(t_, w_, 3, s[35]); s[35] = t_; }
            { const float w_ = wv[2]; float t_; RW_MUL(t_, w_, 4, s[36]); s[36] = t_; }
            { const float w_ = wv[2]; float t_; RW_MUL(t_, w_, 5, s[37]); s[37] = t_; }
            { const float w_ = wv[2]; float t_; RW_MUL(t_, w_, 6, s[38]); s[38] = t_; }
            { const float w_ = wv[2]; float t_; RW_MUL(t_, w_, 7, s[39]); s[39] = t_; }
            { const float w_ = wv[2]; float t_; RW_MUL(t_, w_, 8, s[40]); s[40] = t_; }
            { const float w_ = wv[2]; float t_; RW_MUL(t_, w_, 9, s[41]); s[41] = t_; }
            { const float w_ = wv[2]; float t_; RW_MUL(t_, w_, 10, s[42]); s[42] = t_; }
            { const float w_ = wv[2]; float t_; RW_MUL(t_, w_, 11, s[43]); s[43] = t_; }
            { const float w_ = wv[2]; float t_; RW_MUL(t_, w_, 12, s[44]); s[44] = t_; }
            { const float w_ = wv[2]; float t_; RW_MUL(t_, w_, 13, s[45]); s[45] = t_; }
            { const float w_ = wv[2]; float t_; RW_MUL(t_, w_, 14, s[46]); s[46] = t_; }
            { const float w_ = wv[2]; float t_; RW_MUL(t_, w_, 15, s[47]); s[47] = t_; }
            { const float w_ = wv[3]; float t_; RW_MUL(t_, w_, 0, s[48]); s[48] = t_; }
            { const float w_ = wv[3]; float t_; RW_MUL(t_, w_, 1, s[49]); s[49] = t_; }
            { const float w_ = wv[3]; float t_; RW_MUL(t_, w_, 2, s[50]); s[50] = t_; }
            { const float w_ = wv[3]; float t_; RW_MUL(t_, w_, 3, s[51]); s[51] = t_; }
            { const float w_ = wv[3]; float t_; RW_MUL(t_, w_, 4, s[52]); s[52] = t_; }
            { const float w_ = wv[3]; float t_; RW_MUL(t_, w_, 5, s[53]); s[53] = t_; }
            { const float w_ = wv[3]; float t_; RW_MUL(t_, w_, 6, s[54]); s[54] = t_; }
            { const float w_ = wv[3]; float t_; RW_MUL(t_, w_, 7, s[55]); s[55] = t_; }
            { const float w_ = wv[3]; float t_; RW_MUL(t_, w_, 8, s[56]); s[56] = t_; }
            { const float w_ = wv[3]; float t_; RW_MUL(t_, w_, 9, s[57]); s[57] = t_; }
            { const float w_ = wv[3]; float t_; RW_MUL(t_, w_, 10, s[58]); s[58] = t_; }
            { const float w_ = wv[3]; float t_; RW_MUL(t_, w_, 11, s[59]); s[59] = t_; }
            { const float w_ = wv[3]; float t_; RW_MUL(t_, w_, 12, s[60]); s[60] = t_; }
            { const float w_ = wv[3]; float t_; RW_MUL(t_, w_, 13, s[61]); s[61] = t_; }
            { const float w_ = wv[3]; float t_; RW_MUL(t_, w_, 14, s[62]); s[62] = t_; }
            { const float w_ = wv[3]; float t_; RW_MUL(t_, w_, 15, s[63]); s[63] = t_; }
            { const float b_ = bv[0]; RW_FMAC(s[0], b_, 0, sa); }
            { const float b_ = bv[0]; RW_FMAC(s[1], b_, 1, sa); }
            { const float b_ = bv[0]; RW_FMAC(s[2], b_, 2, sa); }
            { const float b_ = bv[0]; RW_FMAC(s[3], b_, 3, sa); }
            { const float b_ = bv[0]; RW_FMAC(s[4], b_, 4, sa); }
            { const float b_ = bv[0]; RW_FMAC(s[5], b_, 5, sa); }
            { const float b_ = bv[0]; RW_FMAC(s[6], b_, 6, sa); }
            { const float b_ = bv[0]; RW_FMAC(s[7], b_, 7, sa); }
            { const float b_ = bv[0]; RW_FMAC(s[8], b_, 8, sa); }
            { const float b_ = bv[0]; RW_FMAC(s[9], b_, 9, sa); }
            { const float b_ = bv[0]; RW_FMAC(s[10], b_, 10, sa); }
            { const float b_ = bv[0]; RW_FMAC(s[11], b_, 11, sa); }
            { const float b_ = bv[0]; RW_FMAC(s[12], b_, 12, sa); }
            { const float b_ = bv[0]; RW_FMAC(s[13], b_, 13, sa); }
            { const float b_ = bv[0]; RW_FMAC(s[14], b_, 14, sa); }
            { const float b_ = bv[0]; RW_FMAC(s[15], b_, 15, sa); }
            { const float b_ = bv[1]; RW_FMAC(s[16], b_, 0, sa); }
            { const float b_ = bv[1]; RW_FMAC(s[17], b_, 1, sa); }
            { const float b_ = bv[1]; RW_FMAC(s[18], b_, 2, sa); }
            { const float b_ = bv[1]; RW_FMAC(s[19], b_, 3, sa); }
            { const float b_ = bv[1]; RW_FMAC(s[20], b_, 4, sa); }
            { const float b_ = bv[1]; RW_FMAC(s[21], b_, 5, sa); }
            { const float b_ = bv[1]; RW_FMAC(s[22], b_, 6, sa); }
            { const float b_ = bv[1]; RW_FMAC(s[23], b_, 7, sa); }
            { const float b_ = bv[1]; RW_FMAC(s[24], b_, 8, sa); }
            { const float b_ = bv[1]; RW_FMAC(s[25], b_, 9, sa); }
            { const float b_ = bv[1]; RW_FMAC(s[26], b_, 10, sa); }
            { const float b_ = bv[1]; RW_FMAC(s[27], b_, 11, sa); }
            { const float b_ = bv[1]; RW_FMAC(s[28], b_, 12, sa); }
            { const float b_ = bv[1]; RW_FMAC(s[29], b_, 13, sa); }
            { const float b_ = bv[1]; RW_FMAC(s[30], b_, 14, sa); }
            { const float b_ = bv[1]; RW_FMAC(s[31], b_, 15, sa); }
            { const float b_ = bv[2]; RW_FMAC(s[32], b_, 0, sa); }
            { const float b_ = bv[2]; RW_FMAC(s[33], b_, 1, sa); }
            { const float b_ = bv[2]; RW_FMAC(s[34], b_, 2, sa); }
            { const float b_ = bv[2]; RW_FMAC(s[35], b_, 3, sa); }
            { const float b_ = bv[2]; RW_FMAC(s[36], b_, 4, sa); }
            { const float b_ = bv[2]; RW_FMAC(s[37], b_, 5, sa); }
            { const float b_ = bv[2]; RW_FMAC(s[38], b_, 6, sa); }
            { const float b_ = bv[2]; RW_FMAC(s[39], b_, 7, sa); }
            { const float b_ = bv[2]; RW_FMAC(s[40], b_, 8, sa); }
            { const float b_ = bv[2]; RW_FMAC(s[41], b_, 9, sa); }
            { const float b_ = bv[2]; RW_FMAC(s[42], b_, 10, sa); }
            { const float b_ = bv[2]; RW_FMAC(s[43], b_, 11, sa); }
            { const float b_ = bv[2]; RW_FMAC(s[44], b_, 12, sa); }
            { const float b_ = bv[2]; RW_FMAC(s[45], b_, 13, sa); }
            { const float b_ = bv[2]; RW_FMAC(s[46], b_, 14, sa); }
            { const float b_ = bv[2]; RW_FMAC(s[47], b_, 15, sa); }
            { const float b_ = bv[3]; RW_FMAC(s[48], b_, 0, sa); }
            { const float b_ = bv[3]; RW_FMAC(s[49], b_, 1, sa); }
            { const float b_ = bv[3]; RW_FMAC(s[50], b_, 2, sa); }
            { const float b_ = bv[3]; RW_FMAC(s[51], b_, 3, sa); }
            { const float b_ = bv[3]; RW_FMAC(s[52], b_, 4, sa); }
            { const float b_ = bv[3]; RW_FMAC(s[53], b_, 5, sa); }
            { const float b_ = bv[3]; RW_FMAC(s[54], b_, 6, sa); }
            { const float b_ = bv[3]; RW_FMAC(s[55], b_, 7, sa); }
            { const float b_ = bv[3]; RW_FMAC(s[56], b_, 8, sa); }
            { const float b_ = bv[3]; RW_FMAC(s[57], b_, 9, sa); }
            { const float b_ = bv[3]; RW_FMAC(s[58], b_, 10, sa); }
            { const float b_ = bv[3]; RW_FMAC(s[59], b_, 11, sa); }
            { const float b_ = bv[3]; RW_FMAC(s[60], b_, 12, sa); }
            { const float b_ = bv[3]; RW_FMAC(s[61], b_, 13, sa); }
            { const float b_ = bv[3]; RW_FMAC(s[62], b_, 14, sa); }
            { const float b_ = bv[3]; RW_FMAC(s[63], b_, 15, sa); }
            { const float k_ = kv[0]; RW_FMAC(s[0], k_, 0, vv); }
            { const float k_ = kv[0]; RW_FMAC(s[1], k_, 1, vv); }
            { const float k_ = kv[0]; RW_FMAC(s[2], k_, 2, vv); }
            { const float k_ = kv[0]; RW_FMAC(s[3], k_, 3, vv); }
            { const float k_ = kv[0]; RW_FMAC(s[4], k_, 4, vv); }
            { const float k_ = kv[0]; RW_FMAC(s[5], k_, 5, vv); }
            { const float k_ = kv[0]; RW_FMAC(s[6], k_, 6, vv); }
            { const float k_ = kv[0]; RW_FMAC(s[7], k_, 7, vv); }
            { const float k_ = kv[0]; RW_FMAC(s[8], k_, 8, vv); }
            { const float k_ = kv[0]; RW_FMAC(s[9], k_, 9, vv); }
            { const float k_ = kv[0]; RW_FMAC(s[10], k_, 10, vv); }
            { const float k_ = kv[0]; RW_FMAC(s[11], k_, 11, vv); }
            { const float k_ = kv[0]; RW_FMAC(s[12], k_, 12, vv); }
            { const float k_ = kv[0]; RW_FMAC(s[13], k_, 13, vv); }
            { const float k_ = kv[0]; RW_FMAC(s[14], k_, 14, vv); }
            { const float k_ = kv[0]; RW_FMAC(s[15], k_, 15, vv); }
            { const float k_ = kv[1]; RW_FMAC(s[16], k_, 0, vv); }
            { const float k_ = kv[1]; RW_FMAC(s[17], k_, 1, vv); }
            { const float k_ = kv[1]; RW_FMAC(s[18], k_, 2, vv); }
            { const float k_ = kv[1]; RW_FMAC(s[19], k_, 3, vv); }
            { const float k_ = kv[1]; RW_FMAC(s[20], k_, 4, vv); }
            { const float k_ = kv[1]; RW_FMAC(s[21], k_, 5, vv); }
            { const float k_ = kv[1]; RW_FMAC(s[22], k_, 6, vv); }
            { const float k_ = kv[1]; RW_FMAC(s[23], k_, 7, vv); }
            { const float k_ = kv[1]; RW_FMAC(s[24], k_, 8, vv); }
            { const float k_ = kv[1]; RW_FMAC(s[25], k_, 9, vv); }
            { const float k_ = kv[1]; RW_FMAC(s[26], k_, 10, vv); }
            { const float k_ = kv[1]; RW_FMAC(s[27], k_, 11, vv); }
            { const float k_ = kv[1]; RW_FMAC(s[28], k_, 12, vv); }
            { const float k_ = kv[1]; RW_FMAC(s[29], k_, 13, vv); }
            { const float k_ = kv[1]; RW_FMAC(s[30], k_, 14, vv); }
            { const float k_ = kv[1]; RW_FMAC(s[31], k_, 15, vv); }
            { const float k_ = kv[2]; RW_FMAC(s[32], k_, 0, vv); }
            { const float k_ = kv[2]; RW_FMAC(s[33], k_, 1, vv); }
            { const float k_ = kv[2]; RW_FMAC(s[34], k_, 2, vv); }
            { const float k_ = kv[2]; RW_FMAC(s[35], k_, 3, vv); }
            { const float k_ = kv[2]; RW_FMAC(s[36], k_, 4, vv); }
            { const float k_ = kv[2]; RW_FMAC(s[37], k_, 5, vv); }
            { const float k_ = kv[2]; RW_FMAC(s[38], k_, 6, vv); }
            { const float k_ = kv[2]; RW_FMAC(s[39], k_, 7, vv); }
            { const float k_ = kv[2]; RW_FMAC(s[40], k_, 8, vv); }
            { const float k_ = kv[2]; RW_FMAC(s[41], k_, 9, vv); }
            { const float k_ = kv[2]; RW_FMAC(s[42], k_, 10, vv); }
            { const float k_ = kv[2]; RW_FMAC(s[43], k_, 11, vv); }
            { const float k_ = kv[2]; RW_FMAC(s[44], k_, 12, vv); }
            { const float k_ = kv[2]; RW_FMAC(s[45], k_, 13, vv); }
            { const float k_ = kv[2]; RW_FMAC(s[46], k_, 14, vv); }
            { const float k_ = kv[2]; RW_FMAC(s[47], k_, 15, vv); }
            { const float k_ = kv[3]; RW_FMAC(s[48], k_, 0, vv); }
            { const float k_ = kv[3]; RW_FMAC(s[49], k_, 1, vv); }
            { const float k_ = kv[3]; RW_FMAC(s[50], k_, 2, vv); }
            { const float k_ = kv[3]; RW_FMAC(s[51], k_, 3, vv); }
            { const float k_ = kv[3]; RW_FMAC(s[52], k_, 4, vv); }
            { const float k_ = kv[3]; RW_FMAC(s[53], k_, 5, vv); }
            { const float k_ = kv[3]; RW_FMAC(s[54], k_, 6, vv); }
            { const float k_ = kv[3]; RW_FMAC(s[55], k_, 7, vv); }
            { const float k_ = kv[3]; RW_FMAC(s[56], k_, 8, vv); }
            { const float k_ = kv[3]; RW_FMAC(s[57], k_, 9, vv); }
            { const float k_ = kv[3]; RW_FMAC(s[58], k_, 10, vv); }
            { const float k_ = kv[3]; RW_FMAC(s[59], k_, 11, vv); }
            { const float k_ = kv[3]; RW_FMAC(s[60], k_, 12, vv); }
            { const float k_ = kv[3]; RW_FMAC(s[61], k_, 13, vv); }
            { const float k_ = kv[3]; RW_FMAC(s[62], k_, 14, vv); }
            { const float k_ = kv[3]; RW_FMAC(s[63], k_, 15, vv); }
            float y0 = 0.f, y1 = 0.f, y2 = 0.f, y3 = 0.f, y4 = 0.f, y5 = 0.f, y6 = 0.f, y7 = 0.f;
            { const float a_ = rv[0]; RW_FMAC(y0, a_, 0, s[0]); }
            { const float a_ = rv[0]; RW_FMAC(y1, a_, 1, s[1]); }
            { const float a_ = rv[0]; RW_FMAC(y2, a_, 2, s[2]); }
            { const float a_ = rv[0]; RW_FMAC(y3, a_, 3, s[3]); }
            { const float a_ = rv[0]; RW_FMAC(y4, a_, 4, s[4]); }
            { const float a_ = rv[0]; RW_FMAC(y5, a_, 5, s[5]); }
            { const float a_ = rv[0]; RW_FMAC(y6, a_, 6, s[6]); }
            { const float a_ = rv[0]; RW_FMAC(y7, a_, 7, s[7]); }
            { const float a_ = rv[0]; RW_FMAC(y0, a_, 8, s[8]); }
            { const float a_ = rv[0]; RW_FMAC(y1, a_, 9, s[9]); }
            { const float a_ = rv[0]; RW_FMAC(y2, a_, 10, s[10]); }
            { const float a_ = rv[0]; RW_FMAC(y3, a_, 11, s[11]); }
            { const float a_ = rv[0]; RW_FMAC(y4, a_, 12, s[12]); }
            { const float a_ = rv[0]; RW_FMAC(y5, a_, 13, s[13]); }
            { const float a_ = rv[0]; RW_FMAC(y6, a_, 14, s[14]); }
            { const float a_ = rv[0]; RW_FMAC(y7, a_, 15, s[15]); }
            { const float a_ = rv[1]; RW_FMAC(y0, a_, 0, s[16]); }
            { const float a_ = rv[1]; RW_FMAC(y1, a_, 1, s[17]); }
            { const float a_ = rv[1]; RW_FMAC(y2, a_, 2, s[18]); }
            { const float a_ = rv[1]; RW_FMAC(y3, a_, 3, s[19]); }
            { const float a_ = rv[1]; RW_FMAC(y4, a_, 4, s[20]); }
            { const float a_ = rv[1]; RW_FMAC(y5, a_, 5, s[21]); }
            { const float a_ = rv[1]; RW_FMAC(y6, a_, 6, s[22]); }
            { const float a_ = rv[1]; RW_FMAC(y7, a_, 7, s[23]); }
            { const float a_ = rv[1]; RW_FMAC(y0, a_, 8, s[24]); }
            { const float a_ = rv[1]; RW_FMAC(y1, a_, 9, s[25]); }
            { const float a_ = rv[1]; RW_FMAC(y2, a_, 10, s[26]); }
            { const float a_ = rv[1]; RW_FMAC(y3, a_, 11, s[27]); }
            { const float a_ = rv[1]; RW_FMAC(y4, a_, 12, s[28]); }
            { const float a_ = rv[1]; RW_FMAC(y5, a_, 13, s[29]); }
            { const float a_ = rv[1]; RW_FMAC(y6, a_, 14, s[30]); }
            { const float a_ = rv[1]; RW_FMAC(y7, a_, 15, s[31]); }
            { const float a_ = rv[2]; RW_FMAC(y0, a_, 0, s[32]); }
            { const float a_ = rv[2]; RW_FMAC(y1, a_, 1, s[33]); }
            { const float a_ = rv[2]; RW_FMAC(y2, a_, 2, s[34]); }
            { const float a_ = rv[2]; RW_FMAC(y3, a_, 3, s[35]); }
            { const float a_ = rv[2]; RW_FMAC(y4, a_, 4, s[36]); }
            { const float a_ = rv[2]; RW_FMAC(y5, a_, 5, s[37]); }
            { const float a_ = rv[2]; RW_FMAC(y6, a_, 6, s[38]); }
            { const float a_ = rv[2]; RW_FMAC(y7, a_, 7, s[39]); }
            { const float a_ = rv[2]; RW_FMAC(y0, a_, 8, s[40]); }
            { const float a_ = rv[2]; RW_FMAC(y1, a_, 9, s[41]); }
            { const float a_ = rv[2]; RW_FMAC(y2, a_, 10, s[42]); }
            { const float a_ = rv[2]; RW_FMAC(y3, a_, 11, s[43]); }
            { const float a_ = rv[2]; RW_FMAC(y4, a_, 12, s[44]); }
            { const float a_ = rv[2]; RW_FMAC(y5, a_, 13, s[45]); }
            { const float a_ = rv[2]; RW_FMAC(y6, a_, 14, s[46]); }
            { const float a_ = rv[2]; RW_FMAC(y7, a_, 15, s[47]); }
            { const float a_ = rv[3]; RW_FMAC(y0, a_, 0, s[48]); }
            { const float a_ = rv[3]; RW_FMAC(y1, a_, 1, s[49]); }
            { const float a_ = rv[3]; RW_FMAC(y2, a_, 2, s[50]); }
            { const float a_ = rv[3]; RW_FMAC(y3, a_, 3, s[51]); }
            { const float a_ = rv[3]; RW_FMAC(y4, a_, 4, s[52]); }
            { const float a_ = rv[3]; RW_FMAC(y5, a_, 5, s[53]); }
            { const float a_ = rv[3]; RW_FMAC(y6, a_, 6, s[54]); }
            { const float a_ = rv[3]; RW_FMAC(y7, a_, 7, s[55]); }
            { const float a_ = rv[3]; RW_FMAC(y0, a_, 8, s[56]); }
            { const float a_ = rv[3]; RW_FMAC(y1, a_, 9, s[57]); }
            { const float a_ = rv[3]; RW_FMAC(y2, a_, 10, s[58]); }
            { const float a_ = rv[3]; RW_FMAC(y3, a_, 11, s[59]); }
            { const float a_ = rv[3]; RW_FMAC(y4, a_, 12, s[60]); }
            { const float a_ = rv[3]; RW_FMAC(y5, a_, 13, s[61]); }
            { const float a_ = rv[3]; RW_FMAC(y6, a_, 14, s[62]); }
            { const float a_ = rv[3]; RW_FMAC(y7, a_, 15, s[63]); }
            yo[i * 64] = ((y0 + y1) + (y2 + y3)) + ((y4 + y5) + (y6 + y7));
            wv = wn; av = an; bv = bn; kv = kn; rv = rnv; vv = vn;
        }
    } else {
#pragma unroll 1
        for (int i = 0; i < 64; ++i) {
            row += rstep; const int rn = i < 63 ? row : row - rstep;
            const f32x4 wn = *(const f32x4*)(lb + ((size_t)rn * 11 + 5 + d) * 256), an = *(const f32x4*)(lb + ((size_t)rn * 11 + 2) * 256);
            const f32x4 bn = *(const f32x4*)(lb + ((size_t)rn * 11 + 9 + d) * 256), rnv = *(const f32x4*)(lb + ((size_t)rn * 11 + 0) * 256);
            float sa0 = 0.f, sa1 = 0.f, sa2 = 0.f, sa3 = 0.f, sa4 = 0.f, sa5 = 0.f, sa6 = 0.f, sa7 = 0.f;
            RW_HAZ();
            { const float a_ = av[0]; RW_FMAC(sa0, a_, 0, s[0]); }
            { const float a_ = av[0]; RW_FMAC(sa1, a_, 1, s[1]); }
            { const float a_ = av[0]; RW_FMAC(sa2, a_, 2, s[2]); }
            { const float a_ = av[0]; RW_FMAC(sa3, a_, 3, s[3]); }
            { const float a_ = av[0]; RW_FMAC(sa4, a_, 4, s[4]); }
            { const float a_ = av[0]; RW_FMAC(sa5, a_, 5, s[5]); }
            { const float a_ = av[0]; RW_FMAC(sa6, a_, 6, s[6]); }
            { const float a_ = av[0]; RW_FMAC(sa7, a_, 7, s[7]); }
            { const float a_ = av[0]; RW_FMAC(sa0, a_, 8, s[8]); }
            { const float a_ = av[0]; RW_FMAC(sa1, a_, 9, s[9]); }
            { const float a_ = av[0]; RW_FMAC(sa2, a_, 10, s[10]); }
            { const float a_ = av[0]; RW_FMAC(sa3, a_, 11, s[11]); }
            { const float a_ = av[0]; RW_FMAC(sa4, a_, 12, s[12]); }
            { const float a_ = av[0]; RW_FMAC(sa5, a_, 13, s[13]); }
            { const float a_ = av[0]; RW_FMAC(sa6, a_, 14, s[14]); }
            { const float a_ = av[0]; RW_FMAC(sa7, a_, 15, s[15]); }
            { const float a_ = av[1]; RW_FMAC(sa0, a_, 0, s[16]); }
            { const float a_ = av[1]; RW_FMAC(sa1, a_, 1, s[17]); }
            { const float a_ = av[1]; RW_FMAC(sa2, a_, 2, s[18]); }
            { const float a_ = av[1]; RW_FMAC(sa3, a_, 3, s[19]); }
            { const float a_ = av[1]; RW_FMAC(sa4, a_, 4, s[20]); }
            { const float a_ = av[1]; RW_FMAC(sa5, a_, 5, s[21]); }
            { const float a_ = av[1]; RW_FMAC(sa6, a_, 6, s[22]); }
            { const float a_ = av[1]; RW_FMAC(sa7, a_, 7, s[23]); }
            { const float a_ = av[1]; RW_FMAC(sa0, a_, 8, s[24]); }
            { const float a_ = av[1]; RW_FMAC(sa1, a_, 9, s[25]); }
            { const float a_ = av[1]; RW_FMAC(sa2, a_, 10, s[26]); }
            { const float a_ = av[1]; RW_FMAC(sa3, a_, 11, s[27]); }
            { const float a_ = av[1]; RW_FMAC(sa4, a_, 12, s[28]); }
            { const float a_ = av[1]; RW_FMAC(sa5, a_, 13, s[29]); }
            { const float a_ = av[1]; RW_FMAC(sa6, a_, 14, s[30]); }
            { const float a_ = av[1]; RW_FMAC(sa7, a_, 15, s[31]); }
            { const float a_ = av[2]; RW_FMAC(sa0, a_, 0, s[32]); }
            { const float a_ = av[2]; RW_FMAC(sa1, a_, 1, s[33]); }
            { const float a_ = av[2]; RW_FMAC(sa2, a_, 2, s[34]); }
            { const float a_ = av[2]; RW_FMAC(sa3, a_, 3, s[35]); }
            { const float a_ = av[2]; RW_FMAC(sa4, a_, 4, s[36]); }
            { const float a_ = av[2]; RW_FMAC(sa5, a_, 5, s[37]); }
            { const float a_ = av[2]; RW_FMAC(sa6, a_, 6, s[38]); }
            { const float a_ = av[2]; RW_FMAC(sa7, a_, 7, s[39]); }
            { const float a_ = av[2]; RW_FMAC(sa0, a_, 8, s[40]); }
            { const float a_ = av[2]; RW_FMAC(sa1, a_, 9, s[41]); }
            { const float a_ = av[2]; RW_FMAC(sa2, a_, 10, s[42]); }
            { const float a_ = av[2]; RW_FMAC(sa3, a_, 11, s[43]); }
            { const float a_ = av[2]; RW_FMAC(sa4, a_, 12, s[44]); }
            { const float a_ = av[2]; RW_FMAC(sa5, a_, 13, s[45]); }
            { const float a_ = av[2]; RW_FMAC(sa6, a_, 14, s[46]); }
            { const float a_ = av[2]; RW_FMAC(sa7, a_, 15, s[47]); }
            { const float a_ = av[3]; RW_FMAC(sa0, a_, 0, s[48]); }
            { const float a_ = av[3]; RW_FMAC(sa1, a_, 1, s[49]); }
            { const float a_ = av[3]; RW_FMAC(sa2, a_, 2, s[50]); }
            { const float a_ = av[3]; RW_FMAC(sa3, a_, 3, s[51]); }
            { const float a_ = av[3]; RW_FMAC(sa4, a_, 4, s[52]); }
            { const float a_ = av[3]; RW_FMAC(sa5, a_, 5, s[53]); }
            { const float a_ = av[3]; RW_FMAC(sa6, a_, 6, s[54]); }
            { const float a_ = av[3]; RW_FMAC(sa7, a_, 7, s[55]); }
            { const float a_ = av[3]; RW_FMAC(sa0, a_, 8, s[56]); }
            { const float a_ = av[3]; RW_FMAC(sa1, a_, 9, s[57]); }
            { const float a_ = av[3]; RW_FMAC(sa2, a_, 10, s[58]); }
            { const float a_ = av[3]; RW_FMAC(sa3, a_, 11, s[59]); }
            { const float a_ = av[3]; RW_FMAC(sa4, a_, 12, s[60]); }
            { const float a_ = av[3]; RW_FMAC(sa5, a_, 13, s[61]); }
            { const float a_ = av[3]; RW_FMAC(sa6, a_, 14, s[62]); }
            { const float a_ = av[3]; RW_FMAC(sa7, a_, 15, s[63]); }
            const float sa = -(((sa0 + sa1) + (sa2 + sa3)) + ((sa4 + sa5) + (sa6 + sa7)));
            { const float w_ = wv[0]; float t_; RW_MUL(t_, w_, 0, s[0]); s[0] = t_; }
            { const float w_ = wv[0]; float t_; RW_MUL(t_, w_, 1, s[1]); s[1] = t_; }
            { const float w_ = wv[0]; float t_; RW_MUL(t_, w_, 2, s[2]); s[2] = t_; }
            { const float w_ = wv[0]; float t_; RW_MUL(t_, w_, 3, s[3]); s[3] = t_; }
            { const float w_ = wv[0]; float t_; RW_MUL(t_, w_, 4, s[4]); s[4] = t_; }
            { const float w_ = wv[0]; float t_; RW_MUL(t_, w_, 5, s[5]); s[5] = t_; }
            { const float w_ = wv[0]; float t_; RW_MUL(t_, w_, 6, s[6]); s[6] = t_; }
            { const float w_ = wv[0]; float t_; RW_MUL(t_, w_, 7, s[7]); s[7] = t_; }
            { const float w_ = wv[0]; float t_; RW_MUL(t_, w_, 8, s[8]); s[8] = t_; }
            { const float w_ = wv[0]; float t_; RW_MUL(t_, w_, 9, s[9]); s[9] = t_; }
            { const float w_ = wv[0]; float t_; RW_MUL(t_, w_, 10, s[10]); s[10] = t_; }
            { const float w_ = wv[0]; float t_; RW_MUL(t_, w_, 11, s[11]); s[11] = t_; }
            { const float w_ = wv[0]; float t_; RW_MUL(t_, w_, 12, s[12]); s[12] = t_; }
            { const float w_ = wv[0]; float t_; RW_MUL(t_, w_, 13, s[13]); s[13] = t_; }
            { const float w_ = wv[0]; float t_; RW_MUL(t_, w_, 14, s[14]); s[14] = t_; }
            { const float w_ = wv[0]; float t_; RW_MUL(t_, w_, 15, s[15]); s[15] = t_; }
            { const float w_ = wv[1]; float t_; RW_MUL(t_, w_, 0, s[16]); s[16] = t_; }
            { const float w_ = wv[1]; float t_; RW_MUL(t_, w_, 1, s[17]); s[17] = t_; }
            { const float w_ = wv[1]; float t_; RW_MUL(t_, w_, 2, s[18]); s[18] = t_; }
            { const float w_ = wv[1]; float t_; RW_MUL(t_, w_, 3, s[19]); s[19] = t_; }
            { const float w_ = wv[1]; float t_; RW_MUL(t_, w_, 4, s[20]); s[20] = t_; }
            { const float w_ = wv[1]; float t_; RW_MUL(t_, w_, 5, s[21]); s[21] = t_; }
            { const float w_ = wv[1]; float t_; RW_MUL(t_, w_, 6, s[22]); s[22] = t_; }
            { const float w_ = wv[1]; float t_; RW_MUL(t_, w_, 7, s[23]); s[23] = t_; }
            { const float w_ = wv[1]; float t_; RW_MUL(t_, w_, 8, s[24]); s[24] = t_; }
            { const float w_ = wv[1]; float t_; RW_MUL(t_, w_, 9, s[25]); s[25] = t_; }
            { const float w_ = wv[1]; float t_; RW_MUL(t_, w_, 10, s[26]); s[26] = t_; }
            { const float w_ = wv[1]; float t_; RW_MUL(t_, w_, 11, s[27]); s[27] = t_; }
            { const float w_ = wv[1]; float t_; RW_MUL(t_, w_, 12, s[28]); s[28] = t_; }
            { const float w_ = wv[1]; float t_; RW_MUL(t_, w_, 13, s[29]); s[29] = t_; }
            { const float w_ = wv[1]; float t_; RW_MUL(t_, w_, 14, s[30]); s[30] = t_; }
            { const float w_ = wv[1]; float t_; RW_MUL(t_, w_, 15, s[31]); s[31] = t_; }
            { const float w_ = wv[2]; float t_; RW_MUL(t_, w_, 0, s[32]); s[32] = t_; }
            { const float w_ = wv[2]; float t_; RW_MUL(t_, w_, 1, s[33]); s[33] = t_; }
            { const float w_ = wv[2]; float t_; RW_MUL(t_, w_, 2, s[34]); s[34] = t_; }
            { const float w_ = wv[2]; float t_; RW_MUL(t_, w_, 3, s[35]); s[35] = t_; }
            { const float w_ = wv[2]; float t_; RW_MUL(t_, w_, 4, s[36]); s[36] = t_; }
            { const float w_ = wv[2]; float t_; RW_MUL(t_, w_, 5, s[37]); s[37] = t_; }
            { const float w_ = wv[2]; float t_; RW_MUL(t_, w_, 6, s[38]); s[38] = t_; }
            { const float w_ = wv[2]; float t_; RW_MUL(t_, w_, 7, s[39]); s[39] = t_; }
            { const float w_ = wv[2]; float t_; RW_MUL(t_, w_, 8, s[40]); s[40] = t_; }
            { const float w_ = wv[2]; float t_; RW_MUL(t_, w_, 9, s[41]); s[41] = t_; }
            { const float w_ = wv[2]; float t_; RW_MUL(t_, w_, 10, s[42]); s[42] = t_; }
            { const float w_ = wv[2]; float t_; RW_MUL(t_, w_, 11, s[43]); s[43] = t_; }
            { const float w_ = wv[2]; float t_; RW_MUL(t_, w_, 12, s[44]); s[44] = t_; }
            { const float w_ = wv[2]; float t_; RW_MUL(t_, w_, 13, s[45]); s[45] = t_; }
            { const float w_ = wv[2]; float t_; RW_MUL(t_, w_, 14, s[46]); s[46] = t_; }
            { const float w_ = wv[2]; float t_; RW_MUL(t_, w_, 15, s[47]); s[47] = t_; }
            { const float w_ = wv[3]; float t_; RW_MUL(t_, w_, 0, s[48]); s[48] = t_; }
            { const float w_ = wv[3]; float t_; RW_MUL(t_, w_, 1, s[49]); s[49] = t_; }
            { const float w_ = wv[3]; float t_; RW_MUL(t_, w_, 2, s[50]); s[50] = t_; }
            { const float w_ = wv[3]; float t_; RW_MUL(t_, w_, 3, s[51]); s[51] = t_; }
            { const float w_ = wv[3]; float t_; RW_MUL(t_, w_, 4, s[52]); s[52] = t_; }
            { const float w_ = wv[3]; float t_; RW_MUL(t_, w_, 5, s[53]); s[53] = t_; }
            { const float w_ = wv[3]; float t_; RW_MUL(t_, w_, 6, s[54]); s[54] = t_; }
            { const float w_ = wv[3]; float t_; RW_MUL(t_, w_, 7, s[55]); s[55] = t_; }
            { const float w_ = wv[3]; float t_; RW_MUL(t_, w_, 8, s[56]); s[56] = t_; }
            { const float w_ = wv[3]; float t_; RW_MUL(t_, w_, 9, s[57]); s[57] = t_; }
            { const float w_ = wv[3]; float t_; RW_MUL(t_, w_, 10, s[58]); s[58] = t_; }
            { const float w_ = wv[3]; float t_; RW_MUL(t_, w_, 11, s[59]); s[59] = t_; }
            { const float w_ = wv[3]; float t_; RW_MUL(t_, w_, 12, s[60]); s[60] = t_; }
            { const float w_ = wv[3]; float t_; RW_MUL(t_, w_, 13, s[61]); s[61] = t_; }
            { const float w_ = wv[3]; float t_; RW_MUL(t_, w_, 14, s[62]); s[62] = t_; }
            { const float w_ = wv[3]; float t_; RW_MUL(t_, w_, 15, s[63]); s[63] = t_; }
            { const float b_ = bv[0]; RW_FMAC(s[0], b_, 0, sa); }
            { const float b_ = bv[0]; RW_FMAC(s[1], b_, 1, sa); }
            { const float b_ = bv[0]; RW_FMAC(s[2], b_, 2, sa); }
            { const float b_ = bv[0]; RW_FMAC(s[3], b_, 3, sa); }
            { const float b_ = bv[0]; RW_FMAC(s[4], b_, 4, sa); }
            { const float b_ = bv[0]; RW_FMAC(s[5], b_, 5, sa); }
            { const float b_ = bv[0]; RW_FMAC(s[6], b_, 6, sa); }
            { const float b_ = bv[0]; RW_FMAC(s[7], b_, 7, sa); }
            { const float b_ = bv[0]; RW_FMAC(s[8], b_, 8, sa); }
            { const float b_ = bv[0]; RW_FMAC(s[9], b_, 9, sa); }
            { const float b_ = bv[0]; RW_FMAC(s[10], b_, 10, sa); }
            { const float b_ = bv[0]; RW_FMAC(s[11], b_, 11, sa); }
            { const float b_ = bv[0]; RW_FMAC(s[12], b_, 12, sa); }
            { const float b_ = bv[0]; RW_FMAC(s[13], b_, 13, sa); }
            { const float b_ = bv[0]; RW_FMAC(s[14], b_, 14, sa); }
            { const float b_ = bv[0]; RW_FMAC(s[15], b_, 15, sa); }
            { const float b_ = bv[1]; RW_FMAC(s[16], b_, 0, sa); }
            { const float b_ = bv[1]; RW_FMAC(s[17], b_, 1, sa); }
            { const float b_ = bv[1]; RW_FMAC(s[18], b_, 2, sa); }
            { const float b_ = bv[1]; RW_FMAC(s[19], b_, 3, sa); }
            { const float b_ = bv[1]; RW_FMAC(s[20], b_, 4, sa); }
            { const float b_ = bv[1]; RW_FMAC(s[21], b_, 5, sa); }
            { const float b_ = bv[1]; RW_FMAC(s[22], b_, 6, sa); }
            { const float b_ = bv[1]; RW_FMAC(s[23], b_, 7, sa); }
            { const float b_ = bv[1]; RW_FMAC(s[24], b_, 8, sa); }
            { const float b_ = bv[1]; RW_FMAC(s[25], b_, 9, sa); }
            { const float b_ = bv[1]; RW_FMAC(s[26], b_, 10, sa); }
            { const float b_ = bv[1]; RW_FMAC(s[27], b_, 11, sa); }
            { const float b_ = bv[1]; RW_FMAC(s[28], b_, 12, sa); }
            { const float b_ = bv[1]; RW_FMAC(s[29], b_, 13, sa); }
            { const float b_ = bv[1]; RW_FMAC(s[30], b_, 14, sa); }
            { const float b_ = bv[1]; RW_FMAC(s[31], b_, 15, sa); }
            { const float b_ = bv[2]; RW_FMAC(s[32], b_, 0, sa); }
            { const float b_ = bv[2]; RW_FMAC(s[33], b_, 1, sa); }
            { const float b_ = bv[2]; RW_FMAC(s[34], b_, 2, sa); }
            { const float b_ = bv[2]; RW_FMAC(s[35], b_, 3, sa); }
            { const float b_ = bv[2]; RW_FMAC(s[36], b_, 4, sa); }
            { const float b_ = bv[2]; RW_FMAC(s[37], b_, 5, sa); }
            { const float b_ = bv[2]; RW_FMAC(s[38], b_, 6, sa); }
            { const float b_ = bv[2]; RW_FMAC(s[39], b_, 7, sa); }
            { const float b_ = bv[2]; RW_FMAC(s[40], b_, 8, sa); }
            { const float b_ = bv[2]; RW_FMAC(s[41], b_, 9, sa); }
            { const float b_ = bv[2]; RW_FMAC(s[42], b_, 10, sa); }
            { const float b_ = bv[2]; RW_FMAC(s[43], b_, 11, sa); }
            { const float b_ = bv[2]; RW_FMAC(s[44], b_, 12, sa); }
            { const float b_ = bv[2]; RW_FMAC(s[45], b_, 13, sa); }
            { const float b_ = bv[2]; RW_FMAC(s[46], b_, 14, sa); }
            { const float b_ = bv[2]; RW_FMAC(s[47], b_, 15, sa); }
            { const float b_ = bv[3]; RW_FMAC(s[48], b_, 0, sa); }
            { const float b_ = bv[3]; RW_FMAC(s[49], b_, 1, sa); }
            { const float b_ = bv[3]; RW_FMAC(s[50], b_, 2, sa); }
            { const float b_ = bv[3]; RW_FMAC(s[51], b_, 3, sa); }
            { const float b_ = bv[3]; RW_FMAC(s[52], b_, 4, sa); }
            { const float b_ = bv[3]; RW_FMAC(s[53], b_, 5, sa); }
            { const float b_ = bv[3]; RW_FMAC(s[54], b_, 6, sa); }
            { const float b_ = bv[3]; RW_FMAC(s[55], b_, 7, sa); }
            { const float b_ = bv[3]; RW_FMAC(s[56], b_, 8, sa); }
            { const float b_ = bv[3]; RW_FMAC(s[57], b_, 9, sa); }
            { const float b_ = bv[3]; RW_FMAC(s[58], b_, 10, sa); }
            { const float b_ = bv[3]; RW_FMAC(s[59], b_, 11, sa); }
            { const float b_ = bv[3]; RW_FMAC(s[60], b_, 12, sa); }
            { const float b_ = bv[3]; RW_FMAC(s[61], b_, 13, sa); }
            { const float b_ = bv[3]; RW_FMAC(s[62], b_, 14, sa); }
            { const float b_ = bv[3]; RW_FMAC(s[63], b_, 15, sa); }
            float y0 = 0.f, y1 = 0.f, y2 = 0.f, y3 = 0.f, y4 = 0.f, y5 = 0.f, y6 = 0.f, y7 = 0.f;
            { const float a_ = rv[0]; RW_FMAC(y0, a_, 0, s[0]); }
            { const float a_ = rv[0]; RW_FMAC(y1, a_, 1, s[1]); }
            { const float a_ = rv[0]; RW_FMAC(y2, a_, 2, s[2]); }
            { const float a_ = rv[0]; RW_FMAC(y3, a_, 3, s[3]); }
            { const float a_ = rv[0]; RW_FMAC(y4, a_, 4, s[4]); }
            { const float a_ = rv[0]; RW_FMAC(y5, a_, 5, s[5]); }
            { const float a_ = rv[0]; RW_FMAC(y6, a_, 6, s[6]); }
            { const float a_ = rv[0]; RW_FMAC(y7, a_, 7, s[7]); }
            { const float a_ = rv[0]; RW_FMAC(y0, a_, 8, s[8]); }
            { const float a_ = rv[0]; RW_FMAC(y1, a_, 9, s[9]); }
            { const float a_ = rv[0]; RW_FMAC(y2, a_, 10, s[10]); }
            { const float a_ = rv[0]; RW_FMAC(y3, a_, 11, s[11]); }
            { const float a_ = rv[0]; RW_FMAC(y4, a_, 12, s[12]); }
            { const float a_ = rv[0]; RW_FMAC(y5, a_, 13, s[13]); }
            { const float a_ = rv[0]; RW_FMAC(y6, a_, 14, s[14]); }
            { const float a_ = rv[0]; RW_FMAC(y7, a_, 15, s[15]); }
            { const float a_ = rv[1]; RW_FMAC(y0, a_, 0, s[16]); }
            { const float a_ = rv[1]; RW_FMAC(y1, a_, 1, s[17]); }
            { const float a_ = rv[1]; RW_FMAC(y2, a_, 2, s[18]); }
            { const float a_ = rv[1]; RW_FMAC(y3, a_, 3, s[19]); }
            { const float a_ = rv[1]; RW_FMAC(y4, a_, 4, s[20]); }
            { const float a_ = rv[1]; RW_FMAC(y5, a_, 5, s[21]); }
            { const float a_ = rv[1]; RW_FMAC(y6, a_, 6, s[22]); }
            { const float a_ = rv[1]; RW_FMAC(y7, a_, 7, s[23]); }
            { const float a_ = rv[1]; RW_FMAC(y0, a_, 8, s[24]); }
            { const float a_ = rv[1]; RW_FMAC(y1, a_, 9, s[25]); }
            { const float a_ = rv[1]; RW_FMAC(y2, a_, 10, s[26]); }
            { const float a_ = rv[1]; RW_FMAC(y3, a_, 11, s[27]); }
            { const float a_ = rv[1]; RW_FMAC(y4, a_, 12, s[28]); }
            { const float a_ = rv[1]; RW_FMAC(y5, a_, 13, s[29]); }
            { const float a_ = rv[1]; RW_FMAC(y6, a_, 14, s[30]); }
            { const float a_ = rv[1]; RW_FMAC(y7, a_, 15, s[31]); }
            { const float a_ = rv[2]; RW_FMAC(y0, a_, 0, s[32]); }
            { const float a_ = rv[2]; RW_FMAC(y1, a_, 1, s[33]); }
            { const float a_ = rv[2]; RW_FMAC(y2, a_, 2, s[34]); }
            { const float a_ = rv[2]; RW_FMAC(y3, a_, 3, s[35]); }
            { const float a_ = rv[2]; RW_FMAC(y4, a_, 4, s[36]); }
            { const float a_ = rv[2]; RW_FMAC(y5, a_, 5, s[37]); }
            { const float a_ = rv[2]; RW_FMAC(y6, a_, 6, s[38]); }
            { const float a_ = rv[2]; RW_FMAC(y7, a_, 7, s[39]); }
            { const float a_ = rv[2]; RW_FMAC(y0, a_, 8, s[40]); }
            { const float a_ = rv[2]; RW_FMAC(y1, a_, 9, s[41]); }
            { const float a_ = rv[2]; RW_FMAC(y2, a_, 10, s[42]); }
            { const float a_ = rv[2]; RW_FMAC(y3, a_, 11, s[43]); }
            { const float a_ = rv[2]; RW_FMAC(y4, a_, 12, s[44]); }
            { const float a_ = rv[2]; RW_FMAC(y5, a_, 13, s[45]); }
            { const float a_ = rv[2]; RW_FMAC(y6, a_, 14, s[46]); }
            { const float a_ = rv[2]; RW_FMAC(y7, a_, 15, s[47]); }
            { const float a_ = rv[3]; RW_FMAC(y0, a_, 0, s[48]); }
            { const float a_ = rv[3]; RW_FMAC(y1, a_, 1, s[49]); }
            { const float a_ = rv[3]; RW_FMAC(y2, a_, 2, s[50]); }
            { const float a_ = rv[3]; RW_FMAC(y3, a_, 3, s[51]); }
            { const float a_ = rv[3]; RW_FMAC(y4, a_, 4, s[52]); }
            { const float a_ = rv[3]; RW_FMAC(y5, a_, 5, s[53]); }
            { const float a_ = rv[3]; RW_FMAC(y6, a_, 6, s[54]); }
            { const float a_ = rv[3]; RW_FMAC(y7, a_, 7, s[55]); }
            { const float a_ = rv[3]; RW_FMAC(y0, a_, 8, s[56]); }
            { const float a_ = rv[3]; RW_FMAC(y1, a_, 9, s[57]); }
            { const float a_ = rv[3]; RW_FMAC(y2, a_, 10, s[58]); }
            { const float a_ = rv[3]; RW_FMAC(y3, a_, 11, s[59]); }
            { const float a_ = rv[3]; RW_FMAC(y4, a_, 12, s[60]); }
            { const float a_ = rv[3]; RW_FMAC(y5, a_, 13, s[61]); }
            { const float a_ = rv[3]; RW_FMAC(y6, a_, 14, s[62]); }
            { const float a_ = rv[3]; RW_FMAC(y7, a_, 15, s[63]); }
            yo[i * 64] = ((y0 + y1) + (y2 + y3)) + ((y4 + y5) + (y6 + y7));
            wv = wn; av = an; bv = bn; rv = rnv;
        }
    }
    float* o = RPQ + (cs * 2 + kind) * 4096;
    if (kind) {
#pragma unroll
        for (int k = 0; k < 64; ++k) o[k * 64 + lane] = s[k];
    } else {
        bf16_t* ph = (bf16_t*)o;
        const int ks = lane >> 5, rem = lane & 31, jj = 4 * (rem >> 4) + (rem & 3), g = (rem >> 2) & 3;
#pragma unroll
        for (int k2 = 0; k2 < 64; ++k2) { const int mt = k2 >> 4, r = k2 & 15; const int idx = (((mt * 2 + ks) * 64 + g * 16 + r) * 8 + jj);
            ph[idx] = f2bf(s[k2]); }
    }
}

#endif
struct RwBPre { bf16x8 ah[8]; f32x4 qv[4]; };
__device__ __forceinline__ void rwB_load(RwBPre& o, const float* RPQ, size_t cb, int lane, int vt) {
    const bf16x8* ph = (const bf16x8*)(RPQ + (cb * 2 + 0) * 4096);
#pragma unroll
    for (int t = 0; t < 8; ++t) o.ah[t] = ph[t * 64 + lane];
    const float* qt = RPQ + (cb * 2 + 1) * 4096 + (16 * vt + (lane & 15)) * 64 + 4 * (lane >> 4);
#pragma unroll
    for (int mt = 0; mt < 4; ++mt) o.qv[mt] = *(const f32x4*)(qt + 16 * mt);
}
__device__ __forceinline__ void rwB_step(f32x4 (&acc)[4], const RwBPre& c, float* so) {
#pragma unroll
    for (int mt = 0; mt < 4; ++mt) *(f32x4*)(so + 16 * mt) = acc[mt];
    bf16x8 bh[2], bl[2];
#pragma unroll
    for (int ks = 0; ks < 2; ++ks) { u32x4 wh, wl;
#pragma unroll
        for (int jp = 0; jp < 4; ++jp) { const float v0 = acc[2 * ks + (jp >> 1)][(2 * jp) & 3], v1 = acc[2 * ks + (jp >> 1)][((2 * jp) & 3) + 1];
            const unsigned hh = cvtpk_bf16(v0, v1); wh[jp] = hh;
            wl[jp] = cvtpk_bf16(v0 - __uint_as_float(hh << 16), v1 - __uint_as_float(hh & 0xffff0000u)); }
        bh[ks] = *reinterpret_cast<bf16x8*>(&wh); bl[ks] = *reinterpret_cast<bf16x8*>(&wl); }
#pragma unroll
    for (int mt = 0; mt < 4; ++mt) { f32x4 n = c.qv[mt];
#pragma unroll
        for (int ks = 0; ks < 2; ++ks) {
            n = __builtin_amdgcn_mfma_f32_16x16x32_bf16(c.ah[mt * 2 + ks], bh[ks], n, 0, 0, 0);
            n = __builtin_amdgcn_mfma_f32_16x16x32_bf16(c.ah[mt * 2 + ks], bl[ks], n, 0, 0, 0); }
        acc[mt] = n; }
}
__device__ void rwkv_passB_wave(const Params& p, int gwave) {
    const float* RPQ = (const float*)(p.ws + WS_RPQ); float* RS0 = (float*)(p.ws + WS_RS0);
    const int lane = tidx() & 63;
    const int stream = gwave >> 2, vt = gwave & 3, db = stream >> 2, h = stream & 3;
    f32x4 acc[4];
#pragma unroll
    for (int mt = 0; mt < 4; ++mt) acc[mt] = (f32x4){0.f, 0.f, 0.f, 0.f};
    const size_t cb0 = (size_t)db * 260 * 4 + h;
    float* so0 = RS0 + (16 * vt + (lane & 15)) * 64 + 4 * (lane >> 4);
    RwBPre c0, c1, c2;
    rwB_load(c0, RPQ, cb0 + 0, lane, vt); rwB_load(c1, RPQ, cb0 + 4, lane, vt);
#pragma unroll 1
    for (int q = 0; q < 260; q += 3) {
        rwB_load(c2, RPQ, cb0 + 4 * (size_t)(q + 2 < 260 ? q + 2 : 259), lane, vt);
        rwB_step(acc, c0, so0 + (cb0 + 4 * (size_t)q) * 4096);
        if (q + 1 < 260) {
            rwB_load(c0, RPQ, cb0 + 4 * (size_t)(q + 3 < 260 ? q + 3 : 259), lane, vt);
            rwB_step(acc, c1, so0 + (cb0 + 4 * (size_t)(q + 1)) * 4096);
            if (q + 2 < 260) {
                rwB_load(c1, RPQ, cb0 + 4 * (size_t)(q + 4 < 260 ? q + 4 : 259), lane, vt);
                rwB_step(acc, c2, so0 + (cb0 + 4 * (size_t)(q + 2)) * 4096);
            }
        }
    }
}

__device__ void rwkv_passC_unit(const Params& p, int L, int item) {
    const float* RS0 = (const float*)(p.ws + WS_RS0); const float* RY = (const float*)(p.ws + WS_RY);
    const bf16_t* RWPH = (const bf16_t*)(p.ws + WS_RWP); bf16_t* MIX = (bf16_t*)(p.ws + WS_MIX);
    const int lane = tidx() & 63, wid = wave_id(), h = wid & 3, sh = wid >> 2, fr = lane & 15, g = lane >> 4;
    const int b = item / 260, j = item % 260;
    const int row0 = rw_chunk_row0(0, b, j);
    const int qf = j, qb = j < 4 ? 3 - j : 263 - j;
    f32x4 acc[2][4];
#pragma unroll
    for (int d = 0; d < 2; ++d) {
        const size_t cs = ((size_t)(d * 2 + b) * 260 + (d ? qb : qf)) * 4 + h;
        const float* s0 = RS0 + cs * 4096 + fr * 64 + 8 * g;
        const float* rab = RY + (cs * 2 + 0) * 4096 + 8 * g;
        const float* y1b = RY + (cs * 2 + 1) * 4096 + fr * 64;
        bf16x8 bf[4][2];
#pragma unroll
        for (int nt = 0; nt < 4; ++nt)
#pragma unroll
            for (int ks = 0; ks < 2; ++ks) { const f32x4 a = *(const f32x4*)(s0 + nt * 1024 + 32 * ks), c = *(const f32x4*)(s0 + nt * 1024 + 32 * ks + 4);
                u32x4 w = {cvtpk_bf16(a[0], a[1]), cvtpk_bf16(a[2], a[3]), cvtpk_bf16(c[0], c[1]), cvtpk_bf16(c[2], c[3])}; bf[nt][ks] = *reinterpret_cast<bf16x8*>(&w); }
#pragma unroll
        for (int m2 = 0; m2 < 2; ++m2) {
            const int ro = 32 * sh + 16 * m2;
            const int ta = d ? 63 - (ro + fr) : ro + fr;
            bf16x8 af[2];
#pragma unroll
            for (int ks = 0; ks < 2; ++ks) { const f32x4 a = *(const f32x4*)(rab + ta * 64 + 32 * ks), c = *(const f32x4*)(rab + ta * 64 + 32 * ks + 4);
                u32x4 w = {cvtpk_bf16(a[0], a[1]), cvtpk_bf16(a[2], a[3]), cvtpk_bf16(c[0], c[1]), cvtpk_bf16(c[2], c[3])}; af[ks] = *reinterpret_cast<bf16x8*>(&w); }
#pragma unroll
            for (int nt = 0; nt < 4; ++nt) {
                f32x4 a_;
#pragma unroll
                for (int r = 0; r < 1; ++r) { const f32x4 yv = *(const f32x4*)(y1b + nt * 1024 + (d ? 60 - (ro + 4 * g) : ro + 4 * g));
                    if (d) { a_[0] = yv[3] + acc[m2][nt][0]; a_[1] = yv[2] + acc[m2][nt][1]; a_[2] = yv[1] + acc[m2][nt][2]; a_[3] = yv[0] + acc[m2][nt][3]; } else a_ = yv; }
                a_ = __builtin_amdgcn_mfma_f32_16x16x32_bf16(af[0], bf[nt][0], a_, 0, 0, 0);
                a_ = __builtin_amdgcn_mfma_f32_16x16x32_bf16(af[1], bf[nt][1], a_, 0, 0, 0);
                acc[m2][nt] = a_;
            }
        }
    }
    float lw_[4], lb_[4];
#pragma unroll
    for (int nt = 0; nt < 4; ++nt) { const int c = h * 64 + 16 * nt + fr; lw_[nt] = p.rwkv_ln_w[L * 256 + c]; lb_[nt] = p.rwkv_ln_b[L * 256 + c]; }
#pragma unroll
    for (int m2 = 0; m2 < 2; ++m2)
#pragma unroll
        for (int r = 0; r < 4; ++r) {
            const int row = row0 + 32 * sh + 16 * m2 + 4 * g + r;
            const float mu = row16_sum((acc[m2][0][r] + acc[m2][1][r]) + (acc[m2][2][r] + acc[m2][3][r])) * (1.f / 64.f);
            float dv[4], sq = 0.f;
#pragma unroll
            for (int nt = 0; nt < 4; ++nt) { dv[nt] = acc[m2][nt][r] - mu; sq += dv[nt] * dv[nt]; }
            const float rs = rsqrtf(row16_sum(sq) * (1.f / 64.f) + 64e-5f);
            const bf16_t* rw = RWPH + (size_t)row * 9 * 256 + h * 64 + fr;
            bf16_t* mo = MIX + (size_t)row * 1024 + 768 + h * 64 + fr;
#pragma unroll
            for (int nt = 0; nt < 4; ++nt) { const float yn = dv[nt] * rs * lw_[nt] + lb_[nt];
                mo[16 * nt] = f2bf((yn + bf2f(rw[3 * 256 + 16 * nt])) * bf2f(rw[4 * 256 + 16 * nt])); }
        }
}

constexpr int UT_TS = 72;
constexpr int UT_AT = 0, UT_RT = 9216, UT_BT = 18432, UT_KT = 27648, UT_BHT = 36864, UT_KHT = 46080, UT_VTT = 55296;
constexpr int UT_MAK = UT_AT, UT_NRB = UT_BT, UT_NRK = UT_KT;
constexpr int UT_RF = 64512, UT_MAB = UT_RF + 16384, UT_XT = UT_MAB + 16384, UT_XS = 68, UT_EC = UT_XT + 128 * UT_XS * 4, UT_GT = UT_EC + 256;
constexpr int UT_TD = UT_GT + 2048;
static_assert(UT_TD + 4096 <= LDS_MISC, "UT LDS map");
__device__ __forceinline__ bf16x8 ut_cvt8(const float* p) { const f32x4 a = *(const f32x4*)p, b = *(const f32x4*)(p + 4);
    u32x4 w = {cvtpk_bf16(a[0], a[1]), cvtpk_bf16(a[2], a[3]), cvtpk_bf16(b[0], b[1]), cvtpk_bf16(b[2], b[3])}; return *reinterpret_cast<bf16x8*>(&w); }

#ifndef UT_WR
#define UT_WR 15
#endif
__device__ void rwkv_ut_unit(const Params& p, int unit) {
    const bf16_t* RWPH = (const bf16_t*)(p.ws + WS_RWP); const float* RWPW = (const float*)(p.ws + WS_RWPW); float* RPQ = (float*)(p.ws + WS_RPQ); float* RY = (float*)(p.ws + WS_RY);
    const int d = unit / 520, b = (unit / 260) & 1, q = unit % 260;
    const int row0 = rw_chunk_row0(d, b, q);
    bf16_t* AT = (bf16_t*)(smem + UT_AT); bf16_t* RT = (bf16_t*)(smem + UT_RT); bf16_t* BT = (bf16_t*)(smem + UT_BT); bf16_t* KT = (bf16_t*)(smem + UT_KT);
    bf16_t* BHT = (bf16_t*)(smem + UT_BHT); bf16_t* KHT = (bf16_t*)(smem + UT_KHT); bf16_t* VTT = (bf16_t*)(smem + UT_VTT);
    bf16_t* MAK = (bf16_t*)(smem + UT_MAK); bf16_t* NRB = (bf16_t*)(smem + UT_NRB); bf16_t* NRK = (bf16_t*)(smem + UT_NRK);
    float* RF = (float*)(smem + UT_RF); float* MAB = (float*)(smem + UT_MAB); float* XT = (float*)(smem + UT_XT); float* EC = (float*)(smem + UT_EC); float* GT = (float*)(smem + UT_GT);
    float* TD = (float*)(smem + UT_TD);
    float lw[8]; unsigned short ukk[8], ubd[8], ukd[8], ur[8], uvv[8];
#define UT_LOAD0(hh) { const int tid_ = tidx(), k_ = tid_ & 63, tg_ = tid_ >> 6; const int kp_ = (hh) * 64 + ((k_ & 15) << 2) + (k_ >> 4); \
    _Pragma("unroll") for (int j = 0; j < 8; ++j) { const int t_ = tg_ * 8 + j, row_ = row0 + (d ? 63 - t_ : t_); \
        const bf16_t* rp = RWPH + (size_t)row_ * 9 * 256 + kp_; \
        lw[j] = RWPW[(size_t)row_ * 512 + d * 256 + kp_]; ukk[j] = rp[2 * 256]; ubd[j] = rp[(7 + d) * 256]; ukd[j] = rp[(5 + d) * 256]; ur[j] = rp[0]; \
        uvv[j] = RWPH[((size_t)row_ * 9 + 1) * 256 + (hh) * 64 + k_]; } }
    UT_LOAD0(0)
#pragma unroll 1
    for (int h = 0; h < 4; ++h) {
        const size_t cs = ((size_t)(d * 2 + b) * 260 + q) * 4 + h;
        __syncthreads();
        {
            const int tid = tidx(), k = tid & 63, tg = tid >> 6;
            float cum[8]; float run = 0.f;
#pragma unroll
            for (int j = 0; j < 8; ++j) { lw[j] = __logf(lw[j]); run += lw[j]; cum[j] = run; }
            GT[tg * 64 + k] = run;
            __syncthreads();
            float off = 0.f, tot = 0.f;
#pragma unroll
            for (int g2 = 0; g2 < 8; ++g2) { const float gv = GT[g2 * 64 + k]; tot += gv; if (g2 < tg) off += gv; }
            if (tg == 0) EC[k] = __expf(tot);
#pragma unroll
            for (int j = 0; j < 8; ++j) { const int t = tg * 8 + j;
                const float ct = off + cum[j], cm = ct - lw[j];
                const float e_t = __expf(ct), e_m = __expf(cm), e_i = __expf(-ct), e_c = __expf(tot - ct);
                const float vkk_ = bf2f(ukk[j]), vbd_ = bf2f(ubd[j]), vkd_ = bf2f(ukd[j]), vr_ = bf2f(ur[j]);
                const float at = -vkk_ * e_m, rt = vr_ * e_t;
                AT[t * UT_TS + k] = f2bf(at); RT[t * UT_TS + k] = f2bf(rt); RF[t * 64 + k] = rt; XT[k * UT_XS + t] = at;
                BT[t * UT_TS + k] = f2bf(vbd_ * e_i); KT[t * UT_TS + k] = f2bf(vkd_ * e_i);
                BHT[k * UT_TS + t] = f2bf(vbd_ * e_c); KHT[k * UT_TS + t] = f2bf(vkd_ * e_c);
                VTT[k * UT_TS + t] = uvv[j]; }
        }
        if (h < 3) UT_LOAD0(h + 1)
        __syncthreads();
        const int tid = tidx(), lane = tid & 63, w = tid >> 6, fr = lane & 15, g = lane >> 4;
        {
            const bf16_t* Asrc = (w < 4 ? AT : RT) + (16 * (w & 3) + fr) * UT_TS + 8 * g;
            const bf16x8 a0 = *(const bf16x8*)Asrc, a1 = *(const bf16x8*)(Asrc + 32);
            f32x4 acc[8];
#pragma unroll
            for (int nt = 0; nt < 8; ++nt) { const bf16_t* Bsrc = (nt < 4 ? BT : KT) + (16 * (nt & 3) + fr) * UT_TS + 8 * g;
                f32x4 c = {0.f, 0.f, 0.f, 0.f};
                c = __builtin_amdgcn_mfma_f32_16x16x32_bf16(a0, *(const bf16x8*)Bsrc, c, 0, 0, 0);
                c = __builtin_amdgcn_mfma_f32_16x16x32_bf16(a1, *(const bf16x8*)(Bsrc + 32), c, 0, 0, 0);
                acc[nt] = c; }
            __syncthreads();
#pragma unroll
            for (int nt = 0; nt < 8; ++nt)
#pragma unroll
                for (int r = 0; r < 4; ++r) { const int t = 16 * (w & 3) + 4 * g + r, i = 16 * (nt & 3) + fr;
                    if (w < 4) { const float v = i < t ? acc[nt][r] : 0.f;
                        if (nt < 4) MAB[t * 64 + i] = v; else MAK[t * UT_TS + i] = f2bf(v); }
                    else { const float v = i <= t ? acc[nt][r] : 0.f;
                        if (nt < 4) NRB[t * UT_TS + i] = f2bf(v); else NRK[t * UT_TS + i] = f2bf(v); } }
        }
        __syncthreads();
        {
            const int mt = w >> 1;
            const bf16_t* Asrc = MAK + (16 * mt + fr) * UT_TS + 8 * g;
            const bf16x8 a0 = *(const bf16x8*)Asrc, a1 = *(const bf16x8*)(Asrc + 32);
#pragma unroll
            for (int n2 = 0; n2 < 2; ++n2) { const int nt = 2 * (w & 1) + n2; const bf16_t* Bsrc = VTT + (16 * nt + fr) * UT_TS + 8 * g;
                f32x4 c = {0.f, 0.f, 0.f, 0.f};
                c = __builtin_amdgcn_mfma_f32_16x16x32_bf16(a0, *(const bf16x8*)Bsrc, c, 0, 0, 0);
                c = __builtin_amdgcn_mfma_f32_16x16x32_bf16(a1, *(const bf16x8*)(Bsrc + 32), c, 0, 0, 0);
                *(f32x4*)(XT + (64 + 16 * nt + fr) * UT_XS + 16 * mt + 4 * g) = c; }
            if (w == 0) {
                const float* mb = MAB + (16 * g) * 64 + 16 * g;
                float x[16];
#pragma unroll
                for (int t = 0; t < 16; ++t) { float s_ = (t == fr) ? 1.f : 0.f;
#pragma unroll
                    for (int i = 0; i < t; ++i) s_ = fmaf(mb[t * 64 + i], x[i], s_);
                    x[t] = s_; }
#pragma unroll
                for (int t = 0; t < 16; ++t) TD[(g * 16 + t) * 16 + fr] = x[t];
            }
        }
        __syncthreads();
        {
            const float* xr = XT + (16 * w + fr) * UT_XS + 4 * g;
            f32x4 X[4];
#pragma unroll
            for (int I = 0; I < 4; ++I) {
                f32x4 acc = *(const f32x4*)(xr + 16 * I);
#pragma unroll
                for (int J = 0; J < I; ++J) { const f32x4 m = *(const f32x4*)(MAB + (16 * I + fr) * 64 + 16 * J + 4 * g);
#pragma unroll
                    for (int mm = 0; mm < 4; ++mm) acc = __builtin_amdgcn_mfma_f32_16x16x4f32(m[mm], X[J][mm], acc, 0, 0, 0); }
                const f32x4 tq = *(const f32x4*)(TD + (I * 16 + fr) * 16 + 4 * g);
                f32x4 xi = {0.f, 0.f, 0.f, 0.f};
#pragma unroll
                for (int mm = 0; mm < 4; ++mm) xi = __builtin_amdgcn_mfma_f32_16x16x4f32(tq[mm], acc[mm], xi, 0, 0, 0);
                X[I] = xi;
            }
#pragma unroll
            for (int I = 0; I < 4; ++I) *(f32x4*)(XT + (16 * w + fr) * UT_XS + 16 * I + 4 * g) = X[I];
        }
        __syncthreads();
        {
            const int mt = w & 3, og = w >> 2;
            const bf16_t* Ah = BHT + (16 * mt + fr) * UT_TS + 8 * g; const bf16_t* Ak = KHT + (16 * mt + fr) * UT_TS + 8 * g;
            const bf16_t* An = NRB + (16 * mt + fr) * UT_TS + 8 * g; const bf16_t* Am = NRK + (16 * mt + fr) * UT_TS + 8 * g;
            const bf16x8 ah0 = *(const bf16x8*)Ah, ah1 = *(const bf16x8*)(Ah + 32), an0 = *(const bf16x8*)An, an1 = *(const bf16x8*)(An + 32);
            if (og == 0) {
                float* ra = RY + (cs * 2 + 0) * 4096;
#pragma unroll
                for (int nt = 0; nt < 4; ++nt) { const float* xb = XT + (16 * nt + fr) * UT_XS + 8 * g;
                    const bf16x8 b0 = ut_cvt8(xb), b1 = ut_cvt8(xb + 32);
                    f32x4 pc = {0.f, 0.f, 0.f, 0.f}, rc = {0.f, 0.f, 0.f, 0.f};
                    pc = __builtin_amdgcn_mfma_f32_16x16x32_bf16(ah0, b0, pc, 0, 0, 0); pc = __builtin_amdgcn_mfma_f32_16x16x32_bf16(ah1, b1, pc, 0, 0, 0);
                    rc = __builtin_amdgcn_mfma_f32_16x16x32_bf16(b0, an0, rc, 0, 0, 0); rc = __builtin_amdgcn_mfma_f32_16x16x32_bf16(b1, an1, rc, 0, 0, 0);
                    { const int o_ = (16 * mt + fr) * 64 + 16 * nt + 4 * g; const f32x4 rf = *(const f32x4*)(RF + o_);
                      f32x4 ov = {rc[0] + rf[0], rc[1] + rf[1], rc[2] + rf[2], rc[3] + rf[3]}; if (UT_WR & 4) *(f32x4*)(ra + o_) = ov; }
#pragma unroll
                    for (int r = 0; r < 4; ++r) { const int rr = 16 * mt + 4 * g + r, k = 16 * nt + fr;
                        const float pv = pc[r] + (rr == k ? EC[rr] : 0.f);
                        const int ks = k >> 5, rem = k & 31, jj = 4 * (rem >> 4) + (rem & 3), gg = (rem >> 2) & 3;
                        ((bf16_t*)MAB)[(((rr >> 4) * 2 + ks) * 64 + gg * 16 + (rr & 15)) * 8 + jj] = f2bf(pv);
                    } }
            } else {
                const bf16x8 ak0 = *(const bf16x8*)Ak, ak1 = *(const bf16x8*)(Ak + 32), am0 = *(const bf16x8*)Am, am1 = *(const bf16x8*)(Am + 32);
                float* qo = RPQ + (cs * 2 + 1) * 4096; float* y1 = RY + (cs * 2 + 1) * 4096;
#pragma unroll
                for (int nt = 0; nt < 4; ++nt) { const float* xb = XT + (64 + 16 * nt + fr) * UT_XS + 8 * g; const bf16_t* vb = VTT + (16 * nt + fr) * UT_TS + 8 * g;
                    const bf16x8 z0 = ut_cvt8(xb), z1 = ut_cvt8(xb + 32), v0 = *(const bf16x8*)vb, v1 = *(const bf16x8*)(vb + 32);
                    f32x4 qc = {0.f, 0.f, 0.f, 0.f}, yc = {0.f, 0.f, 0.f, 0.f};
                    qc = __builtin_amdgcn_mfma_f32_16x16x32_bf16(ah0, z0, qc, 0, 0, 0); qc = __builtin_amdgcn_mfma_f32_16x16x32_bf16(ah1, z1, qc, 0, 0, 0);
                    qc = __builtin_amdgcn_mfma_f32_16x16x32_bf16(ak0, v0, qc, 0, 0, 0); qc = __builtin_amdgcn_mfma_f32_16x16x32_bf16(ak1, v1, qc, 0, 0, 0);
                    yc = __builtin_amdgcn_mfma_f32_16x16x32_bf16(an0, z0, yc, 0, 0, 0); yc = __builtin_amdgcn_mfma_f32_16x16x32_bf16(an1, z1, yc, 0, 0, 0);
                    yc = __builtin_amdgcn_mfma_f32_16x16x32_bf16(am0, v0, yc, 0, 0, 0); yc = __builtin_amdgcn_mfma_f32_16x16x32_bf16(am1, v1, yc, 0, 0, 0);
#pragma unroll
                    for (int r = 0; r < 1; ++r) { const int o_ = (16 * nt + fr) * 64 + 16 * mt + 4 * g; if (UT_WR & 2) *(f32x4*)(qo + o_) = qc; if (UT_WR & 8) *(f32x4*)(y1 + o_) = yc; } }
            }
        }
        __syncthreads();
        if (UT_WR & 1) ((u32x4*)(RPQ + (cs * 2 + 0) * 4096))[tid] = ((const u32x4*)MAB)[tid];
    }
}
constexpr int RT_PAR = 0;
constexpr int RT_BS = 72, RT_BBUF = 2 * 80 * RT_BS * 2;
constexpr int RT_B = 36864, RT_LG = RT_B + 2 * RT_BBUF, RT_CNT = RT_LG + 8 * 16 * 80 * 4;
static_assert(RT_CNT + 512 <= LDS_MISC, "router LDS map");
struct RtTile { int row; float rs; const bf16_t* xr; const float* pw; const float* ps; };
__device__ __forceinline__ void rt_tile_init(RtTile& t, const bf16_t* X, const float* par, int tile, int fr, int g) {
    const int row0 = tile * 16, set = row_set(row0); t.row = row0 + fr;
    t.xr = X + (size_t)t.row * 1024 + 8 * g; t.pw = par + (set * 3 + 0) * 1024 + 8 * g; t.ps = par + (set * 3 + 1) * 1024 + 8 * g;
    float ss = 0.f;
#pragma unroll 8
    for (int ks = 0; ks < 32; ++ks) { const f32x4 a = ld4bf(t.xr + 32 * ks), b = ld4bf(t.xr + 32 * ks + 4);
        ss += a[0] * a[0] + a[1] * a[1] + a[2] * a[2] + a[3] * a[3] + b[0] * b[0] + b[1] * b[1] + b[2] * b[2] + b[3] * b[3]; }
    ss += __int_as_float(__builtin_amdgcn_ds_swizzle(__float_as_int(ss), 0x401F));
    { auto rr = __builtin_amdgcn_permlane32_swap(__float_as_uint(ss), __float_as_uint(ss), false, false); ss = __uint_as_float(rr[0]) + __uint_as_float(rr[1]); }
    t.rs = rsqrtf(ss * (1.f / 1024.f) + NORM_EPS);
}
struct RtX { u32x4 u[2]; };
__device__ __forceinline__ void rt_xload(RtX& o, const RtTile& t, int kc) {
#pragma unroll
    for (int s2 = 0; s2 < 2; ++s2) o.u[s2] = *(const u32x4*)(t.xr + 64 * kc + 32 * s2); }
__device__ __forceinline__ void rt_chunk(f32x4 (&acc)[5], const RtTile& t, const RtX& x, bf16_t* H, const bf16_t* Bc, int kc, int fr, int g) {
#pragma unroll
    for (int s2 = 0; s2 < 2; ++s2) { const int ks = 2 * kc + s2;
        const f32x4 w0 = *(const f32x4*)(t.pw + 32 * ks), w1 = *(const f32x4*)(t.pw + 32 * ks + 4), s0 = *(const f32x4*)(t.ps + 32 * ks), s1 = *(const f32x4*)(t.ps + 32 * ks + 4);
        float hv[8];
        { const u32x4 u = x.u[s2];
          const float xa[4] = {__uint_as_float(u[0] << 16), __uint_as_float(u[0] & 0xffff0000u), __uint_as_float(u[1] << 16), __uint_as_float(u[1] & 0xffff0000u)};
          const float xb[4] = {__uint_as_float(u[2] << 16), __uint_as_float(u[2] & 0xffff0000u), __uint_as_float(u[3] << 16), __uint_as_float(u[3] & 0xffff0000u)};
#pragma unroll
          for (int e = 0; e < 4; ++e) { hv[e] = fmaf(xa[e] * t.rs, w0[e], s0[e]); hv[4 + e] = fmaf(xb[e] * t.rs, w1[e], s1[e]); } }
        u32x4 hi, lo;
#pragma unroll
        for (int e = 0; e < 4; ++e) { const unsigned hh = cvtpk_bf16(hv[2 * e], hv[2 * e + 1]); hi[e] = hh;
            lo[e] = cvtpk_bf16(hv[2 * e] - __uint_as_float(hh << 16), hv[2 * e + 1] - __uint_as_float(hh & 0xffff0000u)); }
        *(u32x4*)(H + (size_t)t.row * 1024 + 32 * ks + 8 * g) = hi;
        const bf16x8 ah = *reinterpret_cast<bf16x8*>(&hi), al = *reinterpret_cast<bf16x8*>(&lo);
#pragma unroll
        for (int nt = 0; nt < 5; ++nt) {
            const bf16x8 wh = *(const bf16x8*)(Bc + (16 * nt + fr) * RT_BS + 32 * s2 + 8 * g), wl = *(const bf16x8*)(Bc + (80 + 16 * nt + fr) * RT_BS + 32 * s2 + 8 * g);
            acc[nt] = __builtin_amdgcn_mfma_f32_16x16x32_bf16(ah, wh, acc[nt], 0, 0, 0);
            acc[nt] = __builtin_amdgcn_mfma_f32_16x16x32_bf16(al, wh, acc[nt], 0, 0, 0);
            acc[nt] = __builtin_amdgcn_mfma_f32_16x16x32_bf16(ah, wl, acc[nt], 0, 0, 0); } }
}
__device__ __forceinline__ void rt_pick(const Params& p, int L, const f32x4 (&acc)[5], float* lg, int* lcnt, int row0, int lane, int fr, int g,
                                        int& ea, int& eb, int& pa, int& pb, int& trow) {
    int* EID = (int*)(p.ws + WS_EID); float* GATE = (float*)(p.ws + WS_GATE); const float* bias = (const float*)(smem + RT_PAR) + 2 * 1024;
#pragma unroll
    for (int nt = 0; nt < 5; ++nt)
#pragma unroll
        for (int r = 0; r < 4; ++r) lg[(4 * g + r) * 80 + 16 * nt + fr] = acc[nt][r];
    asm volatile("s_waitcnt lgkmcnt(0)" ::: "memory");
    if (lane < 16) {
        const float* l = lg + lane * 80; trow = row0 + lane;
        float gl[8]; int gi = 0; float gm = -3.0e38f;
#pragma unroll
        for (int j = 0; j < 8; ++j) { gl[j] = l[j] + bias[j]; if (gl[j] > gm) { gm = gl[j]; gi = j; } }
        float gs = 0.f;
#pragma unroll
        for (int j = 0; j < 8; ++j) gs += __expf(gl[j] - gm);
        const float pg = 1.f / gs;
        float e1 = -3.0e38f, e2 = -3.0e38f; int i1 = 0, i2 = 0;
        for (int j = 0; j < 8; ++j) { const float v = l[8 + gi * 8 + j] + bias[8 + gi * 8 + j];
            if (v > e1) { e2 = e1; i2 = i1; e1 = v; i1 = j; } else if (v > e2) { e2 = v; i2 = j; } }
        const float x2 = __expf(e2 - e1);
        const float g0 = pg / (1.f + x2), g1 = pg * x2 / (1.f + x2);
        ea = gi * 8 + i1; eb = gi * 8 + i2;
        EID[trow * 2] = ea; EID[trow * 2 + 1] = eb; GATE[trow * 2] = g0; GATE[trow * 2 + 1] = g1;
        pa = atomicAdd(&lcnt[ea], 1); pb = atomicAdd(&lcnt[eb], 1);
    }
    asm volatile("s_waitcnt lgkmcnt(0)" ::: "memory");
}
__device__ __forceinline__ void ph_norm2_router(const Params& p, int L) {
    unsigned char* ws = p.ws;
    const bf16_t* X = (const bf16_t*)(ws + WS_X); bf16_t* H = (bf16_t*)(ws + WS_H);
    const float* mods = (const float*)(ws + WS_MODS);
    const bf16_t* WRH = (const bf16_t*)(ws + WS_WRH) + (size_t)L * 2 * 80 * 1024; const bf16_t* WRL = WRH + 80 * 1024;
    int* POS = (int*)(ws + WS_POS); int* CNT = (int*)(ws + WS_MISC);
    const int tid = tidx(), lane = tid & 63, wid = tid >> 6, fr = lane & 15, g = lane >> 4;
    float* par = (float*)(smem + RT_PAR); float* lg = (float*)(smem + RT_LG) + wid * (16 * 80); int* lcnt = (int*)(smem + RT_CNT);
    bf16_t* Bs = (bf16_t*)(smem + RT_B);
    __syncthreads();
    for (int i = tid; i < 3 * 1024; i += NTHREADS) { const int set = i >> 10, c = i & 1023; const float* md = mods + (L * 3 + set) * 6144;
        par[(set * 3 + 0) * 1024 + c] = p.norm2_w[L * 1024 + c] * (1.f + md[4 * 1024 + c]); par[(set * 3 + 1) * 1024 + c] = md[3 * 1024 + c]; }
    if (tid < 72) par[2 * 1024 + tid] = tid < 8 ? p.moe_b_rg[L * 8 + tid] : p.moe_b_re[L * 64 + tid - 8];
    constexpr int NTILE = NTOK / 16;
    const int G = gridDim.x, tbase = NTILE / G, trem = NTILE % G, bx = bidx();
    const int t_lo = bx * tbase + (bx < trem ? bx : trem), t_hi = t_lo + tbase + (bx < trem ? 1 : 0);
    for (int t0 = t_lo; t0 < t_hi; t0 += 9) {
        const int tA = t0 + wid, tB = t0 + 8;
        const bool hasA = tA < t_hi && wid < 8, hasB = (wid == 0) && tB < t_hi;
        if (tid < 64) lcnt[tid] = 0;
        RtTile A, B;
        rt_tile_init(A, X, par, hasA ? tA : t0, fr, g);
        if (hasB) rt_tile_init(B, X, par, tB, fr, g); else B = A;
        f32x4 accA[5], accB[5];
#pragma unroll
        for (int nt = 0; nt < 5; ++nt) { accA[nt] = (f32x4){0.f, 0.f, 0.f, 0.f}; accB[nt] = (f32x4){0.f, 0.f, 0.f, 0.f}; }
        u32x4 st[3];
#pragma unroll
        for (int i = 0; i < 3; ++i) { const int idx = tid + 512 * i; if (idx < 1280) { const int part = idx / 640, rem = idx % 640, o = rem >> 3, c8 = rem & 7;
            st[i] = *(const u32x4*)((part ? WRL : WRH) + (size_t)o * 1024 + c8 * 8); } }
        RtX xa, xb, xan, xbn; rt_xload(xa, A, 0); if (hasB) rt_xload(xb, B, 0);
#pragma unroll 1
        for (int kc = 0; kc < 16; ++kc) {
            bf16_t* Bc = Bs + (kc & 1) * (RT_BBUF / 2);
#pragma unroll
            for (int i = 0; i < 3; ++i) { const int idx = tid + 512 * i; if (idx < 1280) { const int part = idx / 640, rem = idx % 640, o = rem >> 3, c8 = rem & 7;
                *(u32x4*)(Bc + (part * 80 + o) * RT_BS + c8 * 8) = st[i]; } }
            __syncthreads();
            const int kn = kc < 15 ? kc + 1 : 15;
#pragma unroll
            for (int i = 0; i < 3; ++i) { const int idx = tid + 512 * i; if (idx < 1280) { const int part = idx / 640, rem = idx % 640, o = rem >> 3, c8 = rem & 7;
                st[i] = *(const u32x4*)((part ? WRL : WRH) + (size_t)o * 1024 + kn * 64 + c8 * 8); } }
            rt_xload(xan, A, kn); if (hasB) rt_xload(xbn, B, kn);
            if (hasA) rt_chunk(accA, A, xa, H, Bc, kc, fr, g);
            if (hasB) rt_chunk(accB, B, xb, H, Bc, kc, fr, g);
            xa = xan; xb = xbn;
        }
        int eaA = 0, ebA = 0, paA = 0, pbA = 0, trA = 0, eaB = 0, ebB = 0, paB = 0, pbB = 0, trB = 0;
        if (hasA) rt_pick(p, L, accA, lg, lcnt, tA * 16, lane, fr, g, eaA, ebA, paA, pbA, trA);
        if (hasB) rt_pick(p, L, accB, lg, lcnt, tB * 16, lane, fr, g, eaB, ebB, paB, pbB, trB);
        __syncthreads();
        if (tid < 64) { const int c = lcnt[tid]; lcnt[64 + tid] = c > 0 ? atomicAdd(&CNT[tid * 16], c) : 0; }
        __syncthreads();
        if (hasA && lane < 16) { POS[trA * 2] = lcnt[64 + eaA] + paA; POS[trA * 2 + 1] = lcnt[64 + ebA] + pbA; }
        if (hasB && lane < 16) { POS[trB * 2] = lcnt[64 + eaB] + paB; POS[trB * 2 + 1] = lcnt[64 + ebB] + pbB; }
        __syncthreads();
    }
}

constexpr int MOE_TBL = 131072;
__device__ __forceinline__ void moe_table(const Params& p) {
    int* tb = (int*)(smem + MOE_TBL); const int* CNT = (const int*)(p.ws + WS_MISC);
    __syncthreads();
    if (tidx() < 64) {
        const int e = tidx(), cnt = CNT[e * 16], pd = (cnt + 255) / 256 * 256;
        const int incl = (int)wave_scan_incl((float)pd);
        tb[e] = incl - pd; tb[64 + e] = pd; tb[576 + e] = cnt; if (e == 63) tb[128] = incl / 256;
        for (int t = (incl - pd) >> 8; t < (incl >> 8); ++t) tb[192 + t] = e; }
    __syncthreads();
}
__device__ __forceinline__ void ph_slots(const Params& p) {
    unsigned char* ws = p.ws;
    const int* EID = (const int*)(ws + WS_EID); const int* POS = (const int*)(ws + WS_POS); int* SLOT = (int*)(ws + WS_SLOT);
    const bf16_t* H = (const bf16_t*)(ws + WS_H); bf16_t* HG = (bf16_t*)(ws + WS_HG);
    const int* CNT = (const int*)(ws + WS_MISC);
    moe_table(p);
    const int* tb = (const int*)(smem + MOE_TBL);
    const int lane = tidx() & 63, gw = bidx() * 8 + wave_id(), nw = gridDim.x * 8;
    for (int i0 = gw * 4; i0 < NTOK * 2; i0 += nw * 4) {
        int sl[4]; u32x4 a[4], b[4];
#pragma unroll
        for (int q = 0; q < 4; ++q) sl[q] = tb[EID[i0 + q]] + POS[i0 + q];
#pragma unroll
        for (int q = 0; q < 4; ++q) { const u32x4* src = (const u32x4*)(H + (size_t)((i0 + q) >> 1) * 1024); a[q] = src[lane]; b[q] = src[64 + lane]; }
#pragma unroll
        for (int q = 0; q < 4; ++q) { if (lane == 0) SLOT[i0 + q] = sl[q]; u32x4* dst = (u32x4*)(HG + (size_t)sl[q] * 1024); dst[lane] = a[q]; dst[64 + lane] = b[q]; }
    }
    for (int e = 0; e < 64; ++e) {
        const int c = tb[e] + tb[576 + e], n = tb[64 + e] - tb[576 + e];
        const unsigned z0 = (unsigned)tidx() >> 20;
        for (int r = gw; r < n; r += nw) { u32x4* dst = (u32x4*)(HG + (size_t)(c + r) * 1024); dst[lane] = (u32x4){z0, z0, z0, z0}; dst[64 + lane] = (u32x4){z0, z0, z0, z0}; }
    }
}
struct UnitsMoe1 { const bf16_t* W13; bf16_t* HM; const int* tb; int bid, nb, nunit;
    struct Info { size_t a; const bf16_t* b; bf16_t* o; };
    __device__ __forceinline__ bool get(int i, Info& u) const { const int t0 = bid + i * nb; if (t0 >= nunit) return false; const int t = xcd_remap(t0, nunit), rt = t >> 2, pn = t & 3; const int e = __builtin_amdgcn_readfirstlane(tb[192 + rt]);
        u.a = (size_t)rt * 256 * 1024; u.b = W13 + ((size_t)e * 1024 + pn * 256) * 1024; u.o = HM + (size_t)rt * 256 * 512 + pn * 128; return true; }
    __device__ __forceinline__ void epi(const f32x4 (&acc)[2][2][4][2], const Info& u, int wr, int wc, int fr, int fq) const { EpiSwiglu e{u.o}; e(acc, wr, wc, fr, fq); } };
__device__ __forceinline__ void ph_moe1(const Params& p) {
    unsigned char* ws = p.ws;
    moe_table(p);
    const int* tb = (const int*)(smem + MOE_TBL);
    UnitsMoe1 un{(const bf16_t*)(ws + WS_W13), (bf16_t*)(ws + WS_HMID), tb, bidx(), (int)gridDim.x, tb[128] * 4};
    gemm_stream<1024, 1024, 1024>((const bf16_t*)(ws + WS_HG), un);
}
struct UnitsMoe2 { const bf16_t* W2; bf16_t* YE; const int* tb; int bid, nb, nunit;
    struct Info { size_t a; const bf16_t* b; bf16_t* o; };
    __device__ __forceinline__ bool get(int i, Info& u) const { const int t0 = bid + i * nb; if (t0 >= nunit) return false; const int t = xcd_remap(t0, nunit), rt = t >> 2, pn = t & 3; const int e = __builtin_amdgcn_readfirstlane(tb[192 + rt]);
        u.a = (size_t)rt * 256 * 512; u.b = W2 + ((size_t)e * 1024 + pn * 256) * 512; u.o = YE + (size_t)rt * 256 * 1024 + pn * 256; return true; }
    __device__ __forceinline__ void epi(const f32x4 (&acc)[2][2][4][2], const Info& u, int wr, int wc, int fr, int fq) const { EpiBf16Store e{u.o, 1024}; e(acc, wr, wc, fr, fq); } };
__device__ __forceinline__ void ph_moe2(const Params& p) {
    unsigned char* ws = p.ws;
    moe_table(p);
    const int* tb = (const int*)(smem + MOE_TBL);
    UnitsMoe2 un{(const bf16_t*)(ws + WS_W2), (bf16_t*)(ws + WS_YEXP), tb, bidx(), (int)gridDim.x, tb[128] * 4};
    gemm_stream<512, 512, 512>((const bf16_t*)(ws + WS_HMID), un);
}

__device__ __forceinline__ void ph_final(const Params& p) {
    unsigned char* ws = p.ws;
    const bf16_t* X = (const bf16_t*)(ws + WS_X); const float* mods = (const float*)(ws + WS_MODS);
    const int* SLOT = (const int*)(ws + WS_SLOT); const float* GATE = (const float*)(ws + WS_GATE); const bf16_t* YE = (const bf16_t*)(ws + WS_YEXP);
    const int lane = tidx() & 63, gw = bidx() * 8 + wave_id(), nw = gridDim.x * 8;
    float* par = (float*)smem;
    __syncthreads();
    for (int i = tidx(); i < 3 * 1024; i += NTHREADS) { const int k = i >> 10, c = i & 1023; par[i] = k < 2 ? mods[(3 * 3 + k) * 6144 + 5 * 1024 + c] : p.final_norm_w[c]; }
    __syncthreads();
    for (int row = gw; row < NLAT; row += nw) {
        const int set = row_set(row);
        const float* g2 = par + set * 1024;
        const int s0 = SLOT[row * 2], s1 = SLOT[row * 2 + 1]; const float ga = GATE[row * 2], gb = GATE[row * 2 + 1];
        f32x4 v[4]; float ss = 0.f;
#pragma unroll
        for (int i = 0; i < 4; ++i) { const int col = i * 256 + lane * 4;
            v[i] = ld4bf(X + (size_t)row * 1024 + col);
            const u32x2 ya = *(const u32x2*)(YE + (size_t)s0 * 1024 + col), yb = *(const u32x2*)(YE + (size_t)s1 * 1024 + col);
            const f32x4 gg = *(const f32x4*)(g2 + col);
            v[i][0] += gg[0] * (ga * __uint_as_float(ya[0] << 16) + gb * __uint_as_float(yb[0] << 16));
            v[i][1] += gg[1] * (ga * __uint_as_float(ya[0] & 0xffff0000u) + gb * __uint_as_float(yb[0] & 0xffff0000u));
            v[i][2] += gg[2] * (ga * __uint_as_float(ya[1] << 16) + gb * __uint_as_float(yb[1] << 16));
            v[i][3] += gg[3] * (ga * __uint_as_float(ya[1] & 0xffff0000u) + gb * __uint_as_float(yb[1] & 0xffff0000u));
            ss += v[i][0] * v[i][0] + v[i][1] * v[i][1] + v[i][2] * v[i][2] + v[i][3] * v[i][3]; }
        ss = wave_sum(ss);
        const float rs = rsqrtf(ss * (1.f / 1024.f) + NORM_EPS);
#pragma unroll
        for (int i = 0; i < 4; ++i) { const int col = i * 256 + lane * 4; const f32x4 w = *(const f32x4*)(par + 2048 + col);
            f32x4 o; o[0] = v[i][0] * rs * w[0]; o[1] = v[i][1] * rs * w[1]; o[2] = v[i][2] * rs * w[2]; o[3] = v[i][3] * rs * w[3];
            *(f32x4*)(p.out + (size_t)row * 1024 + col) = o; }
    }
}
struct WQ { unsigned* ctr; int pend; };
__device__ __forceinline__ void wq_init(WQ& q, unsigned* ctr) { q.ctr = ctr; q.pend = 0; if (tidx() == 0) q.pend = (int)__hip_atomic_fetch_add(ctr, 1u, __ATOMIC_RELAXED, __HIP_MEMORY_SCOPE_AGENT); }
__device__ __forceinline__ int wq_next(WQ& q) {
    volatile LAS int* slot = (volatile LAS int*)(LAS unsigned char*)(smem + LDS_MISC + 32);
    __syncthreads();
    if (tidx() == 0) { *slot = q.pend; q.pend = (int)__hip_atomic_fetch_add(q.ctr, 1u, __ATOMIC_RELAXED, __HIP_MEMORY_SCOPE_AGENT); }
    __syncthreads();
    return __builtin_amdgcn_readfirstlane(*slot);
}
__device__ __forceinline__ unsigned* wq_ctr(const Params& p, int L, int k) { return (unsigned*)(p.ws + WS_MISC) + 1024 + L * 16 + k; }

__device__ __forceinline__ void ph_mixA(const Params& p, int L) {
    unsigned char* ws = p.ws;
    const bf16_t* U = (const bf16_t*)(ws + WS_U); const bf16_t* W = (const bf16_t*)(ws + WS_WUP) + (size_t)L * UPW * UPK; bf16_t* QU = (bf16_t*)(ws + WS_QKVUP);
    constexpr int NS = SSD_UNITS, NR = RW_UNITS_PREP, NG = 130 * 6;
    WQ wq; wq_init(wq, wq_ctr(p, L, 0));
    int u = wq_next(wq);
    for (; u < NS; u = wq_next(wq)) QREP(1) { QSYNC ssd_pass1_unit(p, L, u); }
    for (; u < NS + NR; u = wq_next(wq)) QREP(2) { QSYNC rwkv_prep_unit(p, L, u - NS); }
    for (; u < NS + NR + NG; u = wq_next(wq)) QREP(3) { const int v = u - NS - NR, pm = v / 6, pn = v % 6; QSYNC
        ARowLin<UW> ar{(size_t)pm * 256 * UW + U_QD};
        EpiBf16Store ep{QU + (size_t)pm * 256 * UPW + pn * 256, UPW};
        gemm256<UPK, UPK>(U, ar, W + (size_t)pn * 256 * UPK, ep);
    }
}
__device__ __forceinline__ void ph_mixB(const Params& p, int L) {
    constexpr int NA = RW_UNITS, NM = NTOK / 32, NSC = (2 * 2 * 6 * 128 * 64) / NTHREADS;
    WQ wq; wq_init(wq, wq_ctr(p, L, 1));
    int u = wq_next(wq);
#if RW_UT
    for (; u < NA; u = wq_next(wq)) QREP(4) rwkv_ut_unit(p, u);
#else
    for (; u < NA; u = wq_next(wq)) rwkv_passA_unit(p, u);
#endif
    for (; u < NA + NM; u = wq_next(wq)) ph_mla_prep_rows(p, (u - NA) * 32, (u - NA) * 32 + 32, wave_id(), 8);
    for (; u < NA + NM + NSC; u = wq_next(wq)) ssd_scan_range(p, (u - NA - NM) * NTHREADS + tidx(), 0x40000000);
}
__device__ __forceinline__ void ph_mixD(const Params& p, int L) {
    unsigned char* ws = p.ws;
    const bf16_t* Q = (const bf16_t*)(ws + WS_Q); const bf16_t* Kb = (const bf16_t*)(ws + WS_K); const bf16_t* Vb = (const bf16_t*)(ws + WS_V); bf16_t* MIX = (bf16_t*)(ws + WS_MIX);
    unsigned* flag = (unsigned*)(ws + WS_MISC) + 1200 + L;
    if (bidx() < 64 && wave_id() == 0) {
        rwkv_passB_wave(p, bidx());
        asm volatile("s_waitcnt vmcnt(0)" ::: "memory");
        __builtin_amdgcn_fence(__ATOMIC_RELEASE, "agent");
        asm volatile("s_waitcnt vmcnt(0)" ::: "memory");
        if ((tidx() & 63) == 0) __hip_atomic_fetch_add(flag, 1u, __ATOMIC_RELAXED, __HIP_MEMORY_SCOPE_AGENT);
    }
    constexpr int NS = SSD_UNITS, NA = 768, NC = 12, NR = RW_UNITS / 2;
    WQ wq; wq_init(wq, wq_ctr(p, L, 3));
    int u = wq_next(wq);
    for (; u < NS; u = wq_next(wq)) QREP(7) { QSYNC ssd_pass3_unit(p, L, u); }
#ifdef PROBE_ATT
    for (int rep = 0; rep <= PROBE_ATT; ++rep) { const int samet = (rep < PROBE_ATT) && PROBE_ATT_SAME;
      for (int a = bidx(); a < NA + NC; a += gridDim.x) {
        int b, h, row0, seq;
        if (a < NA) { b = a / 384; h = (a / 64) % 6; row0 = b * SEQ + (a % 64) * 256; seq = KEYS; }
        else { const int c = a - NA; b = c / 6; h = c % 6; row0 = NLAT + b * CTXL; seq = CTXL; }
        __syncthreads();
        att::attn_body(Q + (size_t)row0 * 576 + h * 96, Kb + (size_t)(b * 6 + h) * KEYS * 96, Vb + (size_t)(b * 6 + h) * KEYS * 64,
                       MIX + (size_t)row0 * 1024 + 384 + h * 64, seq, (char*)smem, samet); } }
    u += NA + NC;
#define wq_next(c) (wq_next(c) + NA + NC)
#else
    for (; u < NS + NA + NC; u = wq_next(wq)) { const int a = u - NS;
        int b, h, row0, seq;
        if (a < NA) { b = a / 384; h = (a / 64) % 6; row0 = b * SEQ + (a % 64) * 256; seq = KEYS; }
        else { const int c = a - NA; b = c / 6; h = c % 6; row0 = NLAT + b * CTXL; seq = CTXL; }
        att::attn_body(Q + (size_t)row0 * 576 + h * 96, Kb + (size_t)(b * 6 + h) * KEYS * 96, Vb + (size_t)(b * 6 + h) * KEYS * 64,
                       MIX + (size_t)row0 * 1024 + 384 + h * 64, seq, (char*)smem);
    }
#endif
    if (u < NS + NA + NC + NR) {
        if (tidx() == 0) { unsigned sp = 0;
            while (__hip_atomic_load(flag, __ATOMIC_RELAXED, __HIP_MEMORY_SCOPE_AGENT) < 64u) { __builtin_amdgcn_s_sleep(2); if (++sp > (1u << 22)) break; }
            __builtin_amdgcn_fence(__ATOMIC_ACQUIRE, "agent");
            asm volatile("s_waitcnt vmcnt(0)" ::: "memory"); }
        __syncthreads();
    }
    for (; u < NS + NA + NC + NR; u = wq_next(wq)) rwkv_passC_unit(p, L, u - NS - NA - NC);
#ifdef PROBE_ATT
#undef wq_next
#endif
}

__device__ __forceinline__ void ph_moe_convert(const Params& p, int L) {
    constexpr int G = 4, NI = (MOE_CV_N13 + MOE_CV_N2) / G;
    WQ wq; wq_init(wq, wq_ctr(p, L, 4));
    for (int it = wq_next(wq); it < NI; it = wq_next(wq))
#pragma unroll 1
        for (int u = it * G; u < it * G + G; ++u) moe_convert_tile(p, L, u);
}
constexpr int PH_PER_LAYER = 10, PH_TOTAL = 2 + 4 * PH_PER_LAYER;
typedef const __attribute__((address_space(4))) Params* KParams;
__device__ __forceinline__ KParams kp_launder() { KParams q = (KParams)__builtin_amdgcn_kernarg_segment_ptr(); asm volatile("" : "+s"(q)); return q; }
#ifndef PROBE_REP_PH
#define PROBE_REP_PH (-1)
#define PROBE_REP_N 1
#endif
#define PHASE(k, call) do { if (lo <= (k) && (k) < hi) { const int nrep_ = (PROBE_REP_PH >= 0 && (k) >= 1 && ((k) - 1) % PH_PER_LAYER == PROBE_REP_PH && (k) < PH_TOTAL - 1) ? PROBE_REP_N : 1; \
    for (int rep_ = 0; rep_ < nrep_; ++rep_) { { const Params p = *(const Params*)kp_launder(); call; } if ((k) + 1 < hi) xcd_barrier(bar); \
        if (nrep_ > 1) { if (bidx() == 0 && tidx() < 64) ((unsigned*)(p_.ws + WS_MISC))[1024 + tidx()] = 0u; xcd_barrier(bar); } } } } while (0)
__global__ void __launch_bounds__(NTHREADS, 2) mega(Params p_) {
    volatile LAS unsigned* st = (volatile LAS unsigned*)(LAS unsigned char*)(smem + LDS_MISC);
    if (threadIdx.x < 4) st[threadIdx.x] = 0u;
    __syncthreads();
    const int lo = (int)p_.ph_lo, hi = (int)p_.ph_hi;
    XcdBarrier bar; bar.bar = (unsigned*)(p_.ws + WS_BAR); bar.x = 0; bar.st = st;
    if (hi - lo > 1) bar = xcd_barrier_post((unsigned*)(p_.ws + WS_BAR), st);
    PHASE(0, ph_prologue(p));
#ifdef PROBE_DUP
#define DUP(k, idx, call) do { if ((idx) == PROBE_DUP) { xcd_barrier(bar); if (bidx() == 0 && tidx() < 64) ((unsigned*)(p_.ws + WS_MISC))[1024 + tidx()] = 0u; xcd_barrier(bar); { const Params p = *(const Params*)kp_launder(); call; } xcd_barrier(bar); } } while (0)
#else
#define DUP(k, idx, call) do { } while (0)
#endif
    for (int L = 0; L < DEPTH; ++L) {
        const int pb = 1 + PH_PER_LAYER * L;
        PHASE(pb + 0, ph_norm1(p, L));
        PHASE(pb + 1, ph_gemm_in(p, L)); DUP(pb + 1, 1, ph_gemm_in(p, L));
        PHASE(pb + 2, ph_mixA(p, L)); DUP(pb + 2, 2, ph_mixA(p, L));
        PHASE(pb + 3, ph_mixB(p, L)); DUP(pb + 3, 3, ph_mixB(p, L));
        PHASE(pb + 4, ph_mixD(p, L)); DUP(pb + 4, 4, ph_mixD(p, L));
        PHASE(pb + 5, (ph_gemm_out(p, L), ph_moe_convert(p, L)));
        PHASE(pb + 6, ph_norm2_router(p, L));
        PHASE(pb + 7, ph_slots(p)); DUP(pb + 7, 8, ph_slots(p));
        PHASE(pb + 8, ph_moe1(p)); DUP(pb + 8, 9, ph_moe1(p));
        PHASE(pb + 9, ph_moe2(p)); DUP(pb + 9, 10, ph_moe2(p));
    }
    PHASE(PH_TOTAL - 1, ph_final(p));
#ifdef PROBE_PH
    for (int r = 0; r < PROBE_N; ++r) { xcd_barrier(bar); if (bidx() == 0 && tidx() < 64) ((unsigned*)(p_.ws + WS_MISC))[1024 + tidx()] = 0u; xcd_barrier(bar); const Params p = *(const Params*)kp_launder(); const int L = 3;
        if (PROBE_PH == 0) ph_norm1(p, L); if (PROBE_PH == 1) ph_gemm_in(p, L); if (PROBE_PH == 2) ph_mixA(p, L); if (PROBE_PH == 3) ph_mixB(p, L);
        if (PROBE_PH == 5) ph_mixD(p, L); if (PROBE_PH == 7) ph_gemm_out(p, L);
        if (PROBE_PH == 8) ph_norm2_router(p, L); if (PROBE_PH == 9) ph_slots(p); if (PROBE_PH == 10) ph_moe1(p); if (PROBE_PH == 11) ph_moe2(p);
        if (PROBE_PH == 12) ph_moe_convert(p, L); if (PROBE_PH == 13) ph_prologue(p);
        if (PROBE_PH == 14) { for (int u = bidx(); u < SSD_UNITS; u += gridDim.x) { __syncthreads(); ssd_pass1_unit(p, L, u); } }
        if (PROBE_PH == 15) { for (int u = bidx(); u < RW_UNITS_PREP; u += gridDim.x) { __syncthreads(); rwkv_prep_unit(p, L, u); } }
        if (PROBE_PH == 16) { for (int u = bidx(); u < SSD_UNITS; u += gridDim.x) { __syncthreads(); ssd_pass3_unit(p, L, u); } }
        if (PROBE_PH == 17) { for (int u = bidx(); u < RW_UNITS / 2; u += gridDim.x) { __syncthreads(); rwkv_passC_unit(p, L, u); } }
        if (PROBE_PH == 18) { ph_mla_prep_rows(p, 0, NTOK, bidx() * 8 + wave_id(), gridDim.x * 8); }
        if (PROBE_PH == 19) { ssd_scan_range(p, bidx() * NTHREADS + tidx(), gridDim.x * NTHREADS); }
        if (PROBE_PH == 20) { for (int u = bidx(); u < RW_UNITS; u += gridDim.x) { __syncthreads(); rwkv_ut_unit(p, u); } } }
#endif
}

extern "C" void kernel_launch(void* const* d_in, const int* in_sizes, int n_in, void* d_out, int out_size, void* d_ws, size_t ws_size, hipStream_t stream) {
    static int grid = 0;
    if (grid == 0) {
        if (n_in != 39 || in_sizes[0] != NLAT * DM || out_size != NLAT * DM || ws_size < WS_END) {
            fprintf(stderr, "kernel_launch: shape mismatch: n_in %d in0 %d out %d ws %zu (need %zu)\n", n_in, n_in > 0 ? in_sizes[0] : -1, out_size, ws_size, (size_t)WS_END); grid = -1; return; }
        int dev = 0, cus = 0, per_cu = 0;
        if (hipGetDevice(&dev) != hipSuccess || hipDeviceGetAttribute(&cus, hipDeviceAttributeMultiprocessorCount, dev) != hipSuccess) { fprintf(stderr, "kernel_launch: device query failed\n"); grid = -1; return; }
        if (hipFuncSetAttribute((const void*)mega, hipFuncAttributeMaxDynamicSharedMemorySize, LDS_BYTES) != hipSuccess) { fprintf(stderr, "kernel_launch: hipFuncSetAttribute failed\n"); grid = -1; return; }
        if (hipOccupancyMaxActiveBlocksPerMultiprocessor(&per_cu, (const void*)mega, NTHREADS, LDS_BYTES) != hipSuccess || per_cu < 1)
            fprintf(stderr, "kernel_launch: occupancy query reports %d workgroups per CU\n", per_cu);
        (void)hipGetLastError();
        grid = cus;
    }
    if (grid < 0) return;
    if (hipMemsetAsync((char*)d_ws + WS_BAR, 0, 32768, stream) != hipSuccess) { fprintf(stderr, "kernel_launch: memset failed\n"); return; }
    Params p{};
    { const float** pp = (const float**)&p; for (int i = 0; i < 39; ++i) pp[i] = (const float*)d_in[i]; }
    p.out = (float*)d_out; p.ws = (unsigned char*)d_ws;
#if MK_MULTI
    for (int k = 0; k < PH_TOTAL; ++k) {
        p.ph_lo = k; p.ph_hi = k + 1;
        hipLaunchKernelGGL(mega, dim3(grid), dim3(NTHREADS), LDS_BYTES, stream, p);
    }
#else
    p.ph_lo = 0; p.ph_hi = PH_TOTAL;
    hipLaunchKernelGGL(mega, dim3(grid), dim3(NTHREADS), LDS_BYTES, stream, p);
#endif
    const hipError_t le = hipPeekAtLastError();
    if (le != hipSuccess) fprintf(stderr, "kernel_launch: launch failed: %s\n", hipGetErrorName(le));
}
```

```cpp
#include <hip/hip_runtime.h>
#include <cstdio>
#include <cstdint>

#ifndef RW_UT
#define RW_UT 1
#endif
#ifndef MK_MULTI
#define MK_MULTI 0
#endif

typedef unsigned short bf16_t;
typedef short bf16x8 __attribute__((ext_vector_type(8)));
typedef short s16x4 __attribute__((ext_vector_type(4)));
typedef float f32x4 __attribute__((ext_vector_type(4)));
typedef float f32x16 __attribute__((ext_vector_type(16)));
typedef unsigned u32x4 __attribute__((ext_vector_type(4)));
typedef unsigned u32x2 __attribute__((ext_vector_type(2)));

constexpr int DM = 1024, NBATCH = 2, SEQ = 16384, DEPTH = 4, CTXL = 256;
constexpr int NLAT = NBATCH * SEQ;
constexpr int NCTX = NBATCH * CTXL;
constexpr int NTOK = NLAT + NCTX;
constexpr int KEYS = CTXL + SEQ;
constexpr int IN_W = 2796;
constexpr int UW = 2816;
constexpr int U_Z = 0, U_XBC = 384, U_QD = 1280, U_KVD = 1472, U_KR = 1600, U_DT = 1632, U_RW = 1664;
constexpr int UPW = 1536;
constexpr int UPK = 384;
constexpr int NTHREADS = 512;
constexpr int LDS_BYTES = 147456;
constexpr int LDS_MISC = LDS_BYTES - 256;
constexpr float NORM_EPS = 1e-6f;

constexpr size_t al256(size_t x) { return (x + 255) / 256 * 256; }
constexpr size_t WS_BAR   = 0;
constexpr size_t WS_MISC  = 16384;
constexpr size_t WS_MODS  = 32768;
constexpr size_t WS_WRT   = WS_MODS + al256((size_t)4 * 3 * 6144 * 4);
constexpr size_t WS_WRH   = WS_WRT + al256((size_t)4 * 72 * 1024 * 4);
constexpr size_t WS_WIN   = WS_WRH + (size_t)4 * 2 * 80 * 1024 * 2;
constexpr size_t WS_WOUT  = WS_WIN + (size_t)4 * UW * 1024 * 2;
constexpr size_t WS_WUP   = WS_WOUT + (size_t)4 * 1024 * 1024 * 2;
constexpr size_t WS_WLORA = WS_WUP + (size_t)4 * UPW * UPK * 2;
constexpr size_t WS_W13   = WS_WLORA + (size_t)4 * 98304 * 2;
constexpr size_t WS_W2    = WS_W13 + (size_t)64 * 1024 * 1024 * 2;
constexpr size_t WS_X     = WS_W2 + (size_t)64 * 1024 * 512 * 2;
constexpr size_t WS_H     = WS_X + (size_t)NTOK * 1024 * 4;
constexpr size_t WS_U     = WS_H + (size_t)NTOK * 1024 * 2;
constexpr size_t WS_MIX   = WS_U + (size_t)NTOK * UW * 2;
constexpr size_t WS_R0    = WS_MIX + (size_t)NTOK * 1024 * 2;
constexpr size_t WS_QKVUP = WS_R0;
constexpr size_t WS_Q     = WS_QKVUP + (size_t)NTOK * UPW * 2;
constexpr size_t WS_K     = WS_Q + (size_t)NTOK * 576 * 2;
constexpr size_t WS_V     = WS_K + (size_t)2 * 6 * KEYS * 96 * 2;
constexpr size_t WS_SST   = WS_V + (size_t)2 * 6 * KEYS * 64 * 2;
constexpr size_t WS_SDEC  = WS_SST + (size_t)2 * 2 * 130 * 6 * 128 * 64 * 4;
constexpr size_t WS_YS    = WS_SDEC + al256((size_t)2 * 2 * 130 * 8 * 4);
constexpr size_t WS_RWP   = WS_YS + (size_t)2 * NTOK * 384 * 4;
constexpr size_t WS_RPQ   = WS_RWP + (size_t)NTOK * 11 * 256 * 4;
constexpr size_t WS_RS0   = WS_RPQ + (size_t)2 * 2 * 260 * 4 * 2 * 4096 * 4;
constexpr size_t WS_YR    = WS_RS0 + (size_t)2 * 2 * 260 * 4 * 4096 * 4;
constexpr size_t WS_RY    = WS_YR + (size_t)2 * NTOK * 256 * 4;
constexpr size_t WS_SSTB  = WS_RY + (size_t)2 * 2 * 260 * 4 * 2 * 4096 * 4;
constexpr size_t WS_MIXEND= WS_SSTB + (size_t)2 * 2 * 130 * 6 * 64 * 128 * 2;
constexpr int MOE_MAXROWS = 83200;
constexpr size_t WS_EID   = WS_R0;
constexpr size_t WS_POS   = WS_EID + al256((size_t)NTOK * 2 * 4);
constexpr size_t WS_GATE  = WS_POS + al256((size_t)NTOK * 2 * 4);
constexpr size_t WS_SLOT  = WS_GATE + al256((size_t)NTOK * 2 * 4);
constexpr size_t WS_HG    = WS_SLOT + al256((size_t)NTOK * 2 * 4);
constexpr size_t WS_HMID  = WS_HG + (size_t)MOE_MAXROWS * 1024 * 2;
constexpr size_t WS_YEXP  = WS_HMID + (size_t)MOE_MAXROWS * 512 * 2;
constexpr size_t WS_MOEEND= WS_YEXP + (size_t)MOE_MAXROWS * 1024 * 2;
constexpr size_t WS_END   = WS_MIXEND > WS_MOEEND ? WS_MIXEND : WS_MOEEND;

struct Params {
    const float *x, *c, *ctx, *c_ctx, *mod_w, *mod_b, *norm1_w, *norm2_w, *w_in, *ssd_conv_w, *ssd_conv_b, *ssd_dt_bias,
        *ssd_a_log, *ssd_d, *ssd_norm_w, *mla_q_norm_w, *mla_w_uq, *mla_kv_norm_w, *mla_w_ukv, *rwkv_shift_w,
        *rwkv_w0, *rwkv_w2, *rwkv_a0, *rwkv_a2, *rwkv_g2, *rwkv_k_k, *rwkv_k_a, *rwkv_r_k, *rwkv_ln_w, *rwkv_ln_b,
        *w_out, *moe_w_rg, *moe_b_rg, *moe_w_re, *moe_b_re, *moe_w1, *moe_w3, *moe_w2, *final_norm_w;
    float* out;
    unsigned char* ws;
    long long ph_lo, ph_hi;
};

#define LAS __attribute__((address_space(3)))
extern __shared__ __attribute__((aligned(16))) unsigned char smem[];

__device__ __forceinline__ float bf2f(bf16_t v) { return __uint_as_float(((unsigned)v) << 16); }
__device__ __forceinline__ bf16_t f2bf(float f) { unsigned u = __float_as_uint(f); u += 0x7fffu + ((u >> 16) & 1u); return (bf16_t)(u >> 16); }
__device__ __forceinline__ unsigned cvtpk_bf16(float lo, float hi) { unsigned r; asm volatile("v_cvt_pk_bf16_f32 %0, %1, %2" : "=v"(r) : "v"(lo), "v"(hi)); return r; }
__device__ __forceinline__ f32x4 ld4bf(const bf16_t* p) { const u32x2 u = *(const u32x2*)p; f32x4 v = {__uint_as_float(u[0] << 16), __uint_as_float(u[0] & 0xffff0000u), __uint_as_float(u[1] << 16), __uint_as_float(u[1] & 0xffff0000u)}; return v; }
__device__ __forceinline__ void st4bf(bf16_t* p, const f32x4& v) { u32x2 o = {cvtpk_bf16(v[0], v[1]), cvtpk_bf16(v[2], v[3])}; *(u32x2*)p = o; }
__device__ __forceinline__ unsigned pack2bf(float lo, float hi) { return (unsigned)f2bf(lo) | ((unsigned)f2bf(hi) << 16); }
__device__ __forceinline__ float dpp_add(float v, const int ctrl_sel) {
    int r;
    if (ctrl_sel == 0) r = __builtin_amdgcn_update_dpp(0, __float_as_int(v), 0xB1, 0xF, 0xF, true);
    else if (ctrl_sel == 1) r = __builtin_amdgcn_update_dpp(0, __float_as_int(v), 0x4E, 0xF, 0xF, true);
    else if (ctrl_sel == 2) r = __builtin_amdgcn_update_dpp(0, __float_as_int(v), 0x141, 0xF, 0xF, true);
    else r = __builtin_amdgcn_update_dpp(0, __float_as_int(v), 0x140, 0xF, 0xF, true);
    return v + __int_as_float(r);
}
__device__ __forceinline__ float row16_sum(float v) { v = dpp_add(v, 0); v = dpp_add(v, 1); v = dpp_add(v, 2); v = dpp_add(v, 3); return v; }
__device__ __forceinline__ float wave_sum(float v) {
    v = row16_sum(v);
    v += __int_as_float(__builtin_amdgcn_ds_swizzle(__float_as_int(v), 0x401F));
    { auto rr = __builtin_amdgcn_permlane32_swap(__float_as_uint(v), __float_as_uint(v), false, false);
      v = __uint_as_float(rr[0]) + __uint_as_float(rr[1]); }
    return v;
}
__device__ __forceinline__ float wave_scan_incl(float v) {
    v += __int_as_float(__builtin_amdgcn_update_dpp(0, __float_as_int(v), 0x111, 0xF, 0xF, true));
    v += __int_as_float(__builtin_amdgcn_update_dpp(0, __float_as_int(v), 0x112, 0xF, 0xF, true));
    v += __int_as_float(__builtin_amdgcn_update_dpp(0, __float_as_int(v), 0x114, 0xF, 0xF, true));
    v += __int_as_float(__builtin_amdgcn_update_dpp(0, __float_as_int(v), 0x118, 0xF, 0xF, true));
    v += __int_as_float(__builtin_amdgcn_update_dpp(0, __float_as_int(v), 0x142, 0xA, 0xF, false));
    v += __int_as_float(__builtin_amdgcn_update_dpp(0, __float_as_int(v), 0x143, 0xC, 0xF, false));
    return v;
}
__device__ __forceinline__ float silu_f(float x) { return x * __builtin_amdgcn_rcpf(1.f + __expf(-x)); }
__device__ __forceinline__ float sigmoid_f(float x) { return __builtin_amdgcn_rcpf(1.f + __expf(-x)); }
__device__ __forceinline__ float softplus_f(float x) { return x > 15.f ? x : __logf(1.f + __expf(x)); }
__device__ __forceinline__ float tanh_f(float x) { const float e = __expf(-2.f * fabsf(x)); const float t = (1.f - e) * __builtin_amdgcn_rcpf(1.f + e); return x < 0.f ? -t : t; }
__device__ __forceinline__ int tidx() { int t = threadIdx.x; asm volatile("" : "+v"(t)); return t; }
__device__ __forceinline__ int bidx() { int b = blockIdx.x; asm volatile("" : "+s"(b)); return b; }
__device__ __forceinline__ int wave_id() { return __builtin_amdgcn_readfirstlane(tidx() >> 6); }

__device__ __forceinline__ int row_set(int row) { return row < NLAT ? (row >> 14) : 2; }
__device__ __forceinline__ void row_seq(int row, int& base, int& pos, int& len) {
    if (row < NLAT) { base = row & ~16383; pos = row & 16383; len = SEQ; }
    else { const int r = row - NLAT; base = NLAT + (r & ~255); pos = r & 255; len = CTXL; }
}

#define XB_TMO      128
#define XB_XCNT(j)  (256  + 64 * (j))
#define XB_XSUB(j)  (1280 + 64 * (j))
#define XB_XGEN(j)  (2304 + 64 * (j))
#define XB_TOP      3328
#define XB_TOPGEN   3392
#define XCD_BAR_WORDS 3456
#define XB_SPIN_CAP (1u << 18)

__device__ __forceinline__ unsigned xb_ld(unsigned* p)              { return __hip_atomic_load(p, __ATOMIC_RELAXED, __HIP_MEMORY_SCOPE_AGENT); }
__device__ __forceinline__ unsigned xb_add(unsigned* p, unsigned v) { return __hip_atomic_fetch_add(p, v, __ATOMIC_RELAXED, __HIP_MEMORY_SCOPE_AGENT); }
__device__ __forceinline__ unsigned xb_xcc_id() { return (unsigned)__builtin_amdgcn_s_getreg((3 << 11) | 20) & 0xFu; }
#define XB_SPIN(cond, bar) do { unsigned _sp = 0; while (cond) { __builtin_amdgcn_s_sleep(1); \
    if ((++_sp & 255u) == 0u) { if (xb_ld(&(bar)[XB_TMO])) break; if (_sp > XB_SPIN_CAP) { atomicAdd(&(bar)[XB_TMO], 1u); break; } } } } while (0)

struct XcdBarrier { unsigned* bar; unsigned x; volatile LAS unsigned* st; };

__device__ __forceinline__ XcdBarrier xcd_barrier_post(unsigned* bar, volatile LAS unsigned* st) {
    XcdBarrier b; b.bar = bar; b.x = xb_xcc_id(); b.st = st;
    if (threadIdx.x == 0) (void)xb_add(&bar[XB_XCNT(b.x)], 1u);
    return b;
}
__device__ __forceinline__ void xcd_barrier_complete(unsigned* bar, unsigned x, unsigned& nloc, unsigned& nx) {
    const unsigned G = gridDim.x * gridDim.y * gridDim.z;
    unsigned sum, cnt, mine, sp = 0u;
    for (;;) {
        sum = 0u; cnt = 0u; mine = 0u;
#pragma unroll
        for (unsigned j = 0; j < 16; ++j) { const unsigned c = xb_ld(&bar[XB_XCNT(j)]); sum += c; cnt += (c > 0u) ? 1u : 0u; mine = (j == x) ? c : mine; }
        if (sum == G) break;
        __builtin_amdgcn_s_sleep(1);
        if ((++sp & 255u) == 0u) { if (xb_ld(&bar[XB_TMO])) break; if (sp > XB_SPIN_CAP) { atomicAdd(&bar[XB_TMO], 1u); break; } }
    }
    nloc = mine > 0u ? mine : 1u; nx = cnt > 0u ? cnt : 1u;
}
__device__ __forceinline__ void xcd_barrier(const XcdBarrier& b) {
    asm volatile("s_waitcnt vmcnt(0)" ::: "memory");
    __syncthreads();
    if (threadIdx.x == 0) {
        unsigned* bar = b.bar; unsigned bx = b.x;
        asm volatile("" : "+s"(bar), "+s"(bx));
        __builtin_amdgcn_s_waitcnt(0);
        unsigned nloc = b.st[0], nx = b.st[1];
        if (nloc == 0u) { xcd_barrier_complete(bar, bx, nloc, nx); b.st[0] = nloc; b.st[1] = nx; }
        const unsigned old = xb_add(&bar[XB_XSUB(bx)], 1u);
        const unsigned gen = old / nloc;
        if (old + 1u == (gen + 1u) * nloc) {
            __builtin_amdgcn_fence(__ATOMIC_RELEASE, "agent");
            asm volatile("s_waitcnt vmcnt(0)" ::: "memory");
            const unsigned og = xb_add(&bar[XB_TOP], 1u);
            const unsigned tg = og / nx;
            if (og + 1u == (tg + 1u) * nx) xb_add(&bar[XB_TOPGEN], 1u);
            else XB_SPIN(xb_ld(&bar[XB_TOPGEN]) == tg, bar);
            __builtin_amdgcn_fence(__ATOMIC_ACQUIRE, "agent");
            xb_add(&bar[XB_XGEN(bx)], 1u);
            asm volatile("s_waitcnt vmcnt(0)" ::: "memory");
        } else {
            XB_SPIN(xb_ld(&bar[XB_XGEN(bx)]) == gen, bar);
            __builtin_amdgcn_fence(__ATOMIC_ACQUIRE, "agent");
            asm volatile("s_waitcnt vmcnt(0)" ::: "memory");
        }
    }
    __syncthreads();
}

#ifdef PROBE_KIND
__device__ __forceinline__ int qrep(int kind) { int r = (kind == PROBE_KIND) ? 2 : 1; asm volatile("" : "+s"(r)); return r; }
#define QREP(kind) for (int rep_ = 0, nrep_ = qrep(kind); rep_ < nrep_; ++rep_)
#define QSYNC __syncthreads();
#else
#define QREP(kind)
#define QSYNC
#endif
constexpr int G_BK = 64, G_HALF = 128, G_HT = G_HALF * G_BK;

__device__ __forceinline__ int lds_byte(int r, int c) { const int st = (r >> 4) * 2 + (c >> 5), rr = r & 15, cc = c & 31, ob = rr * 64 + cc * 2; return st * 1024 + (ob ^ (((ob >> 9) & 1) << 5)); }
__device__ __forceinline__ void stage_rc(int b, int& R, int& C) { const int st = b / 1024, sb = b % 1024, swz = sb ^ (((sb >> 9) & 1) << 5); R = (st >> 1) * 16 + swz / 64; C = (st & 1) * 32 + (swz % 64) / 2; }

#define G_SA(b, h) (shm + ((b) * 2 + (h)) * G_HT)
#define G_SB(b, h) (shm + (4 + (b) * 2 + (h)) * G_HT)
#define G_GLDS(src, dst) __builtin_amdgcn_global_load_lds((const unsigned*)(src), (LAS unsigned*)(dst), 16, 0, 0)
#define G_STAGE_A(P, h, kt) do { const bf16_t* _s = A + arow.half_off(h) + (size_t)(kt) * G_BK; \
    G_GLDS(_s + ao[0], (char*)(P) + tid16); G_GLDS(_s + ao[1], (char*)(P) + tid16 + 8192); } while (0)
#define G_STAGE_B(P, h, kt) do { const bf16_t* _s = Bt + (size_t)(h) * G_HALF * LDB + (size_t)(kt) * G_BK; \
    G_GLDS(_s + bo[0], (char*)(P) + tid16); G_GLDS(_s + bo[1], (char*)(P) + tid16 + 8192); } while (0)
#define G_LDA(dst, b, h) _Pragma("unroll") for (int m = 0; m < 4; ++m) _Pragma("unroll") for (int k = 0; k < 2; ++k) \
    dst[m][k] = *reinterpret_cast<const bf16x8*>((const char*)G_SA(b, h) + lds_byte(wr * 64 + m * 16 + fr, k * 32 + fq * 8))
#define G_LDB(dst, b, h) _Pragma("unroll") for (int n = 0; n < 2; ++n) _Pragma("unroll") for (int k = 0; k < 2; ++k) \
    dst[n][k] = *reinterpret_cast<const bf16x8*>((const char*)G_SB(b, h) + lds_byte(wc * 32 + n * 16 + fr, k * 32 + fq * 8))
#define G_MMA(ai, bj, At, Bf) do { __builtin_amdgcn_s_setprio(1); \
    _Pragma("unroll") for (int m = 0; m < 4; ++m) _Pragma("unroll") for (int n = 0; n < 2; ++n) _Pragma("unroll") for (int k = 0; k < 2; ++k) \
      acc[ai][bj][m][n] = __builtin_amdgcn_mfma_f32_16x16x32_bf16(Bf[n][k], At[m][k], acc[ai][bj][m][n], 0, 0, 0); \
    __builtin_amdgcn_s_setprio(0); } while (0)
#define G_WAIT_V(n) asm volatile("s_waitcnt vmcnt(" #n ")" ::: "memory")
#define G_WAIT_L(n) asm volatile("s_waitcnt lgkmcnt(" #n ")" ::: "memory")
#define G_BAR __builtin_amdgcn_s_barrier()
#define G_SCHED __builtin_amdgcn_sched_barrier(0)

template <int K, int LDB, class ARow, class Epi>
__device__ __forceinline__ void gemm256(const bf16_t* __restrict__ A, const ARow& arow, const bf16_t* __restrict__ Bt, const Epi& epi) {
    bf16_t* shm = (bf16_t*)smem;
    int tz0 = tidx();
    const int tid16 = tz0 * 16;
    unsigned ao[2], bo[2];
    {
        int R0, C0, R1, C1; stage_rc(tid16, R0, C0); stage_rc(tid16 + 8192, R1, C1);
        ao[0] = arow.lane_off(R0) + C0; ao[1] = arow.lane_off(R1) + C1;
        bo[0] = (unsigned)(R0 * LDB + C0); bo[1] = (unsigned)(R1 * LDB + C1);
    }
    int wid = tz0 >> 6, lane = tz0 & 63, wr = wid >> 2, wc = wid & 3, fr = lane & 15, fq = lane >> 4;
    f32x4 acc[2][2][4][2];
#pragma unroll
    for (int a = 0; a < 2; ++a)
#pragma unroll
        for (int b = 0; b < 2; ++b)
#pragma unroll
            for (int m = 0; m < 4; ++m)
#pragma unroll
                for (int n = 0; n < 2; ++n) acc[a][b][m][n] = (f32x4){0.f, 0.f, 0.f, 0.f};
    bf16x8 At[4][2], B0[2][2], B1[2][2];
    constexpr int nt = K / G_BK;
    G_STAGE_B(G_SB(0, 0), 0, 0); G_STAGE_A(G_SA(0, 0), 0, 0);
    G_STAGE_B(G_SB(0, 1), 1, 0); G_STAGE_A(G_SA(0, 1), 1, 0);
    if (wr == 1) G_BAR;
    G_WAIT_V(4); G_BAR;
    G_STAGE_B(G_SB(1, 0), 0, 1); G_STAGE_A(G_SA(1, 0), 0, 1); G_STAGE_B(G_SB(1, 1), 1, 1);
    G_WAIT_V(6); G_BAR;
    for (int t = 0; t < nt - 2; t += 2) {
        G_LDB(B0, 0, 0); G_SCHED; G_LDA(At, 0, 0); G_STAGE_A(G_SA(1, 1), 1, t + 1);
        G_WAIT_L(8); G_BAR; G_WAIT_L(0); G_MMA(0, 0, At, B0); G_BAR; G_SCHED;
        G_LDB(B1, 0, 1); G_STAGE_B(G_SB(0, 0), 0, t + 2);
        G_BAR; G_WAIT_L(0); G_MMA(0, 1, At, B1); G_BAR;
        G_LDA(At, 0, 1); G_STAGE_A(G_SA(0, 0), 0, t + 2);
        G_BAR; G_WAIT_L(0); G_MMA(1, 0, At, B0); G_BAR; G_SCHED;
        G_STAGE_B(G_SB(0, 1), 1, t + 2);
        G_WAIT_V(6); G_BAR; G_MMA(1, 1, At, B1); G_BAR;
        G_LDB(B0, 1, 0); G_SCHED; G_LDA(At, 1, 0); G_STAGE_A(G_SA(0, 1), 1, t + 2);
        G_WAIT_L(8); G_BAR; G_WAIT_L(0); G_MMA(0, 0, At, B0); G_BAR; G_SCHED;
        G_LDB(B1, 1, 1); G_STAGE_B(G_SB(1, 0), 0, t + 3);
        G_BAR; G_WAIT_L(0); G_MMA(0, 1, At, B1); G_BAR;
        G_LDA(At, 1, 1); G_STAGE_A(G_SA(1, 0), 0, t + 3);
        G_BAR; G_WAIT_L(0); G_MMA(1, 0, At, B0); G_BAR; G_SCHED;
        G_STAGE_B(G_SB(1, 1), 1, t + 3);
        G_WAIT_V(6); G_BAR; G_MMA(1, 1, At, B1); G_BAR;
    }
    { int tz = tidx(); asm volatile("" : "+v"(tz)); wid = tz >> 6; lane = tz & 63; wr = wid >> 2; wc = wid & 3; fr = lane & 15; fq = lane >> 4; }
    { G_LDB(B0, 0, 0); G_WAIT_V(0); G_LDA(At, 0, 0); G_STAGE_A(G_SA(1, 1), 1, nt - 1);
      G_BAR; G_WAIT_L(0); G_MMA(0, 0, At, B0); G_BAR;
      G_LDB(B1, 0, 1); G_BAR; G_WAIT_L(0); G_MMA(0, 1, At, B1); G_BAR;
      G_LDA(At, 0, 1); G_WAIT_V(4); G_BAR; G_WAIT_L(0); G_MMA(1, 0, At, B0); G_MMA(1, 1, At, B1); G_BAR; }
    { G_LDB(B0, 1, 0); G_LDA(At, 1, 0); G_WAIT_V(2); G_BAR; G_WAIT_L(0); G_MMA(0, 0, At, B0); G_BAR;
      G_LDB(B1, 1, 1); G_WAIT_V(0); G_BAR; G_WAIT_L(0); G_MMA(0, 1, At, B1); G_BAR;
      G_LDA(At, 1, 1); G_BAR; G_WAIT_L(0); G_MMA(1, 0, At, B0); G_MMA(1, 1, At, B1); G_BAR; }
    if (wr == 0) G_BAR;
    epi(acc, wr, wc, fr, fq);
}

__device__ __forceinline__ int xcd_remap(int L, int nwg) { const int q = nwg / 8, r = nwg % 8, xcd = L % 8, off = L / 8; return (xcd < r ? xcd * (q + 1) : r * (q + 1) + (xcd - r) * q) + off; }
__device__ __forceinline__ void tile_of(int wgid, int nM, int nN, int& pm, int& pn) { const int nig = 8 * nN, gid = wgid / nig, fm = gid * 8, gsz = (nM - fm) < 8 ? (nM - fm) : 8; pm = fm + ((wgid % nig) % gsz); pn = (wgid % nig) / gsz; }

template <int K, int LDA, int LDB, class Units>
__device__ __forceinline__ void gemm_stream(const bf16_t* __restrict__ A, const Units& U) {
    bf16_t* shm = (bf16_t*)smem;
    typename Units::Info cur, nxt;
    if (!U.get(0, cur)) return;
    __syncthreads();
    int tz0 = tidx();
    const int tid16 = tz0 * 16;
    unsigned va[2], vb[2];
    { int R0, C0, R1, C1; stage_rc(tid16, R0, C0); stage_rc(tid16 + 8192, R1, C1);
      va[0] = (unsigned)(R0 * LDA + C0); va[1] = (unsigned)(R1 * LDA + C1); vb[0] = (unsigned)(R0 * LDB + C0); vb[1] = (unsigned)(R1 * LDB + C1); }
    const int wr = __builtin_amdgcn_readfirstlane(tz0 >> 8);
    int aoff, boff;
    { const int wid = tz0 >> 6, lane = tz0 & 63, wc = wid & 3, fr = lane & 15, fq = lane >> 4; aoff = lds_byte((wid >> 2) * 64 + fr, fq * 8); boff = lds_byte(wc * 32 + fr, fq * 8); }
#define GS_LDA(dst, b, h) _Pragma("unroll") for (int m = 0; m < 4; ++m) _Pragma("unroll") for (int k = 0; k < 2; ++k) \
    dst[m][k] = *reinterpret_cast<const bf16x8*>((const char*)G_SA(b, h) + aoff + m * 2048 + k * 1024)
#define GS_LDB(dst, b, h) _Pragma("unroll") for (int n = 0; n < 2; ++n) _Pragma("unroll") for (int k = 0; k < 2; ++k) \
    dst[n][k] = *reinterpret_cast<const bf16x8*>((const char*)G_SB(b, h) + boff + n * 2048 + k * 1024)
#define GS_STAGE_A(P, base, h) do { const bf16_t* _s = (base) + (size_t)(h) * G_HALF * LDA; G_GLDS(_s + va[0], (char*)(P) + tid16); G_GLDS(_s + va[1], (char*)(P) + tid16 + 8192); } while (0)
#define GS_STAGE_B(P, base, h) do { const bf16_t* _s = (base) + (size_t)(h) * G_HALF * LDB; G_GLDS(_s + vb[0], (char*)(P) + tid16); G_GLDS(_s + vb[1], (char*)(P) + tid16 + 8192); } while (0)
    f32x4 acc[2][2][4][2];
#pragma unroll
    for (int a = 0; a < 2; ++a)
#pragma unroll
        for (int b = 0; b < 2; ++b)
#pragma unroll
            for (int m = 0; m < 4; ++m)
#pragma unroll
                for (int n = 0; n < 2; ++n) acc[a][b][m][n] = (f32x4){0.f, 0.f, 0.f, 0.f};
    bf16x8 At[4][2], B0[2][2], B1[2][2];
    constexpr int nt = K / G_BK;
    const bf16_t* cA = A + cur.a; const bf16_t* cB = cur.b;
    GS_STAGE_B(G_SB(0, 0), cB, 0); GS_STAGE_A(G_SA(0, 0), cA, 0); GS_STAGE_B(G_SB(0, 1), cB, 1); GS_STAGE_A(G_SA(0, 1), cA, 1);
    if (wr == 1) G_BAR;
    G_WAIT_V(4); G_BAR;
    GS_STAGE_B(G_SB(1, 0), cB + G_BK, 0); GS_STAGE_A(G_SA(1, 0), cA + G_BK, 0); GS_STAGE_B(G_SB(1, 1), cB + G_BK, 1);
    G_WAIT_V(6); G_BAR;
    for (int ui = 0;; ++ui) {
        const bool has_next = U.get(ui + 1, nxt);
        const bf16_t* nA = has_next ? A + nxt.a : cA; const bf16_t* nB = has_next ? nxt.b : cB;
        for (int t = 0; t < nt; t += 2) {
            const bool last = (t == nt - 2);
            const bf16_t* a1 = cA + (size_t)(t + 1) * G_BK;
            const bf16_t* a2 = last ? nA : cA + (size_t)(t + 2) * G_BK; const bf16_t* b2 = last ? nB : cB + (size_t)(t + 2) * G_BK;
            const bf16_t* a3 = a2 + G_BK; const bf16_t* b3 = b2 + G_BK;
            GS_LDB(B0, 0, 0); G_SCHED; GS_LDA(At, 0, 0); GS_STAGE_A(G_SA(1, 1), a1, 1);
            G_WAIT_L(8); G_BAR; G_WAIT_L(0); G_MMA(0, 0, At, B0); G_BAR; G_SCHED;
            GS_LDB(B1, 0, 1); GS_STAGE_B(G_SB(0, 0), b2, 0);
            G_BAR; G_WAIT_L(0); G_MMA(0, 1, At, B1); G_BAR;
            GS_LDA(At, 0, 1); GS_STAGE_A(G_SA(0, 0), a2, 0);
            G_BAR; G_WAIT_L(0); G_MMA(1, 0, At, B0); G_BAR; G_SCHED;
            GS_STAGE_B(G_SB(0, 1), b2, 1);
            G_WAIT_V(6); G_BAR; G_MMA(1, 1, At, B1); G_BAR;
            GS_LDB(B0, 1, 0); G_SCHED; GS_LDA(At, 1, 0); GS_STAGE_A(G_SA(0, 1), a2, 1);
            G_WAIT_L(8); G_BAR; G_WAIT_L(0); G_MMA(0, 0, At, B0); G_BAR; G_SCHED;
            GS_LDB(B1, 1, 1); GS_STAGE_B(G_SB(1, 0), b3, 0);
            G_BAR; G_WAIT_L(0); G_MMA(0, 1, At, B1); G_BAR;
            GS_LDA(At, 1, 1); GS_STAGE_A(G_SA(1, 0), a3, 0);
            G_BAR; G_WAIT_L(0); G_MMA(1, 0, At, B0); G_BAR; G_SCHED;
            GS_STAGE_B(G_SB(1, 1), b3, 1);
            G_WAIT_V(6); G_BAR; G_MMA(1, 1, At, B1); G_BAR;
        }
        { const int tz = tidx(), wid = tz >> 6, lane = tz & 63; U.epi(acc, cur, wid >> 2, wid & 3, lane & 15, lane >> 4); }
        if (!has_next) break;
#pragma unroll
        for (int a = 0; a < 2; ++a)
#pragma unroll
            for (int b = 0; b < 2; ++b)
#pragma unroll
                for (int m = 0; m < 4; ++m)
#pragma unroll
                    for (int n = 0; n < 2; ++n) acc[a][b][m][n] = (f32x4){0.f, 0.f, 0.f, 0.f};
        cur = nxt; cA = nA; cB = nB;
    }
    G_WAIT_V(0);
    if (wr == 0) G_BAR;
    G_BAR;
#undef GS_STAGE_A
#undef GS_STAGE_B
#undef GS_LDA
#undef GS_LDB
}
namespace att {
constexpr int DQ = 96, DV = 64, NW = 8, QBLK = 32, KVBLK = 64;
constexpr float SCALE = 0.10206207261596575f;
constexpr float THR = 8.f;
constexpr int LDQ = 576, LDK = 96, LDV = 64, LDO = 1024;
constexpr int SHM_V = KVBLK * DV * 2;
constexpr int SHM_K = KVBLK * 128 * 2;
constexpr int NBUF = 3;
constexpr int SHM_ATTN = NBUF * SHM_V + NBUF * SHM_K + NW * 64 * 4;
#define KSWZ(row, colB) ((row) * 256 + ((colB) ^ (((row) & 7) << 4)))
#define SBAR() __builtin_amdgcn_sched_barrier(0)
__device__ __forceinline__ int crow(int r, int hi) { return (r & 3) + 8 * (r >> 2) + 4 * hi; }
__device__ __forceinline__ unsigned cvtpk(float lo, float hi) { unsigned r; asm volatile("v_cvt_pk_bf16_f32 %0, %1, %2" : "=v"(r) : "v"(lo), "v"(hi)); return r; }

constexpr float THRL = 11.5f;
__device__ __forceinline__ float bf16_exact(float x) { return __uint_as_float(cvtpk_bf16(x, 0.f) << 16); }
template <bool FIRST>
__device__ __forceinline__ void partialSM(f32x16& p0, f32x16& p1, float& m_reg, float& alpha) {
  float pmax = p0[0];
#pragma unroll
  for (int r = 1; r < 16; ++r) pmax = fmaxf(pmax, p0[r]);
#pragma unroll
  for (int r = 0; r < 16; ++r) pmax = fmaxf(pmax, p1[r]);
  { auto rr = __builtin_amdgcn_permlane32_swap(__float_as_uint(pmax), __float_as_uint(pmax), false, false);
    pmax = fmaxf(__uint_as_float(rr[0]), __uint_as_float(rr[1])); }
  if (!FIRST && __builtin_expect(__all(pmax <= THRL), 1)) { alpha = 1.f; }
  else {
    const float mn = FIRST ? bf16_exact(pmax) : bf16_exact(m_reg + fmaxf(pmax, 0.f));
    const float delta = mn - m_reg;
    alpha = __builtin_amdgcn_exp2f(-delta); m_reg = mn;
#pragma unroll
    for (int r = 0; r < 16; ++r) { p0[r] -= delta; p1[r] -= delta; }
  }
#pragma unroll
  for (int r = 0; r < 16; ++r) p0[r] = __builtin_amdgcn_exp2f(p0[r]);
}
__device__ __forceinline__ void finishSM(f32x16& p0, f32x16& p1, float alpha, float& l_reg, bf16x8& pa0, bf16x8& pa1, bf16x8& pa2, bf16x8& pa3) {
#pragma unroll
  for (int r = 0; r < 16; ++r) p1[r] = __builtin_amdgcn_exp2f(p1[r]);
  float ps = 0;
#pragma unroll
  for (int r = 0; r < 16; ++r) ps += p0[r];
#pragma unroll
  for (int r = 0; r < 16; ++r) ps += p1[r];
  { auto rr = __builtin_amdgcn_permlane32_swap(__float_as_uint(ps), __float_as_uint(ps), false, false);
    ps = __uint_as_float(rr[0]) + __uint_as_float(rr[1]); }
  l_reg = l_reg * alpha + ps;
#define PK4(P, BASE, OUT) do { unsigned a0 = cvtpk(P[BASE + 0], P[BASE + 1]), a1 = cvtpk(P[BASE + 2], P[BASE + 3]);   \
    unsigned b0 = cvtpk(P[BASE + 4], P[BASE + 5]), b1 = cvtpk(P[BASE + 6], P[BASE + 7]);                              \
    auto r0 = __builtin_amdgcn_permlane32_swap(a0, b0, false, false); auto r1 = __builtin_amdgcn_permlane32_swap(a1, b1, false, false); \
    u32x4 w = {r0[0], r1[0], r0[1], r1[1]}; OUT = *reinterpret_cast<bf16x8*>(&w); } while (0)
  PK4(p0, 0, pa0); PK4(p0, 8, pa1); PK4(p1, 0, pa2); PK4(p1, 8, pa3);
#undef PK4
}
__device__ __forceinline__ void qkt(f32x16& p0, f32x16& p1, const char* Ks, const bf16x8* qr, bf16x8 kaug, bf16x8 qaug, int r32, int hi) {
  p0 = f32x16{}; p1 = f32x16{};
#pragma unroll
  for (int d0 = 0; d0 < 6; ++d0) { int cb = (d0 * 16 + hi * 8) * 2;
    bf16x8 b0 = *reinterpret_cast<const bf16x8*>(Ks + KSWZ(r32, cb));
    bf16x8 b1 = *reinterpret_cast<const bf16x8*>(Ks + KSWZ(32 + r32, cb));
    p0 = __builtin_amdgcn_mfma_f32_32x32x16_bf16(b0, qr[d0], p0, 0, 0, 0);
    p1 = __builtin_amdgcn_mfma_f32_32x32x16_bf16(b1, qr[d0], p1, 0, 0, 0); }
  p0 = __builtin_amdgcn_mfma_f32_32x32x16_bf16(kaug, qaug, p0, 0, 0, 0);
  p1 = __builtin_amdgcn_mfma_f32_32x32x16_bf16(kaug, qaug, p1, 0, 0, 0);
}
__device__ __forceinline__ int v_st(int k, int c) { const int kk = (k & ~0xC) | ((k & 4) << 1) | ((k & 8) >> 1); return ((kk >> 3) * 2 + (c >> 5)) * 512 + ((kk & 7) * 32 + (c & 31)) * 2; }
__device__ __forceinline__ int v_rd_base(int lane) { return ((lane & 3) << 3) | (((lane >> 2) & 3) << 6) | (((lane >> 4) & 1) << 5) | (((lane >> 5) & 1) << 8); }
constexpr int v_rd_off(int d0, int ks, int half) { return d0 * 512 + ks * 2048 + half * 1024; }
template <int OFF> __device__ __forceinline__ s16x4 tr_read(int vb) {
  s16x4 r; asm volatile("ds_read_b64_tr_b16 %0, %1 offset:%2" : "=&v"(r) : "v"(vb), "i"(OFF) : "memory"); return r;
}
template <int D0> __device__ __forceinline__ void pv_one(f32x16& od, int vb, bf16x8 pa0, bf16x8 pa1, bf16x8 pa2, bf16x8 pa3) {
  const s16x4 l0 = tr_read<v_rd_off(D0, 0, 0)>(vb), h0 = tr_read<v_rd_off(D0, 0, 1)>(vb), l1 = tr_read<v_rd_off(D0, 1, 0)>(vb), h1 = tr_read<v_rd_off(D0, 1, 1)>(vb);
  const s16x4 l2 = tr_read<v_rd_off(D0, 2, 0)>(vb), h2 = tr_read<v_rd_off(D0, 2, 1)>(vb), l3 = tr_read<v_rd_off(D0, 3, 0)>(vb), h3 = tr_read<v_rd_off(D0, 3, 1)>(vb);
  asm volatile("s_waitcnt lgkmcnt(0)" ::: "memory"); SBAR();
#define PK(L, H) (bf16x8){L[0], L[1], L[2], L[3], H[0], H[1], H[2], H[3]}
  od = __builtin_amdgcn_mfma_f32_32x32x16_bf16(pa0, PK(l0, h0), od, 0, 0, 0);
  od = __builtin_amdgcn_mfma_f32_32x32x16_bf16(pa1, PK(l1, h1), od, 0, 0, 0);
  od = __builtin_amdgcn_mfma_f32_32x32x16_bf16(pa2, PK(l2, h2), od, 0, 0, 0);
  od = __builtin_amdgcn_mfma_f32_32x32x16_bf16(pa3, PK(l3, h3), od, 0, 0, 0);
#undef PK
}
__device__ __forceinline__ void pv_d0(f32x16* o, int vb, bf16x8 pa0, bf16x8 pa1, bf16x8 pa2, bf16x8 pa3) {
  pv_one<0>(o[0], vb, pa0, pa1, pa2, pa3); pv_one<1>(o[1], vb, pa0, pa1, pa2, pa3);
}

__device__ __forceinline__ void attn_body(const bf16_t* __restrict__ Qb, const bf16_t* __restrict__ Kh, const bf16_t* __restrict__ Vh, bf16_t* __restrict__ Ob, int seq, char* lds, const int samet = 0) {
  const int tid = tidx(), wid = tid >> 6, lane = tid & 63, r32 = lane & 31, hi = lane >> 5;
  char* V_lds = lds; char* K_lds = lds + NBUF * SHM_V;
  float* ws = (float*)(lds + NBUF * SHM_V + NBUF * SHM_K) + wid * 64; float* li_l = ws; float* al_l = ws + 32;
  float m_reg = 0.f, l_reg = 0.f; f32x16 o[2] = {}; bf16x8 qr[6];
  const bf16_t* Qw = Qb + (long)(wid * QBLK + r32) * LDQ + hi * 8;
#pragma unroll
  for (int d0 = 0; d0 < 6; ++d0) qr[d0] = *reinterpret_cast<const bf16x8*>(Qw + d0 * 16);
  bf16x8 kaug = {0, 0, 0, 0, 0, 0, 0, 0}; if (hi == 0) kaug[0] = 0x3F80;
  bf16x8 qaug = {0, 0, 0, 0, 0, 0, 0, 0};
#define QAUG() do { if (hi == 0) qaug[0] = (short)(cvtpk(-m_reg, 0.f) & 0xffffu); } while (0)
  const int kc0 = tid, kc1 = 512 + (tid & 255);
  const int kr0 = kc0 / 12, kcc0 = kc0 % 12, kr1 = kc1 / 12, kcc1 = kc1 % 12;
  const int vr = tid >> 3, vcc = tid & 7;
  const int kst0 = KSWZ(kr0, kcc0 * 16), kst1 = KSWZ(kr1, kcc1 * 16), vst = v_st(vr, vcc * 8);
  const int vb0 = (int)(uintptr_t)(LAS char*)V_lds + v_rd_base(lane);
  struct { bf16x8 vs0, ks0, ks1; } sr_[2];
#define SLOAD(i, k0_) do { const int k0 = samet ? 0 : (k0_); sr_[i].vs0 = *reinterpret_cast<const bf16x8*>(&Vh[(long)((k0) + vr) * LDV + vcc * 8]); \
    sr_[i].ks0 = *reinterpret_cast<const bf16x8*>(&Kh[(long)((k0) + kr0) * LDK + kcc0 * 8]); \
    sr_[i].ks1 = *reinterpret_cast<const bf16x8*>(&Kh[(long)((k0) + kr1) * LDK + kcc1 * 8]); } while (0)
#define SWRITE(b, i) do { *(bf16x8*)(V_lds + (b) * SHM_V + vst) = sr_[i].vs0; \
    *(bf16x8*)(K_lds + (b) * SHM_K + kst0) = sr_[i].ks0; *(bf16x8*)(K_lds + (b) * SHM_K + kst1) = sr_[i].ks1; } while (0)
#define SWAIT() asm volatile("s_waitcnt vmcnt(3)" ::: "memory")
#define RESC(a) do { if (__any((a) < 1.f)) { if (hi == 0) al_l[r32] = (a); asm volatile("s_waitcnt lgkmcnt(0)" ::: "memory"); \
    _Pragma("unroll") for (int r = 0; r < 16; ++r) { const float f_ = al_l[crow(r, hi)]; o[0][r] *= f_; o[1][r] *= f_; } QAUG(); } } while (0)
  f32x16 pA0, pA1, pB0, pB1; float alA, alB; bf16x8 pa0, pa1, pa2, pa3; const int NT = seq / KVBLK;
  constexpr int SE = 0, SO = 1;
  SLOAD(SE, 0); asm volatile("s_waitcnt vmcnt(0)" ::: "memory"); SWRITE(0, SE); __syncthreads();
  qkt(pA0, pA1, K_lds, qr, kaug, qaug, r32, hi); partialSM<true>(pA0, pA1, m_reg, alA); QAUG(); alA = 1.f;
  SLOAD(SO, KVBLK); if (2 < NT) SLOAD(SE, 2 * KVBLK);
  SWAIT(); SWRITE(1, SO); __syncthreads();
  int bp = 0, bc = 1, bn = 2;
  for (int j = 1; j + 1 < NT; j += 2) {
    SBAR(); qkt(pB0, pB1, K_lds + bc * SHM_K, qr, kaug, qaug, r32, hi);
    finishSM(pA0, pA1, alA, l_reg, pa0, pa1, pa2, pa3); SBAR();
    SLOAD(SO, (j + 2) * KVBLK); SBAR();
    pv_d0(o, vb0 + bp * SHM_V, pa0, pa1, pa2, pa3); partialSM<false>(pB0, pB1, m_reg, alB);
    SWAIT(); SWRITE(bn, SE);
    RESC(alB); __syncthreads();
    bp = bc; bc = bn; bn = bn == 2 ? 0 : bn + 1;
    SBAR(); qkt(pA0, pA1, K_lds + bc * SHM_K, qr, kaug, qaug, r32, hi);
    finishSM(pB0, pB1, alB, l_reg, pa0, pa1, pa2, pa3); SBAR();
    if (j + 3 < NT) SLOAD(SE, (j + 3) * KVBLK); SBAR();
    pv_d0(o, vb0 + bp * SHM_V, pa0, pa1, pa2, pa3); partialSM<false>(pA0, pA1, m_reg, alA);
    SWAIT(); SWRITE(bn, SO);
    RESC(alA); __syncthreads();
    bp = bc; bc = bn; bn = bn == 2 ? 0 : bn + 1;
  }
  SBAR(); qkt(pB0, pB1, K_lds + bc * SHM_K, qr, kaug, qaug, r32, hi);
  finishSM(pA0, pA1, alA, l_reg, pa0, pa1, pa2, pa3); SBAR();
  pv_d0(o, vb0 + bp * SHM_V, pa0, pa1, pa2, pa3); partialSM<false>(pB0, pB1, m_reg, alB);
  RESC(alB);
  finishSM(pB0, pB1, alB, l_reg, pa0, pa1, pa2, pa3); SBAR();
  pv_d0(o, vb0 + bc * SHM_V, pa0, pa1, pa2, pa3);
  if (hi == 0) li_l[r32] = l_reg; asm volatile("s_waitcnt lgkmcnt(0)" ::: "memory");
  float rli[16];
#pragma unroll
  for (int r = 0; r < 16; ++r) rli[r] = __builtin_amdgcn_rcpf(li_l[crow(r, hi)]);
  bf16_t* Ow = Ob + (long)(wid * QBLK) * LDO;
#pragma unroll
  for (int r = 0; r < 16; ++r) { int orow = crow(r, hi);
#pragma unroll
    for (int d0 = 0; d0 < 2; ++d0) Ow[(long)orow * LDO + d0 * 32 + r32] = f2bf(o[d0][r] * rli[r]); }
  __syncthreads();
#undef QAUG
#undef SLOAD
#undef SWRITE
#undef SWAIT
#undef RESC
}
}
template <class ColMap>
__device__ __forceinline__ void tr_tile(const ColMap& cm, int n0, int k0, int ksrc  , bf16_t* __restrict__ dst, long ldo) {
    float* tile = (float*)smem;
    const int tid = tidx();
    __syncthreads();
    {
        const int n = tid & 63; long ld; const float* base = cm(n0 + n, ld);
#pragma unroll
        for (int i = 0; i < 8; ++i) { const int k = (tid >> 6) + 8 * i;
            tile[k * 65 + n] = (base != nullptr && (k0 + k) < ksrc) ? base[(long)(k0 + k) * ld] : 0.f; }
    }
    __syncthreads();
    {
        const int n = tid >> 3, ks = (tid & 7) * 8;
        u32x4 w;
        w[0] = pack2bf(tile[(ks + 0) * 65 + n], tile[(ks + 1) * 65 + n]); w[1] = pack2bf(tile[(ks + 2) * 65 + n], tile[(ks + 3) * 65 + n]);
        w[2] = pack2bf(tile[(ks + 4) * 65 + n], tile[(ks + 5) * 65 + n]); w[3] = pack2bf(tile[(ks + 6) * 65 + n], tile[(ks + 7) * 65 + n]);
        *reinterpret_cast<u32x4*>(dst + (long)(n0 + n) * ldo + k0 + ks) = w;
    }
}

struct CmWin { const float* w; __device__ __forceinline__ const float* operator()(int n, long& ld) const {
    ld = IN_W; int s;
    if (n < 1280) s = n; else if (n < 1472) s = n - 1280 + 1292; else if (n < 1600) s = n - 1472 + 1484; else if (n < 1632) s = n - 1600 + 1612;
    else if (n < 1644) s = n - 1632 + 1280; else if (n < 1664) s = -1; else s = n - 1664 + 1644;
    return s < 0 ? nullptr : w + s; } };
struct CmPlain { const float* w; long ldw; __device__ __forceinline__ const float* operator()(int n, long& ld) const { ld = ldw; return w + n; } };
struct CmW13 { const float *w1, *w3; __device__ __forceinline__ const float* operator()(int n, long& ld) const {
    ld = 512; const int pn = n >> 8, half = (n >> 7) & 1, c = n & 127; return (half ? w3 : w1) + pn * 128 + c; } };

__device__ __forceinline__ void ph_prologue(const Params& p) {
    const int bid = bidx(), nb = gridDim.x, tid = tidx();
    unsigned char* ws = p.ws;
    {
        const int nIn = 4 * 44 * 16, nOut = 4 * 16 * 16;
        for (int u = bid; u < nIn + nOut; u += nb) {
            if (u < nIn) { const int L = u / (44 * 16), r = u % (44 * 16), nt = r / 16, kt = r % 16;
                CmWin cm{p.w_in + (size_t)L * 1024 * IN_W};
                tr_tile(cm, nt * 64, kt * 64, 1024, (bf16_t*)(ws + WS_WIN) + (size_t)L * UW * 1024, 1024);
            } else { const int v = u - nIn, L = v / 256, r = v % 256, nt = r / 16, kt = r % 16;
                CmPlain cm{p.w_out + (size_t)L * 1024 * 1024, 1024};
                tr_tile(cm, nt * 64, kt * 64, 1024, (bf16_t*)(ws + WS_WOUT) + (size_t)L * 1024 * 1024, 1024);
            }
        }
    }
    {
        bf16_t* wup = (bf16_t*)(ws + WS_WUP);
        const long total = (long)4 * UPW * UPK;
        for (long i = (long)bid * NTHREADS + tid; i < total; i += (long)nb * NTHREADS) {
            const int L = (int)(i / (UPW * UPK)), r = (int)(i % (UPW * UPK)), n = r / UPK, k = r % UPK;
            float v = 0.f;
            if (n < 576) { if (k < 192) v = p.mla_q_norm_w[L * 192 + k] * p.mla_w_uq[((size_t)L * 192 + k) * 576 + n]; }
            else if (n >= 768) { if (k >= 192 && k < 320) v = p.mla_kv_norm_w[L * 128 + (k - 192)] * p.mla_w_ukv[((size_t)L * 128 + (k - 192)) * 768 + (n - 768)]; }
            wup[i] = f2bf(v);
        }
    }
    {
        bf16_t* wl = (bf16_t*)(ws + WS_WLORA);
        const long total = (long)4 * 98304;
        for (long i = (long)bid * NTHREADS + tid; i < total; i += (long)nb * NTHREADS) {
            const int L = (int)(i / 98304), r = (int)(i % 98304); float v;
            if (r < 32768) { const int d = r / 16384, n = (r / 64) % 256, k = r % 64; v = p.rwkv_w2[(((size_t)L * 2 + d) * 64 + k) * 256 + n]; }
            else if (r < 65536) { const int q = r - 32768, d = q / 16384, n = (q / 64) % 256, k = q % 64; v = p.rwkv_a2[(((size_t)L * 2 + d) * 64 + k) * 256 + n]; }
            else { const int q = r - 65536, n = q / 128, k = q % 128; v = p.rwkv_g2[((size_t)L * 128 + k) * 256 + n]; }
            wl[i] = f2bf(v);
        }
    }
    {
        float* wrt = (float*)(ws + WS_WRT);
        const long total = (long)4 * 72 * 1024;
        for (long i = (long)bid * NTHREADS + tid; i < total; i += (long)nb * NTHREADS) {
            const int L = (int)(i / (72 * 1024)), r = (int)(i % (72 * 1024)), o = r / 1024, k = r % 1024;
            wrt[i] = o < 8 ? p.moe_w_rg[((size_t)L * 1024 + k) * 8 + o] : p.moe_w_re[((size_t)L * 1024 + k) * 64 + (o - 8)];
        }
    }
    {
        bf16_t* wr = (bf16_t*)(ws + WS_WRH);
        const long total = (long)4 * 80 * 1024;
        for (long i = (long)bid * NTHREADS + tid; i < total; i += (long)nb * NTHREADS) {
            const int L = (int)(i / (80 * 1024)), r = (int)(i % (80 * 1024)), o = r / 1024, k = r % 1024;
            const float v = o < 8 ? p.moe_w_rg[((size_t)L * 1024 + k) * 8 + o] : (o < 72 ? p.moe_w_re[((size_t)L * 1024 + k) * 64 + (o - 8)] : 0.f);
            const bf16_t hi = f2bf(v);
            wr[((size_t)L * 2 + 0) * 80 * 1024 + r] = hi; wr[((size_t)L * 2 + 1) * 80 * 1024 + r] = f2bf(v - bf2f(hi));
        }
    }
    {
        float* cs = (float*)smem;
        __syncthreads();
        for (int i = tid; i < 3 * 1024; i += NTHREADS) { const int s = i >> 10, k = i & 1023; const float v = s < 2 ? p.c[s * 1024 + k] : p.c_ctx[k]; cs[i] = silu_f(v); }
        __syncthreads();
        float* mods = (float*)(ws + WS_MODS);
        float* red = cs + 3 * 1024;
        const int lane = tid & 63, wid = tid >> 6;
        for (int task = bid; task < 4 * 96; task += nb) {
            const int L = task / 96, col = (task % 96) * 64 + lane;
            const float* w = p.mod_w + (size_t)L * 1024 * 6144 + (size_t)(128 * wid) * 6144 + col;
            const float* c0 = cs + 128 * wid;
            float a0 = 0.f, a1 = 0.f, a2 = 0.f;
#pragma unroll 16
            for (int k = 0; k < 128; ++k) { const float wv = w[(size_t)k * 6144]; a0 = fmaf(c0[k], wv, a0); a1 = fmaf(c0[1024 + k], wv, a1); a2 = fmaf(c0[2048 + k], wv, a2); }
            red[(wid * 3 + 0) * 64 + lane] = a0; red[(wid * 3 + 1) * 64 + lane] = a1; red[(wid * 3 + 2) * 64 + lane] = a2;
            __syncthreads();
            if (tid < 192) { const int s3 = tid >> 6; float acc = p.mod_b[L * 6144 + (task % 96) * 64 + lane];
#pragma unroll
                for (int w8 = 0; w8 < 8; ++w8) acc += red[(w8 * 3 + s3) * 64 + lane];
                mods[(L * 3 + s3) * 6144 + (task % 96) * 64 + lane] = acc; }
            __syncthreads();
        }
        __syncthreads();
    }
    {
        bf16_t* Xb = (bf16_t*)(ws + WS_X);
        const f32x4* x4 = (const f32x4*)p.x; const f32x4* c4 = (const f32x4*)p.ctx;
        const long nl = (long)NLAT * 256, nt = (long)NTOK * 256;
        for (long i = (long)bid * NTHREADS + tid; i < nt; i += (long)nb * NTHREADS) st4bf(Xb + i * 4, i < nl ? x4[i] : c4[i - nl]);
    }
}

__device__ __forceinline__ void tr_tile256(const float* __restrict__ srcA, const float* __restrict__ srcB, long ldsrc, bf16_t* __restrict__ dst, long ldo) {
    unsigned* tl = (unsigned*)smem;
    const int tid = tidx(), lane = tid & 63, w = tid >> 6;
    __syncthreads();
    f32x4 v0[4], v1[4];
    const float* sp = (lane < 32 ? srcA + lane * 4 : srcB + (lane - 32) * 4);
#pragma unroll
    for (int it = 0; it < 4; ++it) { const int kp = w + 8 * it;
        v0[it] = *(const f32x4*)(sp + (long)(2 * kp) * ldsrc); v1[it] = *(const f32x4*)(sp + (long)(2 * kp + 1) * ldsrc); }
#pragma unroll
    for (int it = 0; it < 4; ++it) { const int kp = w + 8 * it;
#pragma unroll
        for (int i = 0; i < 4; ++i) tl[(4 * lane + i) * 33 + kp] = cvtpk_bf16(v0[it][i], v1[it][i]); }
    __syncthreads();
#pragma unroll
    for (int it = 0; it < 4; ++it) { const int n = (tid >> 3) + 64 * it, ks = tid & 7;
        u32x4 o; o[0] = tl[n * 33 + ks * 4 + 0]; o[1] = tl[n * 33 + ks * 4 + 1]; o[2] = tl[n * 33 + ks * 4 + 2]; o[3] = tl[n * 33 + ks * 4 + 3];
        *(u32x4*)(dst + (long)n * ldo + ks * 8) = o; }
}
constexpr int MOE_CV_N13 = 64 * 4 * 16, MOE_CV_N2 = 64 * 4 * 8;
__device__ __forceinline__ void moe_convert_tile(const Params& p, int L, int u) {
    unsigned char* ws = p.ws;
    constexpr int n13 = MOE_CV_N13;
    {
        if (u < n13) { const int e = u / 64, r = u % 64, pn = r / 16, kt = r % 16;
            const size_t eo = ((size_t)L * 64 + e) * 1024 * 512 + (size_t)kt * 64 * 512 + pn * 128;
            tr_tile256(p.moe_w1 + eo, p.moe_w3 + eo, 512, (bf16_t*)(ws + WS_W13) + ((size_t)e * 1024 + pn * 256) * 1024 + kt * 64, 1024);
        } else { const int v = u - n13, e = v / 32, r = v % 32, nt = r / 8, kt = r % 8;
            const float* sb = p.moe_w2 + ((size_t)L * 64 + e) * 512 * 1024 + (size_t)kt * 64 * 1024 + nt * 256;
            tr_tile256(sb, sb + 128, 1024, (bf16_t*)(ws + WS_W2) + ((size_t)e * 1024 + nt * 256) * 512 + kt * 64, 512);
        }
    }
}
__device__ __forceinline__ void ph_norm1(const Params& p, int L) {
    unsigned char* ws = p.ws;
    bf16_t* X = (bf16_t*)(ws + WS_X); bf16_t* H = (bf16_t*)(ws + WS_H);
    const float* mods = (const float*)(ws + WS_MODS);
    const int* SLOT = (const int*)(ws + WS_SLOT); const float* GATE = (const float*)(ws + WS_GATE); const bf16_t* YE = (const bf16_t*)(ws + WS_YEXP);
    const int lane = tidx() & 63, gw = bidx() * 8 + wave_id(), nw = gridDim.x * 8;
    if (bidx() == 0) { ((int*)(ws + WS_MISC))[tidx()] = 0; ((int*)(ws + WS_MISC))[512 + tidx()] = 0; }
    const float* n1w = p.norm1_w + L * 1024;
    float* par = (float*)smem;
    __syncthreads();
    for (int i = tidx(); i < 3 * 1024; i += NTHREADS) { const int set = i >> 10, c = i & 1023; const float* md = mods + (L * 3 + set) * 6144;
        par[(set * 3 + 0) * 1024 + c] = n1w[c] * (1.f + md[1024 + c]); par[(set * 3 + 1) * 1024 + c] = md[c];
        par[(set * 3 + 2) * 1024 + c] = L > 0 ? mods[((L - 1) * 3 + set) * 6144 + 5 * 1024 + c] : 0.f; }
    __syncthreads();
    constexpr int RB = 2;
    int s0n[RB], s1n[RB]; float gan[RB], gbn[RB];
#pragma unroll
    for (int q = 0; q < RB; ++q) { s0n[q] = 0; s1n[q] = 0; gan[q] = 0.f; gbn[q] = 0.f; }
    if (L > 0 && gw * RB < NTOK) {
#pragma unroll
        for (int q = 0; q < RB; ++q) { const int r = gw * RB + q; s0n[q] = SLOT[r * 2]; s1n[q] = SLOT[r * 2 + 1]; gan[q] = GATE[r * 2]; gbn[q] = GATE[r * 2 + 1]; } }
    for (int r0 = gw * RB; r0 < NTOK; r0 += nw * RB) {
        f32x4 v[RB][4];
#pragma unroll
        for (int q = 0; q < RB; ++q)
#pragma unroll
            for (int i = 0; i < 4; ++i) v[q][i] = ld4bf(X + (size_t)(r0 + q) * 1024 + i * 256 + lane * 4);
        if (L > 0) {
            int s0[RB], s1[RB]; float ga[RB], gb[RB];
#pragma unroll
            for (int q = 0; q < RB; ++q) { s0[q] = s0n[q]; s1[q] = s1n[q]; ga[q] = gan[q]; gb[q] = gbn[q]; }
            { const int rn = r0 + nw * RB;
              if (rn < NTOK) {
#pragma unroll
                  for (int q = 0; q < RB; ++q) { s0n[q] = SLOT[(rn + q) * 2]; s1n[q] = SLOT[(rn + q) * 2 + 1]; gan[q] = GATE[(rn + q) * 2]; gbn[q] = GATE[(rn + q) * 2 + 1]; } } }
            u32x2 ya[RB][4], yb[RB][4];
#pragma unroll
            for (int q = 0; q < RB; ++q)
#pragma unroll
                for (int i = 0; i < 4; ++i) { const int col = i * 256 + lane * 4; ya[q][i] = *(const u32x2*)(YE + (size_t)s0[q] * 1024 + col); yb[q][i] = *(const u32x2*)(YE + (size_t)s1[q] * 1024 + col); }
#pragma unroll
            for (int q = 0; q < RB; ++q) { const float* g2 = par + (row_set(r0 + q) * 3 + 2) * 1024;
#pragma unroll
                for (int i = 0; i < 4; ++i) { const int col = i * 256 + lane * 4; const f32x4 gg = *(const f32x4*)(g2 + col);
                    v[q][i][0] += gg[0] * (ga[q] * __uint_as_float(ya[q][i][0] << 16) + gb[q] * __uint_as_float(yb[q][i][0] << 16));
                    v[q][i][1] += gg[1] * (ga[q] * __uint_as_float(ya[q][i][0] & 0xffff0000u) + gb[q] * __uint_as_float(yb[q][i][0] & 0xffff0000u));
                    v[q][i][2] += gg[2] * (ga[q] * __uint_as_float(ya[q][i][1] << 16) + gb[q] * __uint_as_float(yb[q][i][1] << 16));
                    v[q][i][3] += gg[3] * (ga[q] * __uint_as_float(ya[q][i][1] & 0xffff0000u) + gb[q] * __uint_as_float(yb[q][i][1] & 0xffff0000u));
                    st4bf(X + (size_t)(r0 + q) * 1024 + col, v[q][i]); } }
        }
#pragma unroll
        for (int q = 0; q < RB; ++q) { const int row = r0 + q, set = row_set(row);
            float ss = 0.f;
#pragma unroll
            for (int i = 0; i < 4; ++i) ss += v[q][i][0] * v[q][i][0] + v[q][i][1] * v[q][i][1] + v[q][i][2] * v[q][i][2] + v[q][i][3] * v[q][i][3];
            ss = wave_sum(ss);
            const float rs = rsqrtf(ss * (1.f / 1024.f) + NORM_EPS);
            const float* pa = par + (set * 3) * 1024;
#pragma unroll
            for (int i = 0; i < 4; ++i) { const int col = i * 256 + lane * 4;
                const f32x4 w = *(const f32x4*)(pa + col), sh = *(const f32x4*)(pa + 1024 + col);
                u32x2 o;
                o[0] = cvtpk_bf16(v[q][i][0] * rs * w[0] + sh[0], v[q][i][1] * rs * w[1] + sh[1]);
                o[1] = cvtpk_bf16(v[q][i][2] * rs * w[2] + sh[2], v[q][i][3] * rs * w[3] + sh[3]);
                *(u32x2*)(H + (size_t)row * 1024 + col) = o; } }
    }
}

template <int LD> struct ARowLin { size_t base;
    __device__ __forceinline__ size_t half_off(int h) const { return base + (size_t)h * G_HALF * LD; }
    __device__ __forceinline__ unsigned lane_off(int r) const { return (unsigned)(r * LD); } };

#define EPI_FENCE() asm volatile("" ::: "memory")
struct EpiBf16Store {
    bf16_t* O; long ld;
    __device__ __forceinline__ void operator()(const f32x4 (&acc)[2][2][4][2], int wr, int wc, int fr, int fq) const {
#pragma unroll
        for (int ai = 0; ai < 2; ++ai)
#pragma unroll
            for (int m = 0; m < 4; ++m) { bf16_t* rp = O + (long)(ai * 128 + wr * 64 + m * 16 + fr) * ld + wc * 32 + fq * 4;
#pragma unroll
                for (int bj = 0; bj < 2; ++bj)
#pragma unroll
                    for (int n = 0; n < 2; ++n) { const f32x4 a = acc[ai][bj][m][n]; u32x2 o; o[0] = cvtpk_bf16(a[0], a[1]); o[1] = cvtpk_bf16(a[2], a[3]);
                        *(u32x2*)(rp + bj * 128 + n * 16) = o; }
                EPI_FENCE(); }
    }
};
struct EpiResid {
    bf16_t* X; const float* mods_g; int row0, col0;
    __device__ __forceinline__ void operator()(const f32x4 (&acc)[2][2][4][2], int wr, int wc, int fr, int fq) const {
        const float* gp = mods_g + row_set(row0) * 6144 + col0 + wc * 32 + fq * 4;
#pragma unroll
        for (int bj = 0; bj < 2; ++bj)
#pragma unroll
            for (int n = 0; n < 2; ++n) { const f32x4 g = *(const f32x4*)(gp + bj * 128 + n * 16);
#pragma unroll
                for (int ai = 0; ai < 2; ++ai)
#pragma unroll
                    for (int m = 0; m < 4; ++m) { const int row = row0 + ai * 128 + wr * 64 + m * 16 + fr;
                        bf16_t* rp = X + (size_t)row * 1024 + col0 + wc * 32 + fq * 4 + bj * 128 + n * 16;
                        f32x4 x = ld4bf(rp); x += g * acc[ai][bj][m][n]; st4bf(rp, x); }
                EPI_FENCE(); }
    }
};
struct EpiSwiglu {
    bf16_t* O;
    __device__ __forceinline__ void operator()(const f32x4 (&acc)[2][2][4][2], int wr, int wc, int fr, int fq) const {
#pragma unroll
        for (int ai = 0; ai < 2; ++ai)
#pragma unroll
            for (int m = 0; m < 4; ++m) { bf16_t* rp = O + (long)(ai * 128 + wr * 64 + m * 16 + fr) * 512 + wc * 32 + fq * 4;
#pragma unroll
                for (int n = 0; n < 2; ++n) { const f32x4 a = acc[ai][0][m][n], b = acc[ai][1][m][n]; u32x2 o;
                    o[0] = cvtpk_bf16(silu_f(a[0]) * b[0], silu_f(a[1]) * b[1]); o[1] = cvtpk_bf16(silu_f(a[2]) * b[2], silu_f(a[3]) * b[3]);
                    *(u32x2*)(rp + n * 16) = o; }
                EPI_FENCE(); }
    }
};

struct UnitsIn { const bf16_t* W; bf16_t* U; int bid, nb;
    struct Info { size_t a; const bf16_t* b; bf16_t* o; };
    __device__ __forceinline__ bool get(int i, Info& u) const { const int t = bid + i * nb; if (t >= 130 * 11) return false; int pm, pn; tile_of(xcd_remap(t, 130 * 11), 130, 11, pm, pn);
        u.a = (size_t)pm * 256 * 1024; u.b = W + (size_t)pn * 256 * 1024; u.o = U + (size_t)pm * 256 * UW + pn * 256; return true; }
    __device__ __forceinline__ void epi(const f32x4 (&acc)[2][2][4][2], const Info& u, int wr, int wc, int fr, int fq) const { EpiBf16Store e{u.o, UW}; e(acc, wr, wc, fr, fq); } };
__device__ __forceinline__ void ph_gemm_in(const Params& p, int L) {
    unsigned char* ws = p.ws;
    UnitsIn un{(const bf16_t*)(ws + WS_WIN) + (size_t)L * UW * 1024, (bf16_t*)(ws + WS_U), bidx(), (int)gridDim.x};
    gemm_stream<1024, 1024, 1024>((const bf16_t*)(ws + WS_H), un);
}
struct UnitsOut { const bf16_t* W; bf16_t* X; const float* mg; int bid, nb, ntile;
    struct Info { size_t a; const bf16_t* b; int row0, col0; };
    __device__ __forceinline__ bool get(int i, Info& u) const { const int t = bid + i * nb; if (t >= ntile) return false; int pm, pn; tile_of(xcd_remap(t, ntile), ntile / 4, 4, pm, pn);
        u.a = (size_t)pm * 256 * 1024; u.b = W + (size_t)pn * 256 * 1024; u.row0 = pm * 256; u.col0 = pn * 256; return true; }
    __device__ __forceinline__ void epi(const f32x4 (&acc)[2][2][4][2], const Info& u, int wr, int wc, int fr, int fq) const { EpiResid e{X, mg, u.row0, u.col0}; e(acc, wr, wc, fr, fq); } };
__device__ __forceinline__ void ph_gemm_out(const Params& p, int L) {
    unsigned char* ws = p.ws;
    UnitsOut un{(const bf16_t*)(ws + WS_WOUT) + (size_t)L * 1024 * 1024, (bf16_t*)(ws + WS_X), (const float*)(ws + WS_MODS) + L * 3 * 6144 + 2 * 1024, bidx(), (int)gridDim.x,
                (L == DEPTH - 1 ? 128 : 130) * 4};
    gemm_stream<1024, 1024, 1024>((const bf16_t*)(ws + WS_MIX), un);
}

constexpr float QSC = 0.10206207261596575f * 1.4426950408889634f;
struct MlaRow { u32x4 nv, c0, c1, c2; };
__device__ __forceinline__ void mla_load(MlaRow& o, const bf16_t* U, const bf16_t* QU, int row, int lane) {
    o.nv = *(const u32x4*)(U + (size_t)row * UW + U_QD + 8 * (lane < 44 ? lane : 43));
    const bf16_t* qu = QU + (size_t)row * UPW + 8 * lane;
    o.c0 = *(const u32x4*)qu; o.c1 = *(const u32x4*)(qu + 512); o.c2 = *(const u32x4*)(qu + 1024);
}
__device__ __forceinline__ void mla_unpack(const u32x4& v, float (&f)[8]) {
#pragma unroll
    for (int i = 0; i < 4; ++i) { f[2 * i] = __uint_as_float(v[i] << 16); f[2 * i + 1] = __uint_as_float(v[i] & 0xffff0000u); } }
__device__ __forceinline__ u32x4 mla_pack(const float (&f)[8]) { u32x4 r = {cvtpk_bf16(f[0], f[1]), cvtpk_bf16(f[2], f[3]), cvtpk_bf16(f[4], f[5]), cvtpk_bf16(f[6], f[7])}; return r; }
__device__ __forceinline__ u32x4 mla_partner(const u32x4& v) { u32x4 r;
#pragma unroll
    for (int i = 0; i < 4; ++i) r[i] = (unsigned)__builtin_amdgcn_update_dpp(0, (int)v[i], 0xB1, 0xF, 0xF, true);
    return r; }
__device__ __forceinline__ u32x4 mla_rot(const u32x4& own, const u32x4& par, const float (&cs)[8], const float (&sn)[8], float scale) {
    float x[8], y[8], o[8]; mla_unpack(own, x); mla_unpack(par, y);
#pragma unroll
    for (int i = 0; i < 8; ++i) o[i] = (x[i] * cs[i] + y[i] * sn[i]) * scale;
    return mla_pack(o); }
__device__ __forceinline__ u32x4 mla_scale(const u32x4& v, float scale) { float x[8]; mla_unpack(v, x);
#pragma unroll
    for (int i = 0; i < 8; ++i) x[i] *= scale;
    return mla_pack(x); }
__device__ __forceinline__ void ph_mla_prep_rows(const Params& p, int row_lo, int row_hi, int wave_lin, int nwaves) {
    unsigned char* ws = p.ws;
    const bf16_t* U = (const bf16_t*)(ws + WS_U); const bf16_t* QU = (const bf16_t*)(ws + WS_QKVUP);
    bf16_t* Q = (bf16_t*)(ws + WS_Q); bf16_t* Kb = (bf16_t*)(ws + WS_K); bf16_t* Vb = (bf16_t*)(ws + WS_V);
    const int lane = tidx() & 63;
    const int l12 = lane % 12;
    const bool rope0 = l12 >= 8, rope1 = (lane >> 2) == 1, ropek = (lane >> 2) == 10;
    const int ropeg = rope0 ? (l12 - 8) >> 1 : (lane & 3) >> 1;
    const float sgn = (lane & 1) ? 1.f : -1.f;
    int row = row_lo + wave_lin;
    if (row >= row_hi) return;
    MlaRow cur; mla_load(cur, U, QU, row, lane);
    for (; row < row_hi; row += nwaves) {
        MlaRow nxt; { const int rn = row + nwaves < row_hi ? row + nwaves : row; mla_load(nxt, U, QU, rn, lane); }
        float ss = 0.f;
        { float f[8]; mla_unpack(cur.nv, f);
#pragma unroll
          for (int i = 0; i < 8; ++i) ss += f[i] * f[i]; }
        const float sq = wave_sum(lane < 24 ? ss : 0.f), sk = wave_sum((lane >= 24 && lane < 40) ? ss : 0.f);
        const float rq = rsqrtf(sq * (1.f / 192.f) + NORM_EPS), rk = rsqrtf(sk * (1.f / 128.f) + NORM_EPS);
        int b, pos; bool lat;
        if (row < NLAT) { b = row >> 14; pos = row & 16383; lat = true; } else { const int r = row - NLAT; b = r >> 8; pos = r & 255; lat = false; }
        const int kpos = lat ? CTXL + pos : pos;
        const float ax = (float)(ropeg ? (pos & 63) : (pos >> 6));
        float cs[8], sn[8];
        { const float inv[8] = {1.f, 0.31622776601683794f, 0.1f, 0.03162277660168379f, 0.01f, 0.003162277660168379f, 0.001f, 0.00031622776601683794f};
#pragma unroll
          for (int i = 0; i < 8; ++i) { const float rev = ax * inv[i] * 0.15915494309189535f;
              cs[i] = lat ? __builtin_amdgcn_cosf(rev) : 1.f; sn[i] = lat ? sgn * __builtin_amdgcn_sinf(rev) : 0.f; } }
        { const u32x4 par = mla_partner(cur.c0);
          const u32x4 o = rope0 ? mla_rot(cur.c0, par, cs, sn, rq * QSC) : mla_scale(cur.c0, rq * QSC);
          *(u32x4*)(Q + (size_t)row * 576 + 8 * lane) = o; }
        { const u32x4 par = mla_partner(cur.c1);
          if (lane < 8) { const u32x4 o = rope1 ? mla_rot(cur.c1, par, cs, sn, rq * QSC) : mla_scale(cur.c1, rq * QSC);
              *(u32x4*)(Q + (size_t)row * 576 + 512 + 8 * lane) = o; } }
        if (lane >= 32) { const int c = lane - 32, hd = c >> 4, cc = c & 15; const size_t base = (size_t)(b * 6 + hd) * KEYS + kpos;
            bf16_t* dst = cc < 8 ? Kb + base * 96 + 8 * cc : Vb + base * 64 + 8 * (cc - 8);
            *(u32x4*)dst = mla_scale(cur.c1, rk); }
        { const int c = lane + 32, hd = c >> 4, cc = c & 15; const size_t base = (size_t)(b * 6 + hd) * KEYS + kpos;
            bf16_t* dst = cc < 8 ? Kb + base * 96 + 8 * cc : Vb + base * 64 + 8 * (cc - 8);
            *(u32x4*)dst = mla_scale(cur.c2, rk); }
        { const u32x4 par = mla_partner(cur.nv);
          if (ropek) { const u32x4 o = mla_rot(cur.nv, par, cs, sn, 1.f);
#pragma unroll
              for (int hd = 0; hd < 6; ++hd) *(u32x4*)(Kb + ((size_t)(b * 6 + hd) * KEYS + kpos) * 96 + 64 + 8 * (lane & 3)) = o; } }
        cur = nxt;
    }
}
constexpr int SSD_UNITS = 2 * 130;
constexpr int SSD_RS = 136;
constexpr int SSD_XT = 0;
constexpr int SSD_B  = SSD_XT + 192 * SSD_RS * 2;
constexpr int SSD_C  = SSD_B + 128 * SSD_RS * 2;
constexpr int SSD_V  = SSD_C + 128 * SSD_RS * 2;
static_assert(SSD_V + 6 * 3 * 128 * 4 <= LDS_MISC, "SSD LDS map");

__device__ __forceinline__ void ssd_unit_rows(int unit, int& b, int& row0, int& qf, int& qb) {
    b = unit / 130; const int c = unit % 130;
    if (c < 2) { row0 = NLAT + b * CTXL + c * 128; qf = c; qb = 1 - c; }
    else { row0 = b * SEQ + (c - 2) * 128; qf = c; qb = 2 + 127 - (c - 2); }
}

template <int PASS>
__device__ __forceinline__ void ssd_stage(const Params& p, int L, int row0, int grp) {
    const bf16_t* U = (const bf16_t*)(p.ws + WS_U);
    bf16_t* XT = (bf16_t*)(smem + SSD_XT); bf16_t* Bl = (bf16_t*)(smem + SSD_B); bf16_t* Cl = (bf16_t*)(smem + SSD_C); float* Vv = (float*)(smem + SSD_V);
    const int tid = tidx();
    int sbase, spos0, slen; row_seq(row0, sbase, spos0, slen);
    if (tid < 448) {
        const int cp = tid % 224, rh = tid / 224, c2 = cp * 2;
        const int src = c2 < 192 ? grp * 192 + c2 : (c2 < 320 ? 384 + grp * 128 + (c2 - 192) : 640 + grp * 128 + (c2 - 320));
        if (PASS == 3 || c2 < 320) {
            const float* cw = p.ssd_conv_w + (size_t)L * 5 * 896 + src; const float* cb = p.ssd_conv_b + L * 896 + src;
            float w0[5], w1[5];
#pragma unroll
            for (int j = 0; j < 5; ++j) { w0[j] = cw[j * 896]; w1[j] = cw[j * 896 + 1]; }
            const float b0 = cb[0], b1 = cb[1];
            const int pos_lo = spos0 + rh * 64;
            const bf16_t* ub = U + (size_t)sbase * UW + U_XBC + src;
            unsigned xr[68];
#pragma unroll
            for (int j = 0; j < 68; ++j) { const int ps = pos_lo - 2 + j; xr[j] = (ps >= 0 && ps < slen) ? *(const unsigned*)(ub + (size_t)ps * UW) : 0u; }
#pragma unroll
            for (int i4 = 0; i4 < 64; i4 += 4) {
                float q0[4], q1[4];
#pragma unroll
                for (int ii = 0; ii < 4; ++ii) { const int i = i4 + ii;
                    float s0 = b0, s1 = b1;
#pragma unroll
                    for (int j = 0; j < 5; ++j) { s0 = fmaf(w0[j], __uint_as_float(xr[i + j] << 16), s0); s1 = fmaf(w1[j], __uint_as_float(xr[i + j] & 0xffff0000u), s1); }
                    q0[ii] = silu_f(s0); q1[ii] = silu_f(s1); }
                const int s = rh * 64 + i4;
                if (c2 < 192 || (PASS == 1 && c2 < 320)) {
                    bf16_t* T = c2 < 192 ? XT + c2 * SSD_RS + s : Bl + (c2 - 192) * SSD_RS + s;
                    u32x2 a = {cvtpk_bf16(q0[0], q0[1]), cvtpk_bf16(q0[2], q0[3])}, b = {cvtpk_bf16(q1[0], q1[1]), cvtpk_bf16(q1[2], q1[3])};
                    *(u32x2*)T = a; *(u32x2*)(T + SSD_RS) = b;
                } else {
                    bf16_t* T = c2 < 320 ? Bl + s * SSD_RS + (c2 - 192) : Cl + s * SSD_RS + (c2 - 320);
#pragma unroll
                    for (int ii = 0; ii < 4; ++ii) *(unsigned*)(T + ii * SSD_RS) = cvtpk_bf16(q0[ii], q1[ii]);
                }
            }
        }
    } else {
        float raw[12];
#pragma unroll
        for (int j = 0; j < 12; ++j) { const int e = tid - 448 + 64 * j, d = e / 384, hh = (e / 128) % 3, s = e % 128; raw[j] = bf2f(U[(size_t)(row0 + s) * UW + U_DT + d * 6 + grp * 3 + hh]); }
#pragma unroll
        for (int j = 0; j < 12; ++j) { const int e = tid - 448 + 64 * j, d = e / 384, hh = (e / 128) % 3, s = e % 128;
            Vv[(d * 3 + hh) * 128 + s] = softplus_f(raw[j] + p.ssd_dt_bias[(L * 2 + d) * 6 + grp * 3 + hh]); }
    }
    __syncthreads();
    if (tid < 384) {
        const int wv = tid >> 6, l = tid & 63, d = wv / 3, hh = wv % 3, h = grp * 3 + hh;
        const float a = -__expf(p.ssd_a_log[(L * 2 + d) * 6 + h]);
        const float* dt = Vv + (d * 3 + hh) * 128; float* cs = Vv + ((2 + d) * 3 + hh) * 128;
        const int s0 = d ? 127 - 2 * l : 2 * l, s1 = d ? 126 - 2 * l : 2 * l + 1;
        const float v0 = dt[s0] * a, v1 = dt[s1] * a;
        const float incl = wave_scan_incl(v0 + v1), excl = incl - (v0 + v1);
        cs[s0] = excl + v0; cs[s1] = incl;
    }
    __syncthreads();
    if (PASS == 1) {
        for (int e = tid; e < 2 * 3 * 128; e += NTHREADS) { const int d = e / 384, hh = (e / 128) % 3, s = e % 128;
            const float* cs = Vv + ((2 + d) * 3 + hh) * 128; const float tot = d ? cs[0] : cs[127];
            Vv[((4 + d) * 3 + hh) * 128 + s] = Vv[(d * 3 + hh) * 128 + s] * __expf(tot - cs[s]); }
        __syncthreads();
    }
}

__device__ void ssd_pass1_unit(const Params& p, int L, int unit) {
    float* SST = (float*)(p.ws + WS_SST); float* SDEC = (float*)(p.ws + WS_SDEC);
    const bf16_t* XT = (const bf16_t*)(smem + SSD_XT); const bf16_t* BT = (const bf16_t*)(smem + SSD_B); const float* Vv = (const float*)(smem + SSD_V);
    int b, row0, qf, qb; ssd_unit_rows(unit, b, row0, qf, qb);
    for (int grp = 0; grp < 2; ++grp) {
        __syncthreads();
        ssd_stage<1>(p, L, row0, grp);
        const int tid = tidx(), lane = tid & 63, w = tid >> 6, fr = lane & 15, g = lane >> 4;
        if (tid < 6) { const int d = tid / 3, hh = tid % 3; const float* cs = Vv + ((2 + d) * 3 + hh) * 128;
            SDEC[((size_t)(d * 2 + b) * 130 + (d ? qb : qf)) * 8 + grp * 3 + hh] = __expf(d ? cs[0] : cs[127]); }
#pragma unroll 1
        for (int dh = 0; dh < 6; ++dh) {
            const int d = dh / 3, hh = dh % 3, h = grp * 3 + hh;
            const float* wd = Vv + ((4 + d) * 3 + hh) * 128;
            bf16x8 bfr[4];
#pragma unroll
            for (int ks = 0; ks < 4; ++ks) {
                const u32x4 raw = *(const u32x4*)(BT + (16 * w + fr) * SSD_RS + 32 * ks + 8 * g);
                const f32x4 wa = *(const f32x4*)(wd + 32 * ks + 8 * g), wb = *(const f32x4*)(wd + 32 * ks + 8 * g + 4);
                u32x4 o;
                o[0] = cvtpk_bf16(__uint_as_float(raw[0] << 16) * wa[0], __uint_as_float(raw[0] & 0xffff0000u) * wa[1]);
                o[1] = cvtpk_bf16(__uint_as_float(raw[1] << 16) * wa[2], __uint_as_float(raw[1] & 0xffff0000u) * wa[3]);
                o[2] = cvtpk_bf16(__uint_as_float(raw[2] << 16) * wb[0], __uint_as_float(raw[2] & 0xffff0000u) * wb[1]);
                o[3] = cvtpk_bf16(__uint_as_float(raw[3] << 16) * wb[2], __uint_as_float(raw[3] & 0xffff0000u) * wb[3]);
                bfr[ks] = *reinterpret_cast<bf16x8*>(&o);
            }
            float* so = SST + ((((size_t)(d * 2 + b) * 130 + (d ? qb : qf)) * 6 + h) * 64) * 128 + 16 * w + fr;
#pragma unroll
            for (int mp = 0; mp < 4; ++mp) {
                f32x4 acc = {0.f, 0.f, 0.f, 0.f};
#pragma unroll
                for (int ks = 0; ks < 4; ++ks) {
                    const bf16x8 af = *(const bf16x8*)(XT + (hh * 64 + 16 * mp + fr) * SSD_RS + 32 * ks + 8 * g);
                    acc = __builtin_amdgcn_mfma_f32_16x16x32_bf16(af, bfr[ks], acc, 0, 0, 0);
                }
#pragma unroll
                for (int r = 0; r < 4; ++r) so[(size_t)(16 * mp + 4 * g + r) * 128] = acc[r];
            }
        }
    }
}

__device__ void ssd_scan_range(const Params& p, int thread_lin, int nthreads_total) {
    const float* SST = (const float*)(p.ws + WS_SST); const float* SDEC = (const float*)(p.ws + WS_SDEC); bf16_t* SB = (bf16_t*)(p.ws + WS_SSTB);
    for (int e = thread_lin; e < 2 * 2 * 6 * 128 * 64; e += nthreads_total) {
        const int db = e / (6 * 128 * 64), r = e % (6 * 128 * 64), h = r / (128 * 64);
        const float* sp = SST + (size_t)db * 130 * 6 * 128 * 64 + r; bf16_t* ob = SB + (size_t)db * 130 * 6 * 128 * 64 + r;
        const float* dp = SDEC + (size_t)db * 130 * 8 + h;
        float cur = 0.f;
#pragma unroll 10
        for (int q = 0; q < 130; ++q) {
            const float tmp = sp[(size_t)q * 6 * 128 * 64];
            ob[(size_t)q * 6 * 128 * 64] = f2bf(cur);
            cur = fmaf(cur, dp[q * 8], tmp);
        }
    }
}

__device__ void ssd_pass3_unit(const Params& p, int L, int unit) {
    const bf16_t* SB = (const bf16_t*)(p.ws + WS_SSTB); const bf16_t* U = (const bf16_t*)(p.ws + WS_U); bf16_t* MIX = (bf16_t*)(p.ws + WS_MIX); float* YS = (float*)(p.ws + WS_YS);
    const bf16_t* XT = (const bf16_t*)(smem + SSD_XT); const bf16_t* Bn = (const bf16_t*)(smem + SSD_B); const bf16_t* Cn = (const bf16_t*)(smem + SSD_C);
    const float* Vv = (const float*)(smem + SSD_V);
    int b, row0, qf, qb; ssd_unit_rows(unit, b, row0, qf, qb);
    float ss = 0.f;
#pragma unroll 1
    for (int grp = 0; grp < 2; ++grp) {
        const size_t hs_f = ((((size_t)(0 * 2 + b) * 130 + qf) * 6 + grp * 3) * 64) * 128, hs_b = ((((size_t)(1 * 2 + b) * 130 + qb) * 6 + grp * 3) * 64) * 128;
        u32x4 es[4];
#define SSD_ES_LOAD(hh_) { const int tid_ = tidx(); _Pragma("unroll") for (int i_ = 0; i_ < 4; ++i_) { const int idx_ = tid_ + 512 * i_, rem_ = idx_ & 1023; \
            es[i_] = *(const u32x4*)(SB + ((idx_ >> 10) ? hs_b : hs_f) + (size_t)(hh_) * 64 * 128 + (rem_ >> 4) * 128 + (rem_ & 15) * 8); } }
        SSD_ES_LOAD(0)
        QREP(10) {
        __syncthreads();
        ssd_stage<3>(p, L, row0, grp);
        }
        const int tid = tidx(), lane = tid & 63, w = tid >> 6, fr = lane & 15, g = lane >> 4;
        const int t = 16 * w + fr;
        const int row = row0 + t;
        bf16x8 cf[4];
#pragma unroll
        for (int ks = 0; ks < 4; ++ks) cf[ks] = *(const bf16x8*)(Cn + t * SSD_RS + 32 * ks + 8 * g);
        f32x4 gt[8];
#pragma unroll
        for (int mt = 0; mt < 8; ++mt) { f32x4 a = {0.f, 0.f, 0.f, 0.f};
#pragma unroll
            for (int ks = 0; ks < 4; ++ks) { const bf16x8 af = *(const bf16x8*)(Bn + (16 * mt + fr) * SSD_RS + 32 * ks + 8 * g);
                a = __builtin_amdgcn_mfma_f32_16x16x32_bf16(af, cf[ks], a, 0, 0, 0); }
            gt[mt] = a; }
        bf16_t* HS = (bf16_t*)(smem + SSD_B);
        const float ss_in = ss;
        { ss = ss_in;
#pragma unroll 1
        for (int hh = 0; hh < 3; ++hh) {
            const int h = grp * 3 + hh;
            const float* dt0 = Vv + (0 * 3 + hh) * 128; const float* dt1 = Vv + (1 * 3 + hh) * 128;
            const float* Av = Vv + (2 * 3 + hh) * 128; const float* Rv = Vv + (3 * 3 + hh) * 128;
            const float tA = Av[t], tR = Rv[t];
            __syncthreads();
            { const int tid_ = tidx();
#pragma unroll
              for (int i_ = 0; i_ < 4; ++i_) { const int idx_ = tid_ + 512 * i_, rem_ = idx_ & 1023; *(u32x4*)(HS + ((idx_ >> 10) * 64 + (rem_ >> 4)) * SSD_RS + (rem_ & 15) * 8) = es[i_]; } }
            __syncthreads();
            if (hh < 2) SSD_ES_LOAD(hh + 1)
            u32x2 zq[4];
#pragma unroll
            for (int mp = 0; mp < 4; ++mp) zq[mp] = *(const u32x2*)(U + (size_t)row * UW + U_Z + h * 64 + 16 * mp + 4 * g);
            bf16x8 wf[4];
#pragma unroll
            for (int ks = 0; ks < 4; ++ks) { u32x4 o;
#pragma unroll
                for (int half = 0; half < 2; ++half) { const int mt = 2 * ks + half, s0 = 16 * mt + 4 * g;
                    const f32x4 sA = *(const f32x4*)(Av + s0), sR = *(const f32x4*)(Rv + s0), d0 = *(const f32x4*)(dt0 + s0), d1 = *(const f32x4*)(dt1 + s0);
                    float wv[4];
#pragma unroll
                    for (int r = 0; r < 4; ++r) { const int s = s0 + r;
                        const float ef = __expf(s < t ? tA - sA[r] : tR - sR[r]);
                        const float m = s < t ? d0[r] * ef : (s > t ? d1[r] * ef : d0[r] + d1[r]);
                        wv[r] = gt[mt][r] * m; }
                    o[half * 2 + 0] = cvtpk_bf16(wv[0], wv[1]); o[half * 2 + 1] = cvtpk_bf16(wv[2], wv[3]); }
                wf[ks] = *reinterpret_cast<bf16x8*>(&o); }
            const float eA = __expf(tA), eR = __expf(tR);
            const float dsk = p.ssd_d[L * 6 + h];
#pragma unroll 1
            for (int mp = 0; mp < 4; ++mp) {
                bf16x8 hc[8];
                { const bf16_t* hl = HS + (16 * mp + fr) * SSD_RS + 8 * g;
#pragma unroll
                  for (int ks = 0; ks < 4; ++ks) { hc[2 * ks] = *(const bf16x8*)(hl + 32 * ks); hc[2 * ks + 1] = *(const bf16x8*)(hl + 64 * SSD_RS + 32 * ks); } }
                f32x4 acc = {0.f, 0.f, 0.f, 0.f};
                const bf16_t* xr = XT + (hh * 64 + 16 * mp + fr) * SSD_RS;
#pragma unroll
                for (int ks = 0; ks < 4; ++ks) {
                    const u32x2 lo = *(const u32x2*)(xr + 32 * ks + 4 * g), hi = *(const u32x2*)(xr + 32 * ks + 16 + 4 * g);
                    u32x4 aw = {lo[0], lo[1], hi[0], hi[1]};
                    acc = __builtin_amdgcn_mfma_f32_16x16x32_bf16(*reinterpret_cast<bf16x8*>(&aw), wf[ks], acc, 0, 0, 0); }
                f32x4 zf = {0.f, 0.f, 0.f, 0.f}, zb = {0.f, 0.f, 0.f, 0.f};
#pragma unroll
                for (int ks = 0; ks < 4; ++ks) {
                    zf = __builtin_amdgcn_mfma_f32_16x16x32_bf16(hc[2 * ks], cf[ks], zf, 0, 0, 0);
                    zb = __builtin_amdgcn_mfma_f32_16x16x32_bf16(hc[2 * ks + 1], cf[ks], zb, 0, 0, 0); }
                const int c = h * 64 + 16 * mp + 4 * g;
                const u32x2 zz = mp == 0 ? zq[0] : (mp == 1 ? zq[1] : (mp == 2 ? zq[2] : zq[3]));
                const float zg[4] = {__uint_as_float(zz[0] << 16), __uint_as_float(zz[0] & 0xffff0000u), __uint_as_float(zz[1] << 16), __uint_as_float(zz[1] & 0xffff0000u)};
#pragma unroll
                for (int r = 0; r < 4; ++r) { float v = acc[r] + eA * zf[r] + eR * zb[r] + dsk * bf2f(XT[(hh * 64 + 16 * mp + 4 * g + r) * SSD_RS + t]);
                    v *= silu_f(zg[r]); ss += v * v; acc[r] = v; }
                *(f32x4*)(YS + (size_t)row * 384 + c) = acc;
            }
        }
        }
    }
    {
        const int tid = tidx(), lane = tid & 63, w = tid >> 6, fr = lane & 15, g = lane >> 4;
        const int row = row0 + 16 * w + fr;
        ss += __int_as_float(__builtin_amdgcn_ds_swizzle(__float_as_int(ss), 0x401F));
        { auto rr = __builtin_amdgcn_permlane32_swap(__float_as_uint(ss), __float_as_uint(ss), false, false); ss = __uint_as_float(rr[0]) + __uint_as_float(rr[1]); }
        const float rs = rsqrtf(ss * (1.f / 384.f) + NORM_EPS);
        const float* nw = p.ssd_norm_w + L * 384;
#pragma unroll 12
        for (int i = 0; i < 24; ++i) { const int c = (i >> 2) * 64 + 16 * (i & 3) + 4 * g; const f32x4 wv = *(const f32x4*)(nw + c); const f32x4 v = *(const f32x4*)(YS + (size_t)row * 384 + c);
            u32x2 o; o[0] = cvtpk_bf16(v[0] * rs * wv[0], v[1] * rs * wv[1]); o[1] = cvtpk_bf16(v[2] * rs * wv[2], v[3] * rs * wv[3]);
            *(u32x2*)(MIX + (size_t)row * 1024 + c) = o; }
    }
}
constexpr size_t WS_RWPW = WS_RWP + (size_t)NTOK * 9 * 256 * 2;
constexpr int RW_UNITS_PREP = NTOK / 16;
__device__ __forceinline__ int rw_perm(int c) { return (c & ~63) | ((c & 15) << 2) | ((c >> 4) & 3); }
constexpr int RW_UCS = 1160;
__device__ void rwkv_prep_unit(const Params& p, int L, int unit) {
    unsigned char* ws = p.ws;
    const bf16_t* U = (const bf16_t*)(ws + WS_U); bf16_t* RWPH = (bf16_t*)(ws + WS_RWP); float* RWPW = (float*)(ws + WS_RWPW);
    const bf16_t* WL = (const bf16_t*)(ws + WS_WLORA) + (size_t)L * 98304;
    float* UC = (float*)smem;
    const int tid = tidx(), lane = tid & 63, w = tid >> 6, fr = lane & 15, g = lane >> 4;
    const int row0 = unit * 16;
    int sbase, spos0, slen; row_seq(row0, sbase, spos0, slen);
    {
        const int c2 = tid * 2;
        const float* sw = p.rwkv_shift_w + (size_t)L * 3 * 1152 + c2;
        const float w00 = sw[0], w01 = sw[1], w10 = sw[1152], w11 = sw[1153], w20 = sw[2304], w21 = sw[2305];
        unsigned xr[18];
#pragma unroll
        for (int j = 0; j < 18; ++j) { const int ps = spos0 - 1 + j; xr[j] = (ps >= 0 && ps < slen) ? *(const unsigned*)(U + (size_t)(row0 - 1 + j) * UW + U_RW + c2) : 0u; }
        const int c2b = 1024 + (tid & 63) * 2, rb = 2 * (tid >> 6);
        const float* swb = p.rwkv_shift_w + (size_t)L * 3 * 1152 + c2b;
        const float v00 = swb[0], v01 = swb[1], v10 = swb[1152], v11 = swb[1153], v20 = swb[2304], v21 = swb[2305];
        unsigned yr[4];
#pragma unroll
        for (int j = 0; j < 4; ++j) { const int ps = spos0 + rb - 1 + j; yr[j] = (ps >= 0 && ps < slen) ? *(const unsigned*)(U + (size_t)(row0 + rb - 1 + j) * UW + U_RW + c2b) : 0u; }
#pragma unroll
        for (int i = 0; i < 16; ++i) {
            float o0 = w00 * __uint_as_float(xr[i] << 16) + w10 * __uint_as_float(xr[i + 1] << 16) + w20 * __uint_as_float(xr[i + 2] << 16);
            float o1 = w01 * __uint_as_float(xr[i] & 0xffff0000u) + w11 * __uint_as_float(xr[i + 1] & 0xffff0000u) + w21 * __uint_as_float(xr[i + 2] & 0xffff0000u);
            if (c2 >= 768 && c2 < 896) { o0 = tanh_f(o0); o1 = tanh_f(o1); }
            UC[i * RW_UCS + c2] = o0; UC[i * RW_UCS + c2 + 1] = o1;
        }
#pragma unroll
        for (int i = 0; i < 2; ++i) {
            const float o0 = v00 * __uint_as_float(yr[i] << 16) + v10 * __uint_as_float(yr[i + 1] << 16) + v20 * __uint_as_float(yr[i + 2] << 16);
            const float o1 = v01 * __uint_as_float(yr[i] & 0xffff0000u) + v11 * __uint_as_float(yr[i + 1] & 0xffff0000u) + v21 * __uint_as_float(yr[i + 2] & 0xffff0000u);
            UC[(rb + i) * RW_UCS + c2b] = sigmoid_f(o0); UC[(rb + i) * RW_UCS + c2b + 1] = sigmoid_f(o1);
        }
    }
    __syncthreads();
    const int h = w & 3, half = w >> 2;
    f32x4 aw[2][4], aa[2][4], ag[4];
#pragma unroll
    for (int nt = 0; nt < 4; ++nt) { ag[nt] = (f32x4){0.f, 0.f, 0.f, 0.f};
#pragma unroll
        for (int d = 0; d < 2; ++d) { aw[d][nt] = (f32x4){0.f, 0.f, 0.f, 0.f}; aa[d][nt] = (f32x4){0.f, 0.f, 0.f, 0.f}; } }
    {
        const float* ur = UC + fr * RW_UCS + 8 * g;
        const bf16_t* wb = WL + (size_t)(h * 64 + fr) * 64 + 8 * g;
        const bf16_t* gb = WL + 65536 + (size_t)(h * 64 + fr) * 128 + 8 * g;
#pragma unroll
        for (int d = 0; d < 2; ++d)
#pragma unroll
            for (int ks = 0; ks < 2; ++ks) {
                const f32x4 x0 = *(const f32x4*)(ur + 768 + d * 64 + 32 * ks), x1 = *(const f32x4*)(ur + 768 + d * 64 + 32 * ks + 4);
                const f32x4 y0 = *(const f32x4*)(ur + 896 + d * 64 + 32 * ks), y1 = *(const f32x4*)(ur + 896 + d * 64 + 32 * ks + 4);
                u32x4 xw = {cvtpk_bf16(x0[0], x0[1]), cvtpk_bf16(x0[2], x0[3]), cvtpk_bf16(x1[0], x1[1]), cvtpk_bf16(x1[2], x1[3])};
                u32x4 yw = {cvtpk_bf16(y0[0], y0[1]), cvtpk_bf16(y0[2], y0[3]), cvtpk_bf16(y1[0], y1[1]), cvtpk_bf16(y1[2], y1[3])};
#pragma unroll
                for (int nt = 0; nt < 4; ++nt) {
                    const bf16x8 bw = *(const bf16x8*)(wb + d * 16384 + nt * 1024 + ks * 32), ba = *(const bf16x8*)(wb + 32768 + d * 16384 + nt * 1024 + ks * 32);
                    aw[d][nt] = __builtin_amdgcn_mfma_f32_16x16x32_bf16(*reinterpret_cast<bf16x8*>(&xw), bw, aw[d][nt], 0, 0, 0);
                    aa[d][nt] = __builtin_amdgcn_mfma_f32_16x16x32_bf16(*reinterpret_cast<bf16x8*>(&yw), ba, aa[d][nt], 0, 0, 0); }
            }
#pragma unroll
        for (int ks = 0; ks < 4; ++ks) {
            const f32x4 x0 = *(const f32x4*)(ur + 1024 + 32 * ks), x1 = *(const f32x4*)(ur + 1024 + 32 * ks + 4);
            u32x4 xw = {cvtpk_bf16(x0[0], x0[1]), cvtpk_bf16(x0[2], x0[3]), cvtpk_bf16(x1[0], x1[1]), cvtpk_bf16(x1[2], x1[3])};
#pragma unroll
            for (int nt = 0; nt < 4; ++nt) { const bf16x8 bg = *(const bf16x8*)(gb + nt * 2048 + ks * 32);
                ag[nt] = __builtin_amdgcn_mfma_f32_16x16x32_bf16(*reinterpret_cast<bf16x8*>(&xw), bg, ag[nt], 0, 0, 0); }
        }
    }
    float w0a[4], w0b[4], a0a[4], a0b[4], kkw[4], kaw[4], rkw[4];
#pragma unroll
    for (int nt = 0; nt < 4; ++nt) { const int c = h * 64 + 16 * nt + fr;
        w0a[nt] = p.rwkv_w0[(L * 2 + 0) * 256 + c]; w0b[nt] = p.rwkv_w0[(L * 2 + 1) * 256 + c];
        a0a[nt] = p.rwkv_a0[(L * 2 + 0) * 256 + c]; a0b[nt] = p.rwkv_a0[(L * 2 + 1) * 256 + c];
        kkw[nt] = p.rwkv_k_k[L * 256 + c]; kaw[nt] = p.rwkv_k_a[L * 256 + c]; rkw[nt] = p.rwkv_r_k[L * 256 + c]; }
#pragma unroll
    for (int rr = 0; rr < 2; ++rr) {
        const int reg = 2 * half + rr, t = 4 * g + reg;
        const float* uc = UC + t * RW_UCS + h * 64 + fr;
        float r[4], k[4], v[4], kr[4], as0[4], as1[4], kd0[4], kd1[4];
        float ss = 0.f, bs = 0.f;
#pragma unroll
        for (int nt = 0; nt < 4; ++nt) {
            r[nt] = uc[16 * nt]; k[nt] = uc[256 + 16 * nt]; v[nt] = uc[512 + 16 * nt];
            as0[nt] = sigmoid_f(a0a[nt] + aa[0][nt][reg]); as1[nt] = sigmoid_f(a0b[nt] + aa[1][nt][reg]);
            kr[nt] = k[nt] * kkw[nt]; ss += kr[nt] * kr[nt];
            kd0[nt] = k[nt] * (1.f + (as0[nt] - 1.f) * kaw[nt]); kd1[nt] = k[nt] * (1.f + (as1[nt] - 1.f) * kaw[nt]);
            bs += r[nt] * (kd0[nt] + kd1[nt]) * rkw[nt]; }
        ss = row16_sum(ss); bs = row16_sum(bs);
        const float rn = 1.f / fmaxf(__builtin_amdgcn_sqrtf(ss), 1e-12f);
        bf16_t* orow = RWPH + (size_t)(row0 + t) * 9 * 256;
        bf16_t* op = orow + h * 64 + fr * 4;
        float* opw = RWPW + (size_t)(row0 + t) * 512 + h * 64 + fr * 4;
#define RW_ST4(F, a0_, a1_, a2_, a3_) { u32x2 o_ = {cvtpk_bf16(a0_, a1_), cvtpk_bf16(a2_, a3_)}; *(u32x2*)(op + (F) * 256) = o_; }
        RW_ST4(0, r[0], r[1], r[2], r[3])
        float kn[4];
#pragma unroll
        for (int nt = 0; nt < 4; ++nt) kn[nt] = kr[nt] * rn;
        RW_ST4(2, kn[0], kn[1], kn[2], kn[3])
        RW_ST4(7, kn[0] * as0[0], kn[1] * as0[1], kn[2] * as0[2], kn[3] * as0[3])
        RW_ST4(8, kn[0] * as1[0], kn[1] * as1[1], kn[2] * as1[2], kn[3] * as1[3])
        f32x4 q;
#pragma unroll
        for (int nt = 0; nt < 4; ++nt) { const float wl0 = -softplus_f(-(w0a[nt] + aw[0][nt][reg])) - 0.5f; q[nt] = __expf(-__expf(wl0)); }
        *(f32x4*)(opw + 0 * 256) = q;
#pragma unroll
        for (int nt = 0; nt < 4; ++nt) { const float wl1 = -softplus_f(-(w0b[nt] + aw[1][nt][reg])) - 0.5f; q[nt] = __expf(-__expf(wl1)); }
        *(f32x4*)(opw + 1 * 256) = q;
        RW_ST4(5, kd0[0], kd0[1], kd0[2], kd0[3])
        RW_ST4(6, kd1[0], kd1[1], kd1[2], kd1[3])
#pragma unroll
        for (int nt = 0; nt < 4; ++nt) { bf16_t* o = orow + h * 64 + 16 * nt + fr; o[1 * 256] = f2bf(v[nt]); o[3 * 256] = f2bf(bs * v[nt]); o[4 * 256] = f2bf(ag[nt][reg]); }
    }
}

__device__ __forceinline__ int rw_chunk_row0(int d, int b, int q) {
    if (d == 0) return q < 4 ? NLAT + b * CTXL + q * 64 : b * SEQ + (q - 4) * 64;
    return q < 4 ? NLAT + b * CTXL + (3 - q) * 64 : b * SEQ + (255 - (q - 4)) * 64;
}
constexpr int RW_UNITS = 2 * 2 * 260;

#define RW_FMAC(acc, vec, n, x) asm("v_fmac_f32_dpp %0, %1, %2 row_newbcast:" #n " row_mask:0xf bank_mask:0xf" : "+v"(acc) : "v"(vec), "v"(x))
#define RW_MUL(d, vec, n, x) asm("v_mul_f32_dpp %0, %1, %2 row_newbcast:" #n " row_mask:0xf bank_mask:0xf" : "=v"(d) : "v"(vec), "v"(x))
#define RW_HAZ() asm volatile("s_nop 1" ::: "memory")

#if !RW_UT
__device__ void rwkv_passA_unit(const Params& p, int unit) {
    const float* RWP = (const float*)(p.ws + WS_RWP); float* RPQ = (float*)(p.ws + WS_RPQ); float* RY = (float*)(p.ws + WS_RY);
    const int lane = tidx() & 63, wid = wave_id(), h = wid & 3, kind = wid >> 2;
    const int d = unit / 520, b = (unit / 260) & 1, q = unit % 260;
    const int row0 = rw_chunk_row0(d, b, q);
    float s[64];
#pragma unroll
    for (int k = 0; k < 64; ++k) s[k] = (kind == 0 && k == lane) ? 1.f : 0.f;
    const int rstep = d ? -1 : 1; int row = d ? row0 + 63 : row0;
    const float* lb = RWP + h * 64 + (lane & 15) * 4;
    const size_t cs = ((size_t)(d * 2 + b) * 260 + q) * 4 + h;
    float* yo = RY + (cs * 2 + kind) * 4096 + lane;
    f32x4 wv = *(const f32x4*)(lb + ((size_t)row * 11 + 5 + d) * 256), av = *(const f32x4*)(lb + ((size_t)row * 11 + 2) * 256);
    f32x4 bv = *(const f32x4*)(lb + ((size_t)row * 11 + 9 + d) * 256), kv = *(const f32x4*)(lb + ((size_t)row * 11 + 7 + d) * 256);
    f32x4 rv = *(const f32x4*)(lb + ((size_t)row * 11 + 0) * 256);
    float vv = kind ? RWP[((size_t)row * 11 + 1) * 256 + h * 64 + lane] : 0.f;
    if (kind) {
#pragma unroll 1
        for (int i = 0; i < 64; ++i) {
            row += rstep; const int rn = i < 63 ? row : row - rstep;
            const f32x4 wn = *(const f32x4*)(lb + ((size_t)rn * 11 + 5 + d) * 256), an = *(const f32x4*)(lb + ((size_t)rn * 11 + 2) * 256);
            const f32x4 bn = *(const f32x4*)(lb + ((size_t)rn * 11 + 9 + d) * 256), kn = *(const f32x4*)(lb + ((size_t)rn * 11 + 7 + d) * 256);
            const f32x4 rnv = *(const f32x4*)(lb + ((size_t)rn * 11 + 0) * 256);
            const float vn = RWP[((size_t)rn * 11 + 1) * 256 + h * 64 + lane];
            float sa0 = 0.f, sa1 = 0.f, sa2 = 0.f, sa3 = 0.f, sa4 = 0.f, sa5 = 0.f, sa6 = 0.f, sa7 = 0.f;
            RW_HAZ();
            { const float a_ = av[0]; RW_FMAC(sa0, a_, 0, s[0]); }
            { const float a_ = av[0]; RW_FMAC(sa1, a_, 1, s[1]); }
            { const float a_ = av[0]; RW_FMAC(sa2, a_, 2, s[2]); }
            { const float a_ = av[0]; RW_FMAC(sa3, a_, 3, s[3]); }
            { const float a_ = av[0]; RW_FMAC(sa4, a_, 4, s[4]); }
            { const float a_ = av[0]; RW_FMAC(sa5, a_, 5, s[5]); }
            { const float a_ = av[0]; RW_FMAC(sa6, a_, 6, s[6]); }
            { const float a_ = av[0]; RW_FMAC(sa7, a_, 7, s[7]); }
            { const float a_ = av[0]; RW_FMAC(sa0, a_, 8, s[8]); }
            { const float a_ = av[0]; RW_FMAC(sa1, a_, 9, s[9]); }
            { const float a_ = av[0]; RW_FMAC(sa2, a_, 10, s[10]); }
            { const float a_ = av[0]; RW_FMAC(sa3, a_, 11, s[11]); }
            { const float a_ = av[0]; RW_FMAC(sa4, a_, 12, s[12]); }
            { const float a_ = av[0]; RW_FMAC(sa5, a_, 13, s[13]); }
            { const float a_ = av[0]; RW_FMAC(sa6, a_, 14, s[14]); }
            { const float a_ = av[0]; RW_FMAC(sa7, a_, 15, s[15]); }
            { const float a_ = av[1]; RW_FMAC(sa0, a_, 0, s[16]); }
            { const float a_ = av[1]; RW_FMAC(sa1, a_, 1, s[17]); }
            { const float a_ = av[1]; RW_FMAC(sa2, a_, 2, s[18]); }
            { const float a_ = av[1]; RW_FMAC(sa3, a_, 3, s[19]); }
            { const float a_ = av[1]; RW_FMAC(sa4, a_, 4, s[20]); }
            { const float a_ = av[1]; RW_FMAC(sa5, a_, 5, s[21]); }
            { const float a_ = av[1]; RW_FMAC(sa6, a_, 6, s[22]); }
            { const float a_ = av[1]; RW_FMAC(sa7, a_, 7, s[23]); }
            { const float a_ = av[1]; RW_FMAC(sa0, a_, 8, s[24]); }
            { const float a_ = av[1]; RW_FMAC(sa1, a_, 9, s[25]); }
            { const float a_ = av[1]; RW_FMAC(sa2, a_, 10, s[26]); }
            { const float a_ = av[1]; RW_FMAC(sa3, a_, 11, s[27]); }
            { const float a_ = av[1]; RW_FMAC(sa4, a_, 12, s[28]); }
            { const float a_ = av[1]; RW_FMAC(sa5, a_, 13, s[29]); }
            { const float a_ = av[1]; RW_FMAC(sa6, a_, 14, s[30]); }
            { const float a_ = av[1]; RW_FMAC(sa7, a_, 15, s[31]); }
            { const float a_ = av[2]; RW_FMAC(sa0, a_, 0, s[32]); }
            { const float a_ = av[2]; RW_FMAC(sa1, a_, 1, s[33]); }
            { const float a_ = av[2]; RW_FMAC(sa2, a_, 2, s[34]); }
            { const float a_ = av[2]; RW_FMAC(sa3, a_, 3, s[35]); }
            { const float a_ = av[2]; RW_FMAC(sa4, a_, 4, s[36]); }
            { const float a_ = av[2]; RW_FMAC(sa5, a_, 5, s[37]); }
            { const float a_ = av[2]; RW_FMAC(sa6, a_, 6, s[38]); }
            { const float a_ = av[2]; RW_FMAC(sa7, a_, 7, s[39]); }
            { const float a_ = av[2]; RW_FMAC(sa0, a_, 8, s[40]); }
            { const float a_ = av[2]; RW_FMAC(sa1, a_, 9, s[41]); }
            { const float a_ = av[2]; RW_FMAC(sa2, a_, 10, s[42]); }
            { const float a_ = av[2]; RW_FMAC(sa3, a_, 11, s[43]); }
            { const float a_ = av[2]; RW_FMAC(sa4, a_, 12, s[44]); }
            { const float a_ = av[2]; RW_FMAC(sa5, a_, 13, s[45]); }
            { const float a_ = av[2]; RW_FMAC(sa6, a_, 14, s[46]); }
            { const float a_ = av[2]; RW_FMAC(sa7, a_, 15, s[47]); }
            { const float a_ = av[3]; RW_FMAC(sa0, a_, 0, s[48]); }
            { const float a_ = av[3]; RW_FMAC(sa1, a_, 1, s[49]); }
            { const float a_ = av[3]; RW_FMAC(sa2, a_, 2, s[50]); }
            { const float a_ = av[3]; RW_FMAC(sa3, a_, 3, s[51]); }
            { const float a_ = av[3]; RW_FMAC(sa4, a_, 4, s[52]); }
            { const float a_ = av[3]; RW_FMAC(sa5, a_, 5, s[53]); }
            { const float a_ = av[3]; RW_FMAC(sa6, a_, 6, s[54]); }
            { const float a_ = av[3]; RW_FMAC(sa7, a_, 7, s[55]); }
            { const float a_ = av[3]; RW_FMAC(sa0, a_, 8, s[56]); }
            { const float a_ = av[3]; RW_FMAC(sa1, a_, 9, s[57]); }
            { const float a_ = av[3]; RW_FMAC(sa2, a_, 10, s[58]); }
            { const float a_ = av[3]; RW_FMAC(sa3, a_, 11, s[59]); }
            { const float a_ = av[3]; RW_FMAC(sa4, a_, 12, s[60]); }
            { const float a_ = av[3]; RW_FMAC(sa5, a_, 13, s[61]); }
            { const float a_ = av[3]; RW_FMAC(sa6, a_, 14, s[62]); }
            { const float a_ = av[3]; RW_FMAC(sa7, a_, 15, s[63]); }
            const float sa = -(((sa0 + sa1) + (sa2 + sa3)) + ((sa4 + sa5) + (sa6 + sa7)));
            { const float w_ = wv[0]; float t_; RW_MUL(t_, w_, 0, s[0]); s[0] = t_; }
            { const float w_ = wv[0]; float t_; RW_MUL(t_, w_, 1, s[1]); s[1] = t_; }
            { const float w_ = wv[0]; float t_; RW_MUL(t_, w_, 2, s[2]); s[2] = t_; }
            { const float w_ = wv[0]; float t_; RW_MUL(t_, w_, 3, s[3]); s[3] = t_; }
            { const float w_ = wv[0]; float t_; RW_MUL(t_, w_, 4, s[4]); s[4] = t_; }
            { const float w_ = wv[0]; float t_; RW_MUL(t_, w_, 5, s[5]); s[5] = t_; }
            { const float w_ = wv[0]; float t_; RW_MUL(t_, w_, 6, s[6]); s[6] = t_; }
            { const float w_ = wv[0]; float t_; RW_MUL(t_, w_, 7, s[7]); s[7] = t_; }
            { const float w_ = wv[0]; float t_; RW_MUL(t_, w_, 8, s[8]); s[8] = t_; }
            { const float w_ = wv[0]; float t_; RW_MUL(t_, w_, 9, s[9]); s[9] = t_; }
            { const float w_ = wv[0]; float t_; RW_MUL(t_, w_, 10, s[10]); s[10] = t_; }
            { const float w_ = wv[0]; float t_; RW_MUL(t_, w_, 11, s[11]); s[11] = t_; }
            { const float w_ = wv[0]; float t_; RW_MUL(t_, w_, 12, s[12]); s[12] = t_; }
            { const float w_ = wv[0]; float t_; RW_MUL(t_, w_, 13, s[13]); s[13] = t_; }
            { const float w_ = wv[0]; float t_; RW_MUL(t_, w_, 14, s[14]); s[14] = t_; }
            { const float w_ = wv[0]; float t_; RW_MUL(t_, w_, 15, s[15]); s[15] = t_; }
            { const float w_ = wv[1]; float t_; RW_MUL(t_, w_, 0, s[16]); s[16] = t_; }
            { const float w_ = wv[1]; float t_; RW_MUL(t_, w_, 1, s[17]); s[17] = t_; }
            { const float w_ = wv[1]; float t_; RW_MUL(t_, w_, 2, s[18]); s[18] = t_; }
            { const float w_ = wv[1]; float t_; RW_MUL(t_, w_, 3, s[19]); s[19] = t_; }
            { const float w_ = wv[1]; float t_; RW_MUL(t_, w_, 4, s[20]); s[20] = t_; }
            { const float w_ = wv[1]; float t_; RW_MUL(t_, w_, 5, s[21]); s[21] = t_; }
            { const float w_ = wv[1]; float t_; RW_MUL(t_, w_, 6, s[22]); s[22] = t_; }
            { const float w_ = wv[1]; float t_; RW_MUL(t_, w_, 7, s[23]); s[23] = t_; }
            { const float w_ = wv[1]; float t_; RW_MUL(t_, w_, 8, s[24]); s[24] = t_; }
            { const float w_ = wv[1]; float t_; RW_MUL(t_, w_, 9, s[25]); s[25] = t_; }
            { const float w_ = wv[1]; float t_; RW_MUL(t_, w_, 10, s[26]); s[26] = t_; }
            { const float w_ = wv[1]; float t_; RW_MUL(t_, w_, 11, s[27]); s[27] = t_; }
            { const float w_ = wv[1]; float t_; RW_MUL(t_, w_, 12, s[28]); s[28] = t_; }
            { const float w_ = wv[1]; float t_; RW_MUL(t_, w_, 13, s[29]); s[29] = t_; }
            { const float w_ = wv[1]; float t_; RW_MUL(t_, w_, 14, s[30]); s[30] = t_; }
            { const float w_ = wv[1]; float t_; RW_MUL(t_, w_, 15, s[31]); s[31] = t_; }
            { const float w_ = wv[2]; float t_; RW_MUL(t_, w_, 0, s[32]); s[32] = t_; }
            { const float w_ = wv[2]; float t_; RW_MUL(t_, w_, 1, s[33]); s[33] = t_; }
            { const float w_ = wv[2]; float t_; RW_MUL(t_, w_, 2, s[34]); s[34] = t_; }
            { const float w_ = wv[2]; float t_; RW_MUL(t_, w_, 3, s[35]); s[35] = t_; }
            { const float w_ = wv[2]; float t_; RW_MUL(t_, w_, 4, s[36]); s[36] = t_; }
            { const float w_ = wv[2]; float t_; RW_MUL(t_, w_, 5, s[37]); s[37] = t_; }
            { const float w_ = wv[2]; float t_; RW_MUL(t_, w_, 6, s[38]); s[38] = t_; }
            { const float w_ = wv[2]; float t_; RW_MUL(t_, w_, 7, s[39]); s[39] = t_; }
            { const float w_ = wv[2]; float t_; RW_MUL(t_, w_, 8, s[40]); s[40] = t_; }
            { const float w_ = wv[2]; float t_; RW_MUL(t_, w_, 9, s[41]); s[41] = t_; }
            { const float w_ = wv[2]; float t_; RW_MUL(t_, w_, 10, s[42]); s[42] = t_; }
            { const float w_ = wv[2]; float t_; RW_MUL(t_, w_, 11, s[43]); s[43] = t_; }
            { const float w_ = wv[2]; float t_; RW_MUL(t_, w_, 12, s[44]); s[44] = t_; }
            { const float w_ = wv[2]; float t_; RW_MUL(t_, w_, 13, s[45]); s[45] = t_; }
            { const float w_ = wv[2]; float t_; RW_MUL(t_, w_, 14, s[46]); s[46] = t_; }
            { const float w_ = wv[2]; float t_; RW_MUL(t_, w_, 15, s[47]); s[47] = t_; }
            { const float w_ = wv[3]; float t_; RW_MUL(t_, w_, 0, s[48]); s[48] = t_; }
            { const float w_ = wv[3]; float t_; RW_MUL(t_, w_, 1, s[49]); s[49] = t_; }
            { const float w_ = wv[3]; float t_; RW_MUL(t_, w_, 2, s[50]); s[50] = t_; }
            { const float w_ = wv[3]; float t_; RW_MUL(t_, w_, 3, s[51]); s[51] = t_; }
            { const float w_ = wv[3]; float t_; RW_MUL(t_, w_, 4, s[52]); s[52] = t_; }
            { const float w_ = wv[3]; float t_; RW_MUL(t_, w_, 5, s[53]); s[53] = t_; }
            { const float w_ = wv[3]; float t_; RW_MUL(t_, w_, 6, s[54]); s[54] = t_; }
            { const float w_ = wv[3]; float t_; RW_MUL(t_, w_, 7, s[55]); s[55] = t_; }
            { const float w_ = wv[3]; float t_; RW_MUL(t_, w_, 8, s[56]); s[56] = t_; }
            { const float w_ = wv[3]; float t_; RW_MUL(t_, w_, 9, s[57]); s[57] = t_; }
            { const float w_ = wv[3]; float t_; RW_MUL(t_, w_, 10, s[58]); s[58] = t_; }
            { const float w_ = wv[3]; float t_; RW_MUL(t_, w_, 11, s[59]); s[59] = t_; }
            { const float w_ = wv[3]; float t_; RW_MUL(t_, w_, 12, s[60]); s[60] = t_; }
            { const float w_ = wv[3]; float t_; RW_MUL(t_, w_, 13, s[61]); s[61] = t_; }
            { const float w_ = wv[3]; float t_; RW_MUL(t_, w_, 14, s[62]); s[62] = t_; }
            { const float w_ = wv[3]; float t_; RW_MUL(t_, w_, 15, s[63]); s[63] = t_; }
            { const float b_ = bv[0]; RW_FMAC(s[0], b_, 0, sa); }
            { const float b_ = bv[0]; RW_FMAC(s[1], b_, 1, sa); }
            { const float b_ = bv[0]; RW_FMAC(s[2], b_, 2, sa); }
            { const float b_ = bv[0]; RW_FMAC(s[3], b_, 3, sa); }
            { const float b_ = bv[0]; RW_FMAC(s[4], b_, 4, sa); }
            { const float b_ = bv[0]; RW_FMAC(s[5], b_, 5, sa); }
            { const float b_ = bv[0]; RW_FMAC(s[6], b_, 6, sa); }
            { const float b_ = bv[0]; RW_FMAC(s[7], b_, 7, sa); }
            { const float b_ = bv[0]; RW_FMAC(s[8], b_, 8, sa); }
            { const float b_ = bv[0]; RW_FMAC(s[9], b_, 9, sa); }
            { const float b_ = bv[0]; RW_FMAC(s[10], b_, 10, sa); }
            { const float b_ = bv[0]; RW_FMAC(s[11], b_, 11, sa); }
            { const float b_ = bv[0]; RW_FMAC(s[12], b_, 12, sa); }
            { const float b_ = bv[0]; RW_FMAC(s[13], b_, 13, sa); }
            { const float b_ = bv[0]; RW_FMAC(s[14], b_, 14, sa); }
            { const float b_ = bv[0]; RW_FMAC(s[15], b_, 15, sa); }
            { const float b_ = bv[1]; RW_FMAC(s[16], b_, 0, sa); }
            { const float b_ = bv[1]; RW_FMAC(s[17], b_, 1, sa); }
            { const float b_ = bv[1]; RW_FMAC(s[18], b_, 2, sa); }
            { const float b_ = bv[1]; RW_FMAC(s[19], b_, 3, sa); }
            { const float b_ = bv[1]; RW_FMAC(s[20], b_, 4, sa); }
            { const float b_ = bv[1]; RW_FMAC(s[21], b_, 5, sa); }
            { const float b_ = bv[1]; RW_FMAC(s[22], b_, 6, sa); }
            { const float b_ = bv[1]; RW_FMAC(s[23], b_, 7, sa); }
            { const float b_ = bv[1]; RW_FMAC(s[24], b_, 8, sa); }
            { const float b_ = bv[1]; RW_FMAC(s[25], b_, 9, sa); }
            { const float b_ = bv[1]; RW_FMAC(s[26], b_, 10, sa); }
            { const float b_ = bv[1]; RW_FMAC(s[27], b_, 11, sa); }
            { const float b_ = bv[1]; RW_FMAC(s[28], b_, 12, sa); }
            { const float b_ = bv[1]; RW_FMAC(s[29], b_, 13, sa); }
            { const float b_ = bv[1]; RW_FMAC(s[30], b_, 14, sa); }
            { const float b_ = bv[1]; RW_FMAC(s[31], b_, 15, sa); }
            { const float b_ = bv[2]; RW_FMAC(s[32], b_, 0, sa); }
            { const float b_ = bv[2]; RW_FMAC(s[33], b_, 1, sa); }
            { const float b_ = bv[2]; RW_FMAC(s[34], b_, 2, sa); }
            { const float b_ = bv[2]; RW_FMAC(s[35], b_, 3, sa); }
            { const float b_ = bv[2]; RW_FMAC(s[36], b_, 4, sa); }
            { const float b_ = bv[2]; RW_FMAC(s[37], b_, 5, sa); }
            { const float b_ = bv[2]; RW_FMAC(s[38], b_, 6, sa); }
            { const float b_ = bv[2]; RW_FMAC(s[39], b_, 7, sa); }
            { const float b_ = bv[2]; RW_FMAC(s[40], b_, 8, sa); }
            { const float b_ = bv[2]; RW_FMAC(s[41], b_, 9, sa); }
            { const float b_ = bv[2]; RW_FMAC(s[42], b_, 10, sa); }
            { const float b_ = bv[2]; RW_FMAC(s[43], b_, 11, sa); }
            { const float b_ = bv[2]; RW_FMAC(s[44], b_, 12, sa); }
            { const float b_ = bv[2]; RW_FMAC(s[45], b_, 13, sa); }
            { const float b_ = bv[2]; RW_FMAC(s[46], b_, 14, sa); }
            { const float b_ = bv[2]; RW_FMAC(s[47], b_, 15, sa); }
            { const float b_ = bv[3]; RW_FMAC(s[48], b_, 0, sa); }
            { const float b_ = bv[3]; RW_FMAC(s[49], b_, 1, sa); }
            { const float b_ = bv[3]; RW_FMAC(s[50], b_, 2, sa); }
            { const float b_ = bv[3]; RW_FMAC(s[51], b_, 3, sa); }
            { const float b_ = bv[3]; RW_FMAC(s[52], b_, 4, sa); }
            { const float b_ = bv[3]; RW_FMAC(s[53], b_, 5, sa); }
            { const float b_ = bv[3]; RW_FMAC(s[54], b_, 6, sa); }
            { const float b_ = bv[3]; RW_FMAC(s[55], b_, 7, sa); }
            { const float b_ = bv[3]; RW_FMAC(s[56], b_, 8, sa); }
            { const float b_ = bv[3]; RW_FMAC(s[57], b_, 9, sa); }
            { const float b_ = bv[3]; RW_FMAC(s[58], b_, 10, sa); }
            { const float b_ = bv[3]; RW_FMAC(s[59], b_, 11, sa); }
            { const float b_ = bv[3]; RW_FMAC(s[60], b_, 12, sa); }
            { const float b_ = bv[3]; RW_FMAC(s[61], b_, 13, sa); }
            { const float b_ = bv[3]; RW_FMAC(s[62], b_, 14, sa); }
            { const float b_ = bv[3]; RW_FMAC(s[63], b_, 15, sa); }
            { const float k_ = kv[0]; RW_FMAC(s[0], k_, 0, vv); }
            { const float k_ = kv[0]; RW_FMAC(s[1], k_, 1, vv); }
            { const float k_ = kv[0]; RW_FMAC(s[2], k_, 2, vv); }
            { const float k_ = kv[0]; RW_FMAC(s[3], k_, 3, vv); }
            { const float k_ = kv[0]; RW_FMAC(s[4], k_, 4, vv); }
            { const float k_ = kv[0]; RW_FMAC(s[5], k_, 5, vv); }
            { const float k_ = kv[0]; RW_FMAC(s[6], k_, 6, vv); }
            { const float k_ = kv[0]; RW_FMAC(s[7], k_, 7, vv); }
            { const float k_ = kv[0]; RW_FMAC(s[8], k_, 8, vv); }
            { const float k_ = kv[0]; RW_FMAC(s[9], k_, 9, vv); }
            { const float k_ = kv[0]; RW_FMAC(s[10], k_, 10, vv); }
            { const float k_ = kv[0]; RW_FMAC(s[11], k_, 11, vv); }
            { const float k_ = kv[0]; RW_FMAC(s[12], k_, 12, vv); }
            { const float k_ = kv[0]; RW_FMAC(s[13], k_, 13, vv); }
            { const float k_ = kv[0]; RW_FMAC(s[14], k_, 14, vv); }
            { const float k_ = kv[0]; RW_FMAC(s[15], k_, 15, vv); }
            { const float k_ = kv[1]; RW_FMAC(s[16], k_, 0, vv); }
            { const float k_ = kv[1]; RW_FMAC(s[17], k_, 1, vv); }
            { const float k_ = kv[1]; RW_FMAC(s[18], k_, 2, vv); }
            { const float k_ = kv[1]; RW_FMAC(s[19], k_, 3, vv); }
            { const float k_ = kv[1]; RW_FMAC(s[20], k_, 4, vv); }
            { const float k_ = kv[1]; RW_FMAC(s[21], k_, 5, vv); }
            { const float k_ = kv[1]; RW_FMAC(s[22], k_, 6, vv); }
            { const float k_ = kv[1]; RW_FMAC(s[23], k_, 7, vv); }
            { const float k_ = kv[1]; RW_FMAC(s[24], k_, 8, vv); }
            { const float k_ = kv[1]; RW_FMAC(s[25], k_, 9, vv); }
            { const float k_ = kv[1]; RW_FMAC(s[26], k_, 10, vv); }
            { const float k_ = kv[1]; RW_FMAC(s[27], k_, 11, vv); }
            { const float k_ = kv[1]; RW_FMAC(s[28], k_, 12, vv); }
            { const float k_ = kv[1]; RW_FMAC(s[29], k_, 13, vv); }
            { const float k_ = kv[1]; RW_FMAC(s[30], k_, 14, vv); }
            { const float k_ = kv[1]; RW_FMAC(s[31], k_, 15, vv); }
            { const float k_ = kv[2]; RW_FMAC(s[32], k_, 0, vv); }
            { const float k_ = kv[2]; RW_FMAC(s[33], k_, 1, vv); }
            { const float k_ = kv[2]; RW_FMAC(s[34], k_, 2, vv); }
            { const float k_ = kv[2]; RW_FMAC(s[35], k_, 3, vv); }
            { const float k_ = kv[2]; RW_FMAC(s[36], k_, 4, vv); }
            { const float k_ = kv[2]; RW_FMAC(s[37], k_, 5, vv); }
            { const float k_ = kv[2]; RW_FMAC(s[38], k_, 6, vv); }
            { const float k_ = kv[2]; RW_FMAC(s[39], k_, 7, vv); }
            { const float k_ = kv[2]; RW_FMAC(s[40], k_, 8, vv); }
            { const float k_ = kv[2]; RW_FMAC(s[41], k_, 9, vv); }
            { const float k_ = kv[2]; RW_FMAC(s[42], k_, 10, vv); }
            { const float k_ = kv[2]; RW_FMAC(s[43], k_, 11, vv); }
            { const float k_ = kv[2]; RW_FMAC(s[44], k_, 12, vv); }
            { const float k_ = kv[2]; RW_FMAC(s[45], k_, 13, vv); }
            { const float k_ = kv[2]; RW_FMAC(s[46], k_, 14, vv); }
            { const float k_ = kv[2]; RW_FMAC(s[47], k_, 15, vv); }
            { const float k_ = kv[3]; RW_FMAC(s[48], k_, 0, vv); }
            { const float k_ = kv[3]; RW_FMAC(s[49], k_, 1, vv); }
            { const float k_ = kv[3]; RW_FMAC(s[50], k_, 2, vv); }
            { const float k_ = kv[3]; RW_FMAC(s[51], k_, 3, vv); }
            { const float k_ = kv[3]; RW_FMAC(s[52], k_, 4, vv); }
            { const float k_ = kv[3]; RW_FMAC(s[53], k_, 5, vv); }
            { const float k_ = kv[3]; RW_FMAC(s[54], k_, 6, vv); }
            { const float k_ = kv[3]; RW_FMAC(s[55], k_, 7, vv); }
            { const float k_ = kv[3]; RW_FMAC(s[56], k_, 8, vv); }
            { const float k_ = kv[3]; RW_FMAC(s[57], k_, 9, vv); }
            { const float k_ = kv[3]; RW_FMAC(s[58], k_, 10, vv); }
            { const float k_ = kv[3]; RW_FMAC(s[59], k_, 11, vv); }
            { const float k_ = kv[3]; RW_FMAC(s[60], k_, 12, vv); }
            { const float k_ = kv[3]; RW_FMAC(s[61], k_, 13, vv); }
            { const float k_ = kv[3]; RW_FMAC(s[62], k_, 14, vv); }
            { const float k_ = kv[3]; RW_FMAC(s[63], k_, 15, vv); }
            float y0 = 0.f, y1 = 0.f, y2 = 0.f, y3 = 0.f, y4 = 0.f, y5 = 0.f, y6 = 0.f, y7 = 0.f;
            { const float a_ = rv[0]; RW_FMAC(y0, a_, 0, s[0]); }
            { const float a_ = rv[0]; RW_FMAC(y1, a_, 1, s[1]); }
            { const float a_ = rv[0]; RW_FMAC(y2, a_, 2, s[2]); }
            { const float a_ = rv[0]; RW_FMAC(y3, a_, 3, s[3]); }
            { const float a_ = rv[0]; RW_FMAC(y4, a_, 4, s[4]); }
            { const float a_ = rv[0]; RW_FMAC(y5, a_, 5, s[5]); }
            { const float a_ = rv[0]; RW_FMAC(y6, a_, 6, s[6]); }
            { const float a_ = rv[0]; RW_FMAC(y7, a_, 7, s[7]); }
            { const float a_ = rv[0]; RW_FMAC(y0, a_, 8, s[8]); }
            { const float a_ = rv[0]; RW_FMAC(y1, a_, 9, s[9]); }
            { const float a_ = rv[0]; RW_FMAC(y2, a_, 10, s[10]); }
            { const float a_ = rv[0]; RW_FMAC(y3, a_, 11, s[11]); }
            { const float a_ = rv[0]; RW_FMAC(y4, a_, 12, s[12]); }
            { const float a_ = rv[0]; RW_FMAC(y5, a_, 13, s[13]); }
            { const float a_ = rv[0]; RW_FMAC(y6, a_, 14, s[14]); }
            { const float a_ = rv[0]; RW_FMAC(y7, a_, 15, s[15]); }
            { const float a_ = rv[1]; RW_FMAC(y0, a_, 0, s[16]); }
            { const float a_ = rv[1]; RW_FMAC(y1, a_, 1, s[17]); }
            { const float a_ = rv[1]; RW_FMAC(y2, a_, 2, s[18]); }
            { const float a_ = rv[1]; RW_FMAC(y3, a_, 3, s[19]); }
            { const float a_ = rv[1]; RW_FMAC(y4, a_, 4, s[20]); }
            { const float a_ = rv[1]; RW_FMAC(y5, a_, 5, s[21]); }
            { const float a_ = rv[1]; RW_FMAC(y6, a_, 6, s[22]); }
            { const float a_ = rv[1]; RW_FMAC(y7, a_, 7, s[23]); }
            { const float a_ = rv[1]; RW_FMAC(y0, a_, 8, s[24]); }
            { const float a_ = rv[1]; RW_FMAC(y1, a_, 9, s[25]); }
            { const float a_ = rv[1]; RW_FMAC(y2, a_, 10, s[26]); }
            { const float a_ = rv[1]; RW_FMAC(y3, a_, 11, s[27]); }
            { const float a_ = rv[1]; RW_FMAC(y4, a_, 12, s[28]); }
            { const float a_ = rv[1]; RW_FMAC(y5, a_, 13, s[29]); }
            { const float a_ = rv[1]; RW_FMAC(y6, a_, 14, s[30]); }
            { const float a_ = rv[1]; RW_FMAC(y7, a_, 15, s[31]); }
            { const float a_ = rv[2]; RW_FMAC(y0, a_, 0, s[32]); }
            { const float a_ = rv[2]; RW_FMAC(y1, a_, 1, s[33]); }
            { const float a_ = rv[2]; RW_FMAC(y2, a_, 2, s[34]); }
            { const float a_ = rv[2]; RW_FMAC(y3, a_, 3, s[35]); }
            { const float a_ = rv[2]; RW_FMAC(y4, a_, 4, s[36]); }
            { const float a_ = rv[2]; RW_FMAC(y5, a_, 5, s[37]); }
            { const float a_ = rv[2]; RW_FMAC(y6, a_, 6, s[38]); }
            { const float a_ = rv[2]; RW_FMAC(y7, a_, 7, s[39]); }
            { const float a_ = rv[2]; RW_FMAC(y0, a_, 8, s[40]); }
            { const float a_ = rv[2]; RW_FMAC(y1, a_, 9, s[41]); }
            { const float a_ = rv[2]; RW_FMAC(y2, a_, 10, s[42]); }
            { const float a_ = rv[2]; RW_FMAC(y3, a_, 11, s[43]); }
            { const float a_ = rv[2]; RW_FMAC(y4, a_, 12, s[44]); }
            { const float a_ = rv[2]; RW_FMAC(y5, a_, 13, s[45]); }
            { const float a_ = rv[2]; RW_FMAC(y6, a_, 14, s[46]); }
            { const float a_ = rv[2]; RW_FMAC(y7, a_, 15, s[47]); }
            { const float a_ = rv[3]; RW_FMAC(y0, a_, 0, s[48]); }
            { const float a_ = rv[3]; RW_FMAC(y1, a_, 1, s[49]); }
            { const float a_ = rv[3]; RW_FMAC(y2, a_, 2, s[50]); }
            { const float a_ = rv[3]; RW_FMAC(y3, a_, 3, s[51]); }
            { const float a_ = rv[3]; RW_FMAC(y4, a_, 4, s[52]); }
            { const float a_ = rv[3]; RW_FMAC(y5, a_, 5, s[53]); }
            { const float a_ = rv[3]; RW_FMAC(y6, a_, 6, s[54]); }
            { const float a_ = rv[3]; RW_FMAC(y7, a_, 7, s[55]); }
            { const float a_ = rv[3]; RW_FMAC(y0, a_, 8, s[56]); }
            { const float a_ = rv[3]; RW_FMAC(y1, a_, 9, s[57]); }
            { const float a_ = rv[3]; RW_FMAC(y2, a_, 10, s[58]); }
            { const float a_ = rv[3]; RW_FMAC(y3, a_, 11, s[59]); }
            { const float a_ = rv[3]; RW_FMAC(y4, a_, 12, s[60]); }
            { const float a_ = rv[3]; RW_FMAC(y5, a_, 13, s[61]); }
            { const float a_ = rv[3]; RW_FMAC(y6, a_, 14, s[62]); }
            { const float a_ = rv[3]; RW_FMAC(y7, a_, 15, s[63]); }
            yo[i * 64] = ((y0 + y1) + (y2 + y3)) + ((y4 + y5) + (y6 + y7));
            wv = wn; av = an; bv = bn; kv = kn; rv = rnv; vv = vn;
        }
    } else {
#pragma unroll 1
        for (int i = 0; i < 64; ++i) {
            row += rstep; const int rn = i < 63 ? row : row - rstep;
            const f32x4 wn = *(const f32x4*)(lb + ((size_t)rn * 11 + 5 + d) * 256), an = *(const f32x4*)(lb + ((size_t)rn * 11 + 2) * 256);
            const f32x4 bn = *(const f32x4*)(lb + ((size_t)rn * 11 + 9 + d) * 256), rnv = *(const f32x4*)(lb + ((size_t)rn * 11 + 0) * 256);
            float sa0 = 0.f, sa1 = 0.f, sa2 = 0.f, sa3 = 0.f, sa4 = 0.f, sa5 = 0.f, sa6 = 0.f, sa7 = 0.f;
            RW_HAZ();
            { const float a_ = av[0]; RW_FMAC(sa0, a_, 0, s[0]); }
            { const float a_ = av[0]; RW_FMAC(sa1, a_, 1, s[1]); }
            { const float a_ = av[0]; RW_FMAC(sa2, a_, 2, s[2]); }
            { const float a_ = av[0]; RW_FMAC(sa3, a_, 3, s[3]); }
            { const float a_ = av[0]; RW_FMAC(sa4, a_, 4, s[4]); }
            { const float a_ = av[0]; RW_FMAC(sa5, a_, 5, s[5]); }
            { const float a_ = av[0]; RW_FMAC(sa6, a_, 6, s[6]); }
            { const float a_ = av[0]; RW_FMAC(sa7, a_, 7, s[7]); }
            { const float a_ = av[0]; RW_FMAC(sa0, a_, 8, s[8]); }
            { const float a_ = av[0]; RW_FMAC(sa1, a_, 9, s[9]); }
            { const float a_ = av[0]; RW_FMAC(sa2, a_, 10, s[10]); }
            { const float a_ = av[0]; RW_FMAC(sa3, a_, 11, s[11]); }
            { const float a_ = av[0]; RW_FMAC(sa4, a_, 12, s[12]); }
            { const float a_ = av[0]; RW_FMAC(sa5, a_, 13, s[13]); }
            { const float a_ = av[0]; RW_FMAC(sa6, a_, 14, s[14]); }
            { const float a_ = av[0]; RW_FMAC(sa7, a_, 15, s[15]); }
            { const float a_ = av[1]; RW_FMAC(sa0, a_, 0, s[16]); }
            { const float a_ = av[1]; RW_FMAC(sa1, a_, 1, s[17]); }
            { const float a_ = av[1]; RW_FMAC(sa2, a_, 2, s[18]); }
            { const float a_ = av[1]; RW_FMAC(sa3, a_, 3, s[19]); }
            { const float a_ = av[1]; RW_FMAC(sa4, a_, 4, s[20]); }
            { const float a_ = av[1]; RW_FMAC(sa5, a_, 5, s[21]); }
            { const float a_ = av[1]; RW_FMAC(sa6, a_, 6, s[22]); }
            { const float a_ = av[1]; RW_FMAC(sa7, a_, 7, s[23]); }
            { const float a_ = av[1]; RW_FMAC(sa0, a_, 8, s[24]); }
            { const float a_ = av[1]; RW_FMAC(sa1, a_, 9, s[25]); }
            { const float a_ = av[1]; RW_FMAC(sa2, a_, 10, s[26]); }
            { const float a_ = av[1]; RW_FMAC(sa3, a_, 11, s[27]); }
            { const float a_ = av[1]; RW_FMAC(sa4, a_, 12, s[28]); }
            { const float a_ = av[1]; RW_FMAC(sa5, a_, 13, s[29]); }
            { const float a_ = av[1]; RW_FMAC(sa6, a_, 14, s[30]); }
            { const float a_ = av[1]; RW_FMAC(sa7, a_, 15, s[31]); }
            { const float a_ = av[2]; RW_FMAC(sa0, a_, 0, s[32]); }
            { const float a_ = av[2]; RW_FMAC(sa1, a_, 1, s[33]); }
            { const float a_ = av[2]; RW_FMAC(sa2, a_, 2, s[34]); }
            { const float a_ = av[2]; RW_FMAC(sa3, a_, 3, s[35]); }
            { const float a_ = av[2]; RW_FMAC(sa4, a_, 4, s[36]); }
            { const float a_ = av[2]; RW_FMAC(sa5, a_, 5, s[37]); }
            { const float a_ = av[2]; RW_FMAC(sa6, a_, 6, s[38]); }
            { const float a_ = av[2]; RW_FMAC(sa7, a_, 7, s[39]); }
            { const float a_ = av[2]; RW_FMAC(sa0, a_, 8, s[40]); }
            { const float a_ = av[2]; RW_FMAC(sa1, a_, 9, s[41]); }
            { const float a_ = av[2]; RW_FMAC(sa2, a_, 10, s[42]); }
            { const float a_ = av[2]; RW_FMAC(sa3, a_, 11, s[43]); }
            { const float a_ = av[2]; RW_FMAC(sa4, a_, 12, s[44]); }
            { const float a_ = av[2]; RW_FMAC(sa5, a_, 13, s[45]); }
            { const float a_ = av[2]; RW_FMAC(sa6, a_, 14, s[46]); }
            { const float a_ = av[2]; RW_FMAC(sa7, a_, 15, s[47]); }
            { const float a_ = av[3]; RW_FMAC(sa0, a_, 0, s[48]); }
            { const float a_ = av[3]; RW_FMAC(sa1, a_, 1, s[49]); }
            { const float a_ = av[3]; RW_FMAC(sa2, a_, 2, s[50]); }
            { const float a_ = av[3]; RW_FMAC(sa3, a_, 3, s[51]); }
            { const float a_ = av[3]; RW_FMAC(sa4, a_, 4, s[52]); }
            { const float a_ = av[3]; RW_FMAC(sa5, a_, 5, s[53]); }
            { const float a_ = av[3]; RW_FMAC(sa6, a_, 6, s[54]); }
            { const float a_ = av[3]; RW_FMAC(sa7, a_, 7, s[55]); }
            { const float a_ = av[3]; RW_FMAC(sa0, a_, 8, s[56]); }
            { const float a_ = av[3]; RW_FMAC(sa1, a_, 9, s[57]); }
            { const float a_ = av[3]; RW_FMAC(sa2, a_, 10, s[58]); }
            { const float a_ = av[3]; RW_FMAC(sa3, a_, 11, s[59]); }
            { const float a_ = av[3]; RW_FMAC(sa4, a_, 12, s[60]); }
            { const float a_ = av[3]; RW_FMAC(sa5, a_, 13, s[61]); }
            { const float a_ = av[3]; RW_FMAC(sa6, a_, 14, s[62]); }
            { const float a_ = av[3]; RW_FMAC(sa7, a_, 15, s[63]); }
            const float sa = -(((sa0 + sa1) + (sa2 + sa3)) + ((sa4 + sa5) + (sa6 + sa7)));
            { const float w_ = wv[0]; float t_; RW_MUL(t_, w_, 0, s[0]); s[0] = t_; }
            { const float w_ = wv[0]; float t_; RW_MUL(t_, w_, 1, s[1]); s[1] = t_; }
            { const float w_ = wv[0]; float t_; RW_MUL(t_, w_, 2, s[2]); s[2] = t_; }
            { const float w_ = wv[0]; float t_; RW_MUL(t_, w_, 3, s[3]); s[3] = t_; }
            { const float w_ = wv[0]; float t_; RW_MUL(t_, w_, 4, s[4]); s[4] = t_; }
            { const float w_ = wv[0]; float t_; RW_MUL(t_, w_, 5, s[5]); s[5] = t_; }
            { const float w_ = wv[0]; float t_; RW_MUL(t_, w_, 6, s[6]); s[6] = t_; }
            { const float w_ = wv[0]; float t_; RW_MUL(t_, w_, 7, s[7]); s[7] = t_; }
            { const float w_ = wv[0]; float t_; RW_MUL(t_, w_, 8, s[8]); s[8] = t_; }
            { const float w_ = wv[0]; float t_; RW_MUL(t_, w_, 9, s[9]); s[9] = t_; }
            { const float w_ = wv[0]; float t_; RW_MUL(t_, w_, 10, s[10]); s[10] = t_; }
            { const float w_ = wv[0]; float t_; RW_MUL(t_, w_, 11, s[11]); s[11] = t_; }
            { const float w_ = wv[0]; float t_; RW_MUL(t_, w_, 12, s[12]); s[12] = t_; }
            { const float w_ = wv[0]; float t_; RW_MUL(t_, w_, 13, s[13]); s[13] = t_; }
            { const float w_ = wv[0]; float t_; RW_MUL(t_, w_, 14, s[14]); s[14] = t_; }
            { const float w_ = wv[0]; float t_; RW_MUL(t_, w_, 15, s[15]); s[15] = t_; }
            { const float w_ = wv[1]; float t_; RW_MUL(t_, w_, 0, s[16]); s[16] = t_; }
            { const float w_ = wv[1]; float t_; RW_MUL(t_, w_, 1, s[17]); s[17] = t_; }
            { const float w_ = wv[1]; float t_; RW_MUL(t_, w_, 2, s[18]); s[18] = t_; }
            { const float w_ = wv[1]; float t_; RW_MUL(t_, w_, 3, s[19]); s[19] = t_; }
            { const float w_ = wv[1]; float t_; RW_MUL(t_, w_, 4, s[20]); s[20] = t_; }
            { const float w_ = wv[1]; float t_; RW_MUL(t_, w_, 5, s[21]); s[21] = t_; }
            { const float w_ = wv[1]; float t_; RW_MUL(t_, w_, 6, s[22]); s[22] = t_; }
            { const float w_ = wv[1]; float t_; RW_MUL(t_, w_, 7, s[23]); s[23] = t_; }
            { const float w_ = wv[1]; float t_; RW_MUL(t_, w_, 8, s[24]); s[24] = t_; }
            { const float w_ = wv[1]; float t_; RW_MUL(t_, w_, 9, s[25]); s[25] = t_; }
            { const float w_ = wv[1]; float t_; RW_MUL(t_, w_, 10, s[26]); s[26] = t_; }
            { const float w_ = wv[1]; float t_; RW_MUL(t_, w_, 11, s[27]); s[27] = t_; }
            { const float w_ = wv[1]; float t_; RW_MUL(t_, w_, 12, s[28]); s[28] = t_; }
            { const float w_ = wv[1]; float t_; RW_MUL(t_, w_, 13, s[29]); s[29] = t_; }
            { const float w_ = wv[1]; float t_; RW_MUL(t_, w_, 14, s[30]); s[30] = t_; }
            { const float w_ = wv[1]; float t_; RW_MUL(t_, w_, 15, s[31]); s[31] = t_; }
            { const float w_ = wv[2]; float t_; RW_MUL(t_, w_, 0, s[32]); s[32] = t_; }
            { const float w_ = wv[2]; float t_; RW_MUL(t_, w_, 1, s[33]); s[33] = t_; }
            { const float w_ = wv[2]; float t_; RW_MUL(t_, w_, 2, s[34]); s[34] = t_; }
            { const float w_ = wv[2]; float t_; RW_MUL(t_, w_, 3, s[35]); s[35] = t_; }
            { const float w_ = wv[2]; float t_; RW_MUL(t_, w_, 4, s[36]); s[36] = t_; }
            { const float w_ = wv[2]; float t_; RW_MUL(t_, w_, 5, s[37]); s[37] = t_; }
            { const float w_ = wv[2]; float t_; RW_MUL(t_, w_, 6, s[38]); s[38] = t_; }
            { const float w_ = wv[2]; float t_; RW_MUL(t_, w_, 7, s[39]); s[39] = t_; }
            { const float w_ = wv[2]; float t_; RW_MUL(t_, w_, 8, s[40]); s[40] = t_; }
            { const float w_ = wv[2]; float t_; RW_MUL(t_, w_, 9, s[41]); s[41] = t_; }
            { const float w_ = wv[2]; float t_; RW_MUL(t_, w_, 10, s[42]); s[42] = t_; }
            { const float w_ = wv[2]; float t_; RW_MUL(t_, w_, 11, s[43]); s[43] = t_; }
            { const float w_ = wv[2]; float t_; RW_MUL(t_, w_, 12, s[44]); s[44] = t_; }
            { const float w_ = wv[2]; float t_; RW_MUL(t_, w_, 13, s[45]); s[45] = t_; }
            { const float w_ = wv[2]; float t_; RW_MUL(t_, w_, 14, s[46]); s[46] = t_; }
            { const float w_ = wv[2]; float t_; RW_MUL(t_, w_, 15, s[47]); s[47] = t_; }
            { const float w_ = wv[3]; float t_; RW_MUL(t_, w_, 0, s[48]); s[48] = t_; }
            { const float w_ = wv[3]; float t_; RW_MUL(t_, w_, 1, s[49]); s[49] = t_; }
            { const float w_ = wv[3]; float t_; RW_MUL(t_, w_, 2, s[50]); s[50] = t_; }
            { const float w_ = wv[3]; float t_; RW_MUL(t_, w_, 3, s[51]); s[51] = t_; }
            { const float w_ = wv[3]; float t_; RW_MUL(t_, w_, 4, s[52]); s[52] = t_; }
            { const float w_ = wv[3]; float t_; RW_MUL(t_, w_, 5, s[53]); s[53] = t_; }
            { const float w_ = wv[3]; float t_; RW_MUL(t_, w_, 6, s[54]); s[54] = t_; }
            { const float w_ = wv[3]; float t_; RW_MUL(t_, w_, 7, s[55]); s[55] = t_; }
            { const float w_ = wv[3]; float t_; RW_MUL(t_, w_, 8, s[56]); s[56] = t_; }
            { const float w_ = wv[3]; float t_; RW_MUL(t_, w_, 9, s[57]); s[57] = t_; }
            { const float w_ = wv[3]; float t_; RW_MUL(t_, w_, 10, s[58]); s[58] = t_; }
            { const float w_ = wv[3]; float t_; RW_MUL(t_, w_, 11, s[59]); s[59] = t_; }
            { const float w_ = wv[3]; float t_; RW_MUL(t_, w_, 12, s[60]); s[60] = t_; }
            { const float w_ = wv[3]; float t_; RW_MUL(t_, w_, 13, s[61]); s[61] = t_; }
            { const float w_ = wv[3]; float t_; RW_MUL(t_, w_, 14, s[62]); s[62] = t_; }
            { const float w_ = wv[3]; float t_; RW_MUL(t_, w_, 15, s[63]); s[63] = t_; }
            { const float b_ = bv[0]; RW_FMAC(s[0], b_, 0, sa); }
            { const float b_ = bv[0]; RW_FMAC(s[1], b_, 1, sa); }
            { const float b_ = bv[0]; RW_FMAC(s[2], b_, 2, sa); }
            { const float b_ = bv[0]; RW_FMAC(s[3], b_, 3, sa); }
            { const float b_ = bv[0]; RW_FMAC(s[4], b_, 4, sa); }
            { const float b_ = bv[0]; RW_FMAC(s[5], b_, 5, sa); }
            { const float b_ = bv[0]; RW_FMAC(s[6], b_, 6, sa); }
            { const float b_ = bv[0]; RW_FMAC(s[7], b_, 7, sa); }
            { const float b_ = bv[0]; RW_FMAC(s[8], b_, 8, sa); }
            { const float b_ = bv[0]; RW_FMAC(s[9], b_, 9, sa); }
            { const float b_ = bv[0]; RW_FMAC(s[10], b_, 10, sa); }
            { const float b_ = bv[0]; RW_FMAC(s[11], b_, 11, sa); }
            { const float b_ = bv[0]; RW_FMAC(s[12], b_, 12, sa); }
            { const float b_ = bv[0]; RW_FMAC(s[13], b_, 13, sa); }
            { const float b_ = bv[0]; RW_FMAC(s[14], b_, 14, sa); }
            { const float b_ = bv[0]; RW_FMAC(s[15], b_, 15, sa); }
            { const float b_ = bv[1]; RW_FMAC(s[16], b_, 0, sa); }
            { const float b_ = bv[1]; RW_FMAC(s[17], b_, 1, sa); }
            { const float b_ = bv[1]; RW_FMAC(s[18], b_, 2, sa); }
            { const float b_ = bv[1]; RW_FMAC(s[19], b_, 3, sa); }
            { const float b_ = bv[1]; RW_FMAC(s[20], b_, 4, sa); }
            { const float b_ = bv[1]; RW_FMAC(s[21], b_, 5, sa); }
            { const float b_ = bv[1]; RW_FMAC(s[22], b_, 6, sa); }
            { const float b_ = bv[1]; RW_FMAC(s[23], b_, 7, sa); }
            { const float b_ = bv[1]; RW_FMAC(s[24], b_, 8, sa); }
            { const float b_ = bv[1]; RW_FMAC(s[25], b_, 9, sa); }
            { const float b_ = bv[1]; RW_FMAC(s[26], b_, 10, sa); }
            { const float b_ = bv[1]; RW_FMAC(s[27], b_, 11, sa); }
            { const float b_ = bv[1]; RW_FMAC(s[28], b_, 12, sa); }
            { const float b_ = bv[1]; RW_FMAC(s[29], b_, 13, sa); }
            { const float b_ = bv[1]; RW_FMAC(s[30], b_, 14, sa); }
            { const float b_ = bv[1]; RW_FMAC(s[31], b_, 15, sa); }
            { const float b_ = bv[2]; RW_FMAC(s[32], b_, 0, sa); }
            { const float b_ = bv[2]; RW_FMAC(s[33], b_, 1, sa); }
            { const float b_ = bv[2]; RW_FMAC(s[34], b_, 2, sa); }
            { const float b_ = bv[2]; RW_FMAC(s[35], b_, 3, sa); }
            { const float b_ = bv[2]; RW_FMAC(s[36], b_, 4, sa); }
            { const float b_ = bv[2]; RW_FMAC(s[37], b_, 5, sa); }
            { const float b_ = bv[2]; RW_FMAC(s[38], b_, 6, sa); }
            { const float b_ = bv[2]; RW_FMAC(s[39], b_, 7, sa); }
            { const float b_ = bv[2]; RW_FMAC(s[40], b_, 8, sa); }
            { const float b_ = bv[2]; RW_FMAC(s[41], b_, 9, sa); }
            { const float b_ = bv[2]; RW_FMAC(s[42], b_, 10, sa); }
            { const float b_ = bv[2]; RW_FMAC(s[43], b_, 11, sa); }
            { const float b_ = bv[2]; RW_FMAC(s[44], b_, 12, sa); }
            { const float b_ = bv[2]; RW_FMAC(s[45], b_, 13, sa); }
            { const float b_ = bv[2]; RW_FMAC(s[46], b_, 14, sa); }
            { const float b_ = bv[2]; RW_FMAC(s[47], b_, 15, sa); }
            { const float b_ = bv[3]; RW_FMAC(s[48], b_, 0, sa); }
            { const float b_ = bv[3]; RW_FMAC(s[49], b_, 1, sa); }
            { const float b_ = bv[3]; RW_FMAC(s[50], b_, 2, sa); }
            { const float b_ = bv[3]; RW_FMAC(s[51], b_, 3, sa); }
            { const float b_ = bv[3]; RW_FMAC(s[52], b_, 4, sa); }
            { const float b_ = bv[3]; RW_FMAC(s[53], b_, 5, sa); }
            { const float b_ = bv[3]; RW_FMAC(s[54], b_, 6, sa); }
            { const float b_ = bv[3]; RW_FMAC(s[55], b_, 7, sa); }
            { const float b_ = bv[3]; RW_FMAC(s[56], b_, 8, sa); }
            { const float b_ = bv[3]; RW_FMAC(s[57], b_, 9, sa); }
            { const float b_ = bv[3]; RW_FMAC(s[58], b_, 10, sa); }
            { const float b_ = bv[3]; RW_FMAC(s[59], b_, 11, sa); }
            { const float b_ = bv[3]; RW_FMAC(s[60], b_, 12, sa); }
            { const float b_ = bv[3]; RW_FMAC(s[61], b_, 13, sa); }
            { const float b_ = bv[3]; RW_FMAC(s[62], b_, 14, sa); }
            { const float b_ = bv[3]; RW_FMAC(s[63], b_, 15, sa); }
            float y0 = 0.f, y1 = 0.f, y2 = 0.f, y3 = 0.f, y4 = 0.f, y5 = 0.f, y6 = 0.f, y7 = 0.f;
            { const float a_ = rv[0]; RW_FMAC(y0, a_, 0, s[0]); }
            { const float a_ = rv[0]; RW_FMAC(y1, a_, 1, s[1]); }
            { const float a_ = rv[0]; RW_FMAC(y2, a_, 2, s[2]); }
            { const float a_ = rv[0]; RW_FMAC(y3, a_, 3, s[3]); }
            { const float a_ = rv[0]; RW_FMAC(y4, a_, 4, s[4]); }
            { const float a_ = rv[0]; RW_FMAC(y5, a_, 5, s[5]); }
            { const float a_ = rv[0]; RW_FMAC(y6, a_, 6, s[6]); }
            { const float a_ = rv[0]; RW_FMAC(y7, a_, 7, s[7]); }
            { const float a_ = rv[0]; RW_FMAC(y0, a_, 8, s[8]); }
            { const float a_ = rv[0]; RW_FMAC(y1, a_, 9, s[9]); }
            { const float a_ = rv[0]; RW_FMAC(y2, a_, 10, s[10]); }
            { const float a_ = rv[0]; RW_FMAC(y3, a_, 11, s[11]); }
            { const float a_ = rv[0]; RW_FMAC(y4, a_, 12, s[12]); }
            { const float a_ = rv[0]; RW_FMAC(y5, a_, 13, s[13]); }
            { const float a_ = rv[0]; RW_FMAC(y6, a_, 14, s[14]); }
            { const float a_ = rv[0]; RW_FMAC(y7, a_, 15, s[15]); }
            { const float a_ = rv[1]; RW_FMAC(y0, a_, 0, s[16]); }
            { const float a_ = rv[1]; RW_FMAC(y1, a_, 1, s[17]); }
            { const float a_ = rv[1]; RW_FMAC(y2, a_, 2, s[18]); }
            { const float a_ = rv[1]; RW_FMAC(y3, a_, 3, s[19]); }
            { const float a_ = rv[1]; RW_FMAC(y4, a_, 4, s[20]); }
            { const float a_ = rv[1]; RW_FMAC(y5, a_, 5, s[21]); }
            { const float a_ = rv[1]; RW_FMAC(y6, a_, 6, s[22]); }
            { const float a_ = rv[1]; RW_FMAC(y7, a_, 7, s[23]); }
            { const float a_ = rv[1]; RW_FMAC(y0, a_, 8, s[24]); }
            { const float a_ = rv[1]; RW_FMAC(y1, a_, 9, s[25]); }
            { const float a_ = rv[1]; RW_FMAC(y2, a_, 10, s[26]); }
            { const float a_ = rv[1]; RW_FMAC(y3, a_, 11, s[27]); }
            { const float a_ = rv[1]; RW_FMAC(y4, a_, 12, s[28]); }
            { const float a_ = rv[1]; RW_FMAC(y5, a_, 13, s[29]); }
            { const float a_ = rv[1]; RW_FMAC(y6, a_, 14, s[30]); }
            { const float a_ = rv[1]; RW_FMAC(y7, a_, 15, s[31]); }
            { const float a_ = rv[2]; RW_FMAC(y0, a_, 0, s[32]); }
            { const float a_ = rv[2]; RW_FMAC(y1, a_, 1, s[33]); }
            { const float a_ = rv[2]; RW_FMAC(y2, a_, 2, s[34]); }
            { const float a_ = rv[2]; RW_FMAC(y3, a_, 3, s[35]); }
            { const float a_ = rv[2]; RW_FMAC(y4, a_, 4, s[36]); }
            { const float a_ = rv[2]; RW_FMAC(y5, a_, 5, s[37]); }
            { const float a_ = rv[2]; RW_FMAC(y6, a_, 6, s[38]); }
            { const float a_ = rv[2]; RW_FMAC(y7, a_, 7, s[39]); }
            { const float a_ = rv[2]; RW_FMAC(y0, a_, 8, s[40]); }
            { const float a_ = rv[2]; RW_FMAC(y1, a_, 9, s[41]); }
            { const float a_ = rv[2]; RW_FMAC(y2, a_, 10, s[42]); }
            { const float a_ = rv[2]; RW_FMAC(y3, a_, 11, s[43]); }
            { const float a_ = rv[2]; RW_FMAC(y4, a_, 12, s[44]); }
            { const float a_ = rv[2]; RW_FMAC(y5, a_, 13, s[45]); }
            { const float a_ = rv[2]; RW_FMAC(y6, a_, 14, s[46]); }
            { const float a_ = rv[2]; RW_FMAC(y7, a_, 15, s[47]); }
            { const float a_ = rv[3]; RW_FMAC(y0, a_, 0, s[48]); }
            { const float a_ = rv[3]; RW_FMAC(y1, a_, 1, s[49]); }
            { const float a_ = rv[3]; RW_FMAC(y2, a_, 2, s[50]); }
            { const float a_ = rv[3]; RW_FMAC(y3, a_, 3, s[51]); }
            { const float a_ = rv[3]; RW_FMAC(y4, a_, 4, s[52]); }
            { const float a_ = rv[3]; RW_FMAC(y5, a_, 5, s[53]); }
            { const float a_ = rv[3]; RW_FMAC(y6, a_, 6, s[54]); }
            { const float a_ = rv[3]; RW_FMAC(y7, a_, 7, s[55]); }
            { const float a_ = rv[3]; RW_FMAC(y0, a_, 8, s[56]); }
            { const float a_ = rv[3]; RW_FMAC(y1, a_, 9, s[57]); }
            { const float a_ = rv[3]; RW_FMAC(y2, a_, 10, s[58]); }
            { const float a_ = rv[3]; RW_FMAC(y3, a_, 11, s[59]); }
            { const float a_ = rv[3]; RW_FMAC(y4, a_, 12, s[60]); }
            { const float a_ = rv[3]; RW_FMAC(y5, a_, 13, s[61]); }
            { const float a_ = rv[3]; RW_FMAC(y6, a_, 14, s[62]); }
            { const float a_ = rv[3]; RW_FMAC(y7, a_, 15, s[63]); }
            yo[i * 64] = ((y0 + y1) + (y2 + y3)) + ((y4 + y5) + (y6 + y7));
            wv = wn; av = an; bv = bn; rv = rnv;
        }
    }
    float* o = RPQ + (cs * 2 + kind) * 4096;
    if (kind) {
#pragma unroll
        for (int k = 0; k < 64; ++k) o[k * 64 + lane] = s[k];
    } else {
        bf16_t* ph = (bf16_t*)o;
        const int ks = lane >> 5, rem = lane & 31, jj = 4 * (rem >> 4) + (rem & 3), g = (rem >> 2) & 3;
#pragma unroll
        for (int k2 = 0; k2 < 64; ++k2) { const int mt = k2 >> 4, r = k2 & 15; const int idx = (((mt * 2 + ks) * 64 + g * 16 + r) * 8 + jj);
            ph[idx] = f2bf(s[k2]); }
    }
}

#endif
struct RwBPre { bf16x8 ah[8]; f32x4 qv[4]; };
__device__ __forceinline__ void rwB_load(RwBPre& o, const float* RPQ, size_t cb, int lane, int vt) {
    const bf16x8* ph = (const bf16x8*)(RPQ + (cb * 2 + 0) * 4096);
#pragma unroll
    for (int t = 0; t < 8; ++t) o.ah[t] = ph[t * 64 + lane];
    const float* qt = RPQ + (cb * 2 + 1) * 4096 + (16 * vt + (lane & 15)) * 64 + 4 * (lane >> 4);
#pragma unroll
    for (int mt = 0; mt < 4; ++mt) o.qv[mt] = *(const f32x4*)(qt + 16 * mt);
}
__device__ __forceinline__ void rwB_step(f32x4 (&acc)[4], const RwBPre& c, float* so) {
#pragma unroll
    for (int mt = 0; mt < 4; ++mt) *(f32x4*)(so + 16 * mt) = acc[mt];
    bf16x8 bh[2], bl[2];
#pragma unroll
    for (int ks = 0; ks < 2; ++ks) { u32x4 wh, wl;
#pragma unroll
        for (int jp = 0; jp < 4; ++jp) { const float v0 = acc[2 * ks + (jp >> 1)][(2 * jp) & 3], v1 = acc[2 * ks + (jp >> 1)][((2 * jp) & 3) + 1];
            const unsigned hh = cvtpk_bf16(v0, v1); wh[jp] = hh;
            wl[jp] = cvtpk_bf16(v0 - __uint_as_float(hh << 16), v1 - __uint_as_float(hh & 0xffff0000u)); }
        bh[ks] = *reinterpret_cast<bf16x8*>(&wh); bl[ks] = *reinterpret_cast<bf16x8*>(&wl); }
#pragma unroll
    for (int mt = 0; mt < 4; ++mt) { f32x4 n = c.qv[mt];
#pragma unroll
        for (int ks = 0; ks < 2; ++ks) {
            n = __builtin_amdgcn_mfma_f32_16x16x32_bf16(c.ah[mt * 2 + ks], bh[ks], n, 0, 0, 0);
            n = __builtin_amdgcn_mfma_f32_16x16x32_bf16(c.ah[mt * 2 + ks], bl[ks], n, 0, 0, 0); }
        acc[mt] = n; }
}
__device__ void rwkv_passB_wave(const Params& p, int gwave) {
    const float* RPQ = (const float*)(p.ws + WS_RPQ); float* RS0 = (float*)(p.ws + WS_RS0);
    const int lane = tidx() & 63;
    const int stream = gwave >> 2, vt = gwave & 3, db = stream >> 2, h = stream & 3;
    f32x4 acc[4];
#pragma unroll
    for (int mt = 0; mt < 4; ++mt) acc[mt] = (f32x4){0.f, 0.f, 0.f, 0.f};
    const size_t cb0 = (size_t)db * 260 * 4 + h;
    float* so0 = RS0 + (16 * vt + (lane & 15)) * 64 + 4 * (lane >> 4);
    RwBPre c0, c1, c2;
    rwB_load(c0, RPQ, cb0 + 0, lane, vt); rwB_load(c1, RPQ, cb0 + 4, lane, vt);
#pragma unroll 1
    for (int q = 0; q < 260; q += 3) {
        rwB_load(c2, RPQ, cb0 + 4 * (size_t)(q + 2 < 260 ? q + 2 : 259), lane, vt);
        rwB_step(acc, c0, so0 + (cb0 + 4 * (size_t)q) * 4096);
        if (q + 1 < 260) {
            rwB_load(c0, RPQ, cb0 + 4 * (size_t)(q + 3 < 260 ? q + 3 : 259), lane, vt);
            rwB_step(acc, c1, so0 + (cb0 + 4 * (size_t)(q + 1)) * 4096);
            if (q + 2 < 260) {
                rwB_load(c1, RPQ, cb0 + 4 * (size_t)(q + 4 < 260 ? q + 4 : 259), lane, vt);
                rwB_step(acc, c2, so0 + (cb0 + 4 * (size_t)(q + 2)) * 4096);
            }
        }
    }
}

__device__ void rwkv_passC_unit(const Params& p, int L, int item) {
    const float* RS0 = (const float*)(p.ws + WS_RS0); const float* RY = (const float*)(p.ws + WS_RY);
    const bf16_t* RWPH = (const bf16_t*)(p.ws + WS_RWP); bf16_t* MIX = (bf16_t*)(p.ws + WS_MIX);
    const int lane = tidx() & 63, wid = wave_id(), h = wid & 3, sh = wid >> 2, fr = lane & 15, g = lane >> 4;
    const int b = item / 260, j = item % 260;
    const int row0 = rw_chunk_row0(0, b, j);
    const int qf = j, qb = j < 4 ? 3 - j : 263 - j;
    f32x4 acc[2][4];
#pragma unroll
    for (int d = 0; d < 2; ++d) {
        const size_t cs = ((size_t)(d * 2 + b) * 260 + (d ? qb : qf)) * 4 + h;
        const float* s0 = RS0 + cs * 4096 + fr * 64 + 8 * g;
        const float* rab = RY + (cs * 2 + 0) * 4096 + 8 * g;
        const float* y1b = RY + (cs * 2 + 1) * 4096 + fr * 64;
        bf16x8 bf[4][2];
#pragma unroll
        for (int nt = 0; nt < 4; ++nt)
#pragma unroll
            for (int ks = 0; ks < 2; ++ks) { const f32x4 a = *(const f32x4*)(s0 + nt * 1024 + 32 * ks), c = *(const f32x4*)(s0 + nt * 1024 + 32 * ks + 4);
                u32x4 w = {cvtpk_bf16(a[0], a[1]), cvtpk_bf16(a[2], a[3]), cvtpk_bf16(c[0], c[1]), cvtpk_bf16(c[2], c[3])}; bf[nt][ks] = *reinterpret_cast<bf16x8*>(&w); }
#pragma unroll
        for (int m2 = 0; m2 < 2; ++m2) {
            const int ro = 32 * sh + 16 * m2;
            const int ta = d ? 63 - (ro + fr) : ro + fr;
            bf16x8 af[2];
#pragma unroll
            for (int ks = 0; ks < 2; ++ks) { const f32x4 a = *(const f32x4*)(rab + ta * 64 + 32 * ks), c = *(const f32x4*)(rab + ta * 64 + 32 * ks + 4);
                u32x4 w = {cvtpk_bf16(a[0], a[1]), cvtpk_bf16(a[2], a[3]), cvtpk_bf16(c[0], c[1]), cvtpk_bf16(c[2], c[3])}; af[ks] = *reinterpret_cast<bf16x8*>(&w); }
#pragma unroll
            for (int nt = 0; nt < 4; ++nt) {
                f32x4 a_;
#pragma unroll
                for (int r = 0; r < 1; ++r) { const f32x4 yv = *(const f32x4*)(y1b + nt * 1024 + (d ? 60 - (ro + 4 * g) : ro + 4 * g));
                    if (d) { a_[0] = yv[3] + acc[m2][nt][0]; a_[1] = yv[2] + acc[m2][nt][1]; a_[2] = yv[1] + acc[m2][nt][2]; a_[3] = yv[0] + acc[m2][nt][3]; } else a_ = yv; }
                a_ = __builtin_amdgcn_mfma_f32_16x16x32_bf16(af[0], bf[nt][0], a_, 0, 0, 0);
                a_ = __builtin_amdgcn_mfma_f32_16x16x32_bf16(af[1], bf[nt][1], a_, 0, 0, 0);
                acc[m2][nt] = a_;
            }
        }
    }
    float lw_[4], lb_[4];
#pragma unroll
    for (int nt = 0; nt < 4; ++nt) { const int c = h * 64 + 16 * nt + fr; lw_[nt] = p.rwkv_ln_w[L * 256 + c]; lb_[nt] = p.rwkv_ln_b[L * 256 + c]; }
#pragma unroll
    for (int m2 = 0; m2 < 2; ++m2)
#pragma unroll
        for (int r = 0; r < 4; ++r) {
            const int row = row0 + 32 * sh + 16 * m2 + 4 * g + r;
            const float mu = row16_sum((acc[m2][0][r] + acc[m2][1][r]) + (acc[m2][2][r] + acc[m2][3][r])) * (1.f / 64.f);
            float dv[4], sq = 0.f;
#pragma unroll
            for (int nt = 0; nt < 4; ++nt) { dv[nt] = acc[m2][nt][r] - mu; sq += dv[nt] * dv[nt]; }
            const float rs = rsqrtf(row16_sum(sq) * (1.f / 64.f) + 64e-5f);
            const bf16_t* rw = RWPH + (size_t)row * 9 * 256 + h * 64 + fr;
            bf16_t* mo = MIX + (size_t)row * 1024 + 768 + h * 64 + fr;
#pragma unroll
            for (int nt = 0; nt < 4; ++nt) { const float yn = dv[nt] * rs * lw_[nt] + lb_[nt];
                mo[16 * nt] = f2bf((yn + bf2f(rw[3 * 256 + 16 * nt])) * bf2f(rw[4 * 256 + 16 * nt])); }
        }
}

constexpr int UT_TS = 72;
constexpr int UT_AT = 0, UT_RT = 9216, UT_BT = 18432, UT_KT = 27648, UT_BHT = 36864, UT_KHT = 46080, UT_VTT = 55296;
constexpr int UT_MAK = UT_AT, UT_NRB = UT_BT, UT_NRK = UT_KT;
constexpr int UT_RF = 64512, UT_MAB = UT_RF + 16384, UT_XT = UT_MAB + 16384, UT_XS = 68, UT_EC = UT_XT + 128 * UT_XS * 4, UT_GT = UT_EC + 256;
constexpr int UT_TD = UT_GT + 2048;
static_assert(UT_TD + 4096 <= LDS_MISC, "UT LDS map");
__device__ __forceinline__ bf16x8 ut_cvt8(const float* p) { const f32x4 a = *(const f32x4*)p, b = *(const f32x4*)(p + 4);
    u32x4 w = {cvtpk_bf16(a[0], a[1]), cvtpk_bf16(a[2], a[3]), cvtpk_bf16(b[0], b[1]), cvtpk_bf16(b[2], b[3])}; return *reinterpret_cast<bf16x8*>(&w); }

#ifndef UT_WR
#define UT_WR 15
#endif
__device__ void rwkv_ut_unit(const Params& p, int unit) {
    const bf16_t* RWPH = (const bf16_t*)(p.ws + WS_RWP); const float* RWPW = (const float*)(p.ws + WS_RWPW); float* RPQ = (float*)(p.ws + WS_RPQ); float* RY = (float*)(p.ws + WS_RY);
    const int d = unit / 520, b = (unit / 260) & 1, q = unit % 260;
    const int row0 = rw_chunk_row0(d, b, q);
    bf16_t* AT = (bf16_t*)(smem + UT_AT); bf16_t* RT = (bf16_t*)(smem + UT_RT); bf16_t* BT = (bf16_t*)(smem + UT_BT); bf16_t* KT = (bf16_t*)(smem + UT_KT);
    bf16_t* BHT = (bf16_t*)(smem + UT_BHT); bf16_t* KHT = (bf16_t*)(smem + UT_KHT); bf16_t* VTT = (bf16_t*)(smem + UT_VTT);
    bf16_t* MAK = (bf16_t*)(smem + UT_MAK); bf16_t* NRB = (bf16_t*)(smem + UT_NRB); bf16_t* NRK = (bf16_t*)(smem + UT_NRK);
    float* RF = (float*)(smem + UT_RF); float* MAB = (float*)(smem + UT_MAB); float* XT = (float*)(smem + UT_XT); float* EC = (float*)(smem + UT_EC); float* GT = (float*)(smem + UT_GT);
    float* TD = (float*)(smem + UT_TD);
    float lw[8]; unsigned short ukk[8], ubd[8], ukd[8], ur[8], uvv[8];
#define UT_LOAD0(hh) { const int tid_ = tidx(), k_ = tid_ & 63, tg_ = tid_ >> 6; const int kp_ = (hh) * 64 + ((k_ & 15) << 2) + (k_ >> 4); \
    _Pragma("unroll") for (int j = 0; j < 8; ++j) { const int t_ = tg_ * 8 + j, row_ = row0 + (d ? 63 - t_ : t_); \
        const bf16_t* rp = RWPH + (size_t)row_ * 9 * 256 + kp_; \
        lw[j] = RWPW[(size_t)row_ * 512 + d * 256 + kp_]; ukk[j] = rp[2 * 256]; ubd[j] = rp[(7 + d) * 256]; ukd[j] = rp[(5 + d) * 256]; ur[j] = rp[0]; \
        uvv[j] = RWPH[((size_t)row_ * 9 + 1) * 256 + (hh) * 64 + k_]; } }
    UT_LOAD0(0)
#pragma unroll 1
    for (int h = 0; h < 4; ++h) {
        const size_t cs = ((size_t)(d * 2 + b) * 260 + q) * 4 + h;
        __syncthreads();
        {
            const int tid = tidx(), k = tid & 63, tg = tid >> 6;
            float cum[8]; float run = 0.f;
#pragma unroll
            for (int j = 0; j < 8; ++j) { lw[j] = __logf(lw[j]); run += lw[j]; cum[j] = run; }
            GT[tg * 64 + k] = run;
            __syncthreads();
            float off = 0.f, tot = 0.f;
#pragma unroll
            for (int g2 = 0; g2 < 8; ++g2) { const float gv = GT[g2 * 64 + k]; tot += gv; if (g2 < tg) off += gv; }
            if (tg == 0) EC[k] = __expf(tot);
#pragma unroll
            for (int j = 0; j < 8; ++j) { const int t = tg * 8 + j;
                const float ct = off + cum[j], cm = ct - lw[j];
                const float e_t = __expf(ct), e_m = __expf(cm), e_i = __expf(-ct), e_c = __expf(tot - ct);
                const float vkk_ = bf2f(ukk[j]), vbd_ = bf2f(ubd[j]), vkd_ = bf2f(ukd[j]), vr_ = bf2f(ur[j]);
                const float at = -vkk_ * e_m, rt = vr_ * e_t;
                AT[t * UT_TS + k] = f2bf(at); RT[t * UT_TS + k] = f2bf(rt); RF[t * 64 + k] = rt; XT[k * UT_XS + t] = at;
                BT[t * UT_TS + k] = f2bf(vbd_ * e_i); KT[t * UT_TS + k] = f2bf(vkd_ * e_i);
                BHT[k * UT_TS + t] = f2bf(vbd_ * e_c); KHT[k * UT_TS + t] = f2bf(vkd_ * e_c);
                VTT[k * UT_TS + t] = uvv[j]; }
        }
        if (h < 3) UT_LOAD0(h + 1)
        __syncthreads();
        const int tid = tidx(), lane = tid & 63, w = tid >> 6, fr = lane & 15, g = lane >> 4;
        {
            const bf16_t* Asrc = (w < 4 ? AT : RT) + (16 * (w & 3) + fr) * UT_TS + 8 * g;
            const bf16x8 a0 = *(const bf16x8*)Asrc, a1 = *(const bf16x8*)(Asrc + 32);
            f32x4 acc[8];
#pragma unroll
            for (int nt = 0; nt < 8; ++nt) { const bf16_t* Bsrc = (nt < 4 ? BT : KT) + (16 * (nt & 3) + fr) * UT_TS + 8 * g;
                f32x4 c = {0.f, 0.f, 0.f, 0.f};
                c = __builtin_amdgcn_mfma_f32_16x16x32_bf16(a0, *(const bf16x8*)Bsrc, c, 0, 0, 0);
                c = __builtin_amdgcn_mfma_f32_16x16x32_bf16(a1, *(const bf16x8*)(Bsrc + 32), c, 0, 0, 0);
                acc[nt] = c; }
            __syncthreads();
#pragma unroll
            for (int nt = 0; nt < 8; ++nt)
#pragma unroll
                for (int r = 0; r < 4; ++r) { const int t = 16 * (w & 3) + 4 * g + r, i = 16 * (nt & 3) + fr;
                    if (w < 4) { const float v = i < t ? acc[nt][r] : 0.f;
                        if (nt < 4) MAB[t * 64 + i] = v; else MAK[t * UT_TS + i] = f2bf(v); }
                    else { const float v = i <= t ? acc[nt][r] : 0.f;
                        if (nt < 4) NRB[t * UT_TS + i] = f2bf(v); else NRK[t * UT_TS + i] = f2bf(v); } }
        }
        __syncthreads();
        {
            const int mt = w >> 1;
            const bf16_t* Asrc = MAK + (16 * mt + fr) * UT_TS + 8 * g;
            const bf16x8 a0 = *(const bf16x8*)Asrc, a1 = *(const bf16x8*)(Asrc + 32);
#pragma unroll
            for (int n2 = 0; n2 < 2; ++n2) { const int nt = 2 * (w & 1) + n2; const bf16_t* Bsrc = VTT + (16 * nt + fr) * UT_TS + 8 * g;
                f32x4 c = {0.f, 0.f, 0.f, 0.f};
                c = __builtin_amdgcn_mfma_f32_16x16x32_bf16(a0, *(const bf16x8*)Bsrc, c, 0, 0, 0);
                c = __builtin_amdgcn_mfma_f32_16x16x32_bf16(a1, *(const bf16x8*)(Bsrc + 32), c, 0, 0, 0);
                *(f32x4*)(XT + (64 + 16 * nt + fr) * UT_XS + 16 * mt + 4 * g) = c; }
            if (w == 0) {
                const float* mb = MAB + (16 * g) * 64 + 16 * g;
                float x[16];
#pragma unroll
                for (int t = 0; t < 16; ++t) { float s_ = (t == fr) ? 1.f : 0.f;
#pragma unroll
                    for (int i = 0; i < t; ++i) s_ = fmaf(mb[t * 64 + i], x[i], s_);
                    x[t] = s_; }
#pragma unroll
                for (int t = 0; t < 16; ++t) TD[(g * 16 + t) * 16 + fr] = x[t];
            }
        }
        __syncthreads();
        {
            const float* xr = XT + (16 * w + fr) * UT_XS + 4 * g;
            f32x4 X[4];
#pragma unroll
            for (int I = 0; I < 4; ++I) {
                f32x4 acc = *(const f32x4*)(xr + 16 * I);
#pragma unroll
                for (int J = 0; J < I; ++J) { const f32x4 m = *(const f32x4*)(MAB + (16 * I + fr) * 64 + 16 * J + 4 * g);
#pragma unroll
                    for (int mm = 0; mm < 4; ++mm) acc = __builtin_amdgcn_mfma_f32_16x16x4f32(m[mm], X[J][mm], acc, 0, 0, 0); }
                const f32x4 tq = *(const f32x4*)(TD + (I * 16 + fr) * 16 + 4 * g);
                f32x4 xi = {0.f, 0.f, 0.f, 0.f};
#pragma unroll
                for (int mm = 0; mm < 4; ++mm) xi = __builtin_amdgcn_mfma_f32_16x16x4f32(tq[mm], acc[mm], xi, 0, 0, 0);
                X[I] = xi;
            }
#pragma unroll
            for (int I = 0; I < 4; ++I) *(f32x4*)(XT + (16 * w + fr) * UT_XS + 16 * I + 4 * g) = X[I];
        }
        __syncthreads();
        {
            const int mt = w & 3, og = w >> 2;
            const bf16_t* Ah = BHT + (16 * mt + fr) * UT_TS + 8 * g; const bf16_t* Ak = KHT + (16 * mt + fr) * UT_TS + 8 * g;
            const bf16_t* An = NRB + (16 * mt + fr) * UT_TS + 8 * g; const bf16_t* Am = NRK + (16 * mt + fr) * UT_TS + 8 * g;
            const bf16x8 ah0 = *(const bf16x8*)Ah, ah1 = *(const bf16x8*)(Ah + 32), an0 = *(const bf16x8*)An, an1 = *(const bf16x8*)(An + 32);
            if (og == 0) {
                float* ra = RY + (cs * 2 + 0) * 4096;
#pragma unroll
                for (int nt = 0; nt < 4; ++nt) { const float* xb = XT + (16 * nt + fr) * UT_XS + 8 * g;
                    const bf16x8 b0 = ut_cvt8(xb), b1 = ut_cvt8(xb + 32);
                    f32x4 pc = {0.f, 0.f, 0.f, 0.f}, rc = {0.f, 0.f, 0.f, 0.f};
                    pc = __builtin_amdgcn_mfma_f32_16x16x32_bf16(ah0, b0, pc, 0, 0, 0); pc = __builtin_amdgcn_mfma_f32_16x16x32_bf16(ah1, b1, pc, 0, 0, 0);
                    rc = __builtin_amdgcn_mfma_f32_16x16x32_bf16(b0, an0, rc, 0, 0, 0); rc = __builtin_amdgcn_mfma_f32_16x16x32_bf16(b1, an1, rc, 0, 0, 0);
                    { const int o_ = (16 * mt + fr) * 64 + 16 * nt + 4 * g; const f32x4 rf = *(const f32x4*)(RF + o_);
                      f32x4 ov = {rc[0] + rf[0], rc[1] + rf[1], rc[2] + rf[2], rc[3] + rf[3]}; if (UT_WR & 4) *(f32x4*)(ra + o_) = ov; }
#pragma unroll
                    for (int r = 0; r < 4; ++r) { const int rr = 16 * mt + 4 * g + r, k = 16 * nt + fr;
                        const float pv = pc[r] + (rr == k ? EC[rr] : 0.f);
                        const int ks = k >> 5, rem = k & 31, jj = 4 * (rem >> 4) + (rem & 3), gg = (rem >> 2) & 3;
                        ((bf16_t*)MAB)[(((rr >> 4) * 2 + ks) * 64 + gg * 16 + (rr & 15)) * 8 + jj] = f2bf(pv);
                    } }
            } else {
                const bf16x8 ak0 = *(const bf16x8*)Ak, ak1 = *(const bf16x8*)(Ak + 32), am0 = *(const bf16x8*)Am, am1 = *(const bf16x8*)(Am + 32);
                float* qo = RPQ + (cs * 2 + 1) * 4096; float* y1 = RY + (cs * 2 + 1) * 4096;
#pragma unroll
                for (int nt = 0; nt < 4; ++nt) { const float* xb = XT + (64 + 16 * nt + fr) * UT_XS + 8 * g; const bf16_t* vb = VTT + (16 * nt + fr) * UT_TS + 8 * g;
                    const bf16x8 z0 = ut_cvt8(xb), z1 = ut_cvt8(xb + 32), v0 = *(const bf16x8*)vb, v1 = *(const bf16x8*)(vb + 32);
                    f32x4 qc = {0.f, 0.f, 0.f, 0.f}, yc = {0.f, 0.f, 0.f, 0.f};
                    qc = __builtin_amdgcn_mfma_f32_16x16x32_bf16(ah0, z0, qc, 0, 0, 0); qc = __builtin_amdgcn_mfma_f32_16x16x32_bf16(ah1, z1, qc, 0, 0, 0);
                    qc = __builtin_amdgcn_mfma_f32_16x16x32_bf16(ak0, v0, qc, 0, 0, 0); qc = __builtin_amdgcn_mfma_f32_16x16x32_bf16(ak1, v1, qc, 0, 0, 0);
                    yc = __builtin_amdgcn_mfma_f32_16x16x32_bf16(an0, z0, yc, 0, 0, 0); yc = __builtin_amdgcn_mfma_f32_16x16x32_bf16(an1, z1, yc, 0, 0, 0);
                    yc = __builtin_amdgcn_mfma_f32_16x16x32_bf16(am0, v0, yc, 0, 0, 0); yc = __builtin_amdgcn_mfma_f32_16x16x32_bf16(am1, v1, yc, 0, 0, 0);
#pragma unroll
                    for (int r = 0; r < 1; ++r) { const int o_ = (16 * nt + fr) * 64 + 16 * mt + 4 * g; if (UT_WR & 2) *(f32x4*)(qo + o_) = qc; if (UT_WR & 8) *(f32x4*)(y1 + o_) = yc; } }
            }
        }
        __syncthreads();
        if (UT_WR & 1) ((u32x4*)(RPQ + (cs * 2 + 0) * 4096))[tid] = ((const u32x4*)MAB)[tid];
    }
}
constexpr int RT_PAR = 0;
constexpr int RT_BS = 72, RT_BBUF = 2 * 80 * RT_BS * 2;
constexpr int RT_B = 36864, RT_LG = RT_B + 2 * RT_BBUF, RT_CNT = RT_LG + 8 * 16 * 80 * 4;
static_assert(RT_CNT + 512 <= LDS_MISC, "router LDS map");
struct RtTile { int row; float rs; const bf16_t* xr; const float* pw; const float* ps; };
__device__ __forceinline__ void rt_tile_init(RtTile& t, const bf16_t* X, const float* par, int tile, int fr, int g) {
    const int row0 = tile * 16, set = row_set(row0); t.row = row0 + fr;
    t.xr = X + (size_t)t.row * 1024 + 8 * g; t.pw = par + (set * 3 + 0) * 1024 + 8 * g; t.ps = par + (set * 3 + 1) * 1024 + 8 * g;
    float ss = 0.f;
#pragma unroll 8
    for (int ks = 0; ks < 32; ++ks) { const f32x4 a = ld4bf(t.xr + 32 * ks), b = ld4bf(t.xr + 32 * ks + 4);
        ss += a[0] * a[0] + a[1] * a[1] + a[2] * a[2] + a[3] * a[3] + b[0] * b[0] + b[1] * b[1] + b[2] * b[2] + b[3] * b[3]; }
    ss += __int_as_float(__builtin_amdgcn_ds_swizzle(__float_as_int(ss), 0x401F));
    { auto rr = __builtin_amdgcn_permlane32_swap(__float_as_uint(ss), __float_as_uint(ss), false, false); ss = __uint_as_float(rr[0]) + __uint_as_float(rr[1]); }
    t.rs = rsqrtf(ss * (1.f / 1024.f) + NORM_EPS);
}
struct RtX { u32x4 u[2]; };
__device__ __forceinline__ void rt_xload(RtX& o, const RtTile& t, int kc) {
#pragma unroll
    for (int s2 = 0; s2 < 2; ++s2) o.u[s2] = *(const u32x4*)(t.xr + 64 * kc + 32 * s2); }
__device__ __forceinline__ void rt_chunk(f32x4 (&acc)[5], const RtTile& t, const RtX& x, bf16_t* H, const bf16_t* Bc, int kc, int fr, int g) {
#pragma unroll
    for (int s2 = 0; s2 < 2; ++s2) { const int ks = 2 * kc + s2;
        const f32x4 w0 = *(const f32x4*)(t.pw + 32 * ks), w1 = *(const f32x4*)(t.pw + 32 * ks + 4), s0 = *(const f32x4*)(t.ps + 32 * ks), s1 = *(const f32x4*)(t.ps + 32 * ks + 4);
        float hv[8];
        { const u32x4 u = x.u[s2];
          const float xa[4] = {__uint_as_float(u[0] << 16), __uint_as_float(u[0] & 0xffff0000u), __uint_as_float(u[1] << 16), __uint_as_float(u[1] & 0xffff0000u)};
          const float xb[4] = {__uint_as_float(u[2] << 16), __uint_as_float(u[2] & 0xffff0000u), __uint_as_float(u[3] << 16), __uint_as_float(u[3] & 0xffff0000u)};
#pragma unroll
          for (int e = 0; e < 4; ++e) { hv[e] = fmaf(xa[e] * t.rs, w0[e], s0[e]); hv[4 + e] = fmaf(xb[e] * t.rs, w1[e], s1[e]); } }
        u32x4 hi, lo;
#pragma unroll
        for (int e = 0; e < 4; ++e) { const unsigned hh = cvtpk_bf16(hv[2 * e], hv[2 * e + 1]); hi[e] = hh;
            lo[e] = cvtpk_bf16(hv[2 * e] - __uint_as_float(hh << 16), hv[2 * e + 1] - __uint_as_float(hh & 0xffff0000u)); }
        *(u32x4*)(H + (size_t)t.row * 1024 + 32 * ks + 8 * g) = hi;
        const bf16x8 ah = *reinterpret_cast<bf16x8*>(&hi), al = *reinterpret_cast<bf16x8*>(&lo);
#pragma unroll
        for (int nt = 0; nt < 5; ++nt) {
            const bf16x8 wh = *(const bf16x8*)(Bc + (16 * nt + fr) * RT_BS + 32 * s2 + 8 * g), wl = *(const bf16x8*)(Bc + (80 + 16 * nt + fr) * RT_BS + 32 * s2 + 8 * g);
            acc[nt] = __builtin_amdgcn_mfma_f32_16x16x32_bf16(ah, wh, acc[nt], 0, 0, 0);
            acc[nt] = __builtin_amdgcn_mfma_f32_16x16x32_bf16(al, wh, acc[nt], 0, 0, 0);
            acc[nt] = __builtin_amdgcn_mfma_f32_16x16x32_bf16(ah, wl, acc[nt], 0, 0, 0); } }
}
__device__ __forceinline__ void rt_pick(const Params& p, int L, const f32x4 (&acc)[5], float* lg, int* lcnt, int row0, int lane, int fr, int g,
                                        int& ea, int& eb, int& pa, int& pb, int& trow) {
    int* EID = (int*)(p.ws + WS_EID); float* GATE = (float*)(p.ws + WS_GATE); const float* bias = (const float*)(smem + RT_PAR) + 2 * 1024;
#pragma unroll
    for (int nt = 0; nt < 5; ++nt)
#pragma unroll
        for (int r = 0; r < 4; ++r) lg[(4 * g + r) * 80 + 16 * nt + fr] = acc[nt][r];
    asm volatile("s_waitcnt lgkmcnt(0)" ::: "memory");
    if (lane < 16) {
        const float* l = lg + lane * 80; trow = row0 + lane;
        float gl[8]; int gi = 0; float gm = -3.0e38f;
#pragma unroll
        for (int j = 0; j < 8; ++j) { gl[j] = l[j] + bias[j]; if (gl[j] > gm) { gm = gl[j]; gi = j; } }
        float gs = 0.f;
#pragma unroll
        for (int j = 0; j < 8; ++j) gs += __expf(gl[j] - gm);
        const float pg = 1.f / gs;
        float e1 = -3.0e38f, e2 = -3.0e38f; int i1 = 0, i2 = 0;
        for (int j = 0; j < 8; ++j) { const float v = l[8 + gi * 8 + j] + bias[8 + gi * 8 + j];
            if (v > e1) { e2 = e1; i2 = i1; e1 = v; i1 = j; } else if (v > e2) { e2 = v; i2 = j; } }
        const float x2 = __expf(e2 - e1);
        const float g0 = pg / (1.f + x2), g1 = pg * x2 / (1.f + x2);
        ea = gi * 8 + i1; eb = gi * 8 + i2;
        EID[trow * 2] = ea; EID[trow * 2 + 1] = eb; GATE[trow * 2] = g0; GATE[trow * 2 + 1] = g1;
        pa = atomicAdd(&lcnt[ea], 1); pb = atomicAdd(&lcnt[eb], 1);
    }
    asm volatile("s_waitcnt lgkmcnt(0)" ::: "memory");
}
__device__ __forceinline__ void ph_norm2_router(const Params& p, int L) {
    unsigned char* ws = p.ws;
    const bf16_t* X = (const bf16_t*)(ws + WS_X); bf16_t* H = (bf16_t*)(ws + WS_H);
    const float* mods = (const float*)(ws + WS_MODS);
    const bf16_t* WRH = (const bf16_t*)(ws + WS_WRH) + (size_t)L * 2 * 80 * 1024; const bf16_t* WRL = WRH + 80 * 1024;
    int* POS = (int*)(ws + WS_POS); int* CNT = (int*)(ws + WS_MISC);
    const int tid = tidx(), lane = tid & 63, wid = tid >> 6, fr = lane & 15, g = lane >> 4;
    float* par = (float*)(smem + RT_PAR); float* lg = (float*)(smem + RT_LG) + wid * (16 * 80); int* lcnt = (int*)(smem + RT_CNT);
    bf16_t* Bs = (bf16_t*)(smem + RT_B);
    __syncthreads();
    for (int i = tid; i < 3 * 1024; i += NTHREADS) { const int set = i >> 10, c = i & 1023; const float* md = mods + (L * 3 + set) * 6144;
        par[(set * 3 + 0) * 1024 + c] = p.norm2_w[L * 1024 + c] * (1.f + md[4 * 1024 + c]); par[(set * 3 + 1) * 1024 + c] = md[3 * 1024 + c]; }
    if (tid < 72) par[2 * 1024 + tid] = tid < 8 ? p.moe_b_rg[L * 8 + tid] : p.moe_b_re[L * 64 + tid - 8];
    constexpr int NTILE = NTOK / 16;
    const int G = gridDim.x, tbase = NTILE / G, trem = NTILE % G, bx = bidx();
    const int t_lo = bx * tbase + (bx < trem ? bx : trem), t_hi = t_lo + tbase + (bx < trem ? 1 : 0);
    for (int t0 = t_lo; t0 < t_hi; t0 += 9) {
        const int tA = t0 + wid, tB = t0 + 8;
        const bool hasA = tA < t_hi && wid < 8, hasB = (wid == 0) && tB < t_hi;
        if (tid < 64) lcnt[tid] = 0;
        RtTile A, B;
        rt_tile_init(A, X, par, hasA ? tA : t0, fr, g);
        if (hasB) rt_tile_init(B, X, par, tB, fr, g); else B = A;
        f32x4 accA[5], accB[5];
#pragma unroll
        for (int nt = 0; nt < 5; ++nt) { accA[nt] = (f32x4){0.f, 0.f, 0.f, 0.f}; accB[nt] = (f32x4){0.f, 0.f, 0.f, 0.f}; }
        u32x4 st[3];
#pragma unroll
        for (int i = 0; i < 3; ++i) { const int idx = tid + 512 * i; if (idx < 1280) { const int part = idx / 640, rem = idx % 640, o = rem >> 3, c8 = rem & 7;
            st[i] = *(const u32x4*)((part ? WRL : WRH) + (size_t)o * 1024 + c8 * 8); } }
        RtX xa, xb, xan, xbn; rt_xload(xa, A, 0); if (hasB) rt_xload(xb, B, 0);
#pragma unroll 1
        for (int kc = 0; kc < 16; ++kc) {
            bf16_t* Bc = Bs + (kc & 1) * (RT_BBUF / 2);
#pragma unroll
            for (int i = 0; i < 3; ++i) { const int idx = tid + 512 * i; if (idx < 1280) { const int part = idx / 640, rem = idx % 640, o = rem >> 3, c8 = rem & 7;
                *(u32x4*)(Bc + (part * 80 + o) * RT_BS + c8 * 8) = st[i]; } }
            __syncthreads();
            const int kn = kc < 15 ? kc + 1 : 15;
#pragma unroll
            for (int i = 0; i < 3; ++i) { const int idx = tid + 512 * i; if (idx < 1280) { const int part = idx / 640, rem = idx % 640, o = rem >> 3, c8 = rem & 7;
                st[i] = *(const u32x4*)((part ? WRL : WRH) + (size_t)o * 1024 + kn * 64 + c8 * 8); } }
            rt_xload(xan, A, kn); if (hasB) rt_xload(xbn, B, kn);
            if (hasA) rt_chunk(accA, A, xa, H, Bc, kc, fr, g);
            if (hasB) rt_chunk(accB, B, xb, H, Bc, kc, fr, g);
            xa = xan; xb = xbn;
        }
        int eaA = 0, ebA = 0, paA = 0, pbA = 0, trA = 0, eaB = 0, ebB = 0, paB = 0, pbB = 0, trB = 0;
        if (hasA) rt_pick(p, L, accA, lg, lcnt, tA * 16, lane, fr, g, eaA, ebA, paA, pbA, trA);
        if (hasB) rt_pick(p, L, accB, lg, lcnt, tB * 16, lane, fr, g, eaB, ebB, paB, pbB, trB);
        __syncthreads();
        if (tid < 64) { const int c = lcnt[tid]; lcnt[64 + tid] = c > 0 ? atomicAdd(&CNT[tid * 16], c) : 0; }
        __syncthreads();
        if (hasA && lane < 16) { POS[trA * 2] = lcnt[64 + eaA] + paA; POS[trA * 2 + 1] = lcnt[64 + ebA] + pbA; }
        if (hasB && lane < 16) { POS[trB * 2] = lcnt[64 + eaB] + paB; POS[trB * 2 + 1] = lcnt[64 + ebB] + pbB; }
        __syncthreads();
    }
}

constexpr int MOE_TBL = 131072;
__device__ __forceinline__ void moe_table(const Params& p) {
    int* tb = (int*)(smem + MOE_TBL); const int* CNT = (const int*)(p.ws + WS_MISC);
    __syncthreads();
    if (tidx() < 64) {
        const int e = tidx(), cnt = CNT[e * 16], pd = (cnt + 255) / 256 * 256;
        const int incl = (int)wave_scan_incl((float)pd);
        tb[e] = incl - pd; tb[64 + e] = pd; tb[576 + e] = cnt; if (e == 63) tb[128] = incl / 256;
        for (int t = (incl - pd) >> 8; t < (incl >> 8); ++t) tb[192 + t] = e; }
    __syncthreads();
}
__device__ __forceinline__ void ph_slots(const Params& p) {
    unsigned char* ws = p.ws;
    const int* EID = (const int*)(ws + WS_EID); const int* POS = (const int*)(ws + WS_POS); int* SLOT = (int*)(ws + WS_SLOT);
    const bf16_t* H = (const bf16_t*)(ws + WS_H); bf16_t* HG = (bf16_t*)(ws + WS_HG);
    const int* CNT = (const int*)(ws + WS_MISC);
    moe_table(p);
    const int* tb = (const int*)(smem + MOE_TBL);
    const int lane = tidx() & 63, gw = bidx() * 8 + wave_id(), nw = gridDim.x * 8;
    for (int i0 = gw * 4; i0 < NTOK * 2; i0 += nw * 4) {
        int sl[4]; u32x4 a[4], b[4];
#pragma unroll
        for (int q = 0; q < 4; ++q) sl[q] = tb[EID[i0 + q]] + POS[i0 + q];
#pragma unroll
        for (int q = 0; q < 4; ++q) { const u32x4* src = (const u32x4*)(H + (size_t)((i0 + q) >> 1) * 1024); a[q] = src[lane]; b[q] = src[64 + lane]; }
#pragma unroll
        for (int q = 0; q < 4; ++q) { if (lane == 0) SLOT[i0 + q] = sl[q]; u32x4* dst = (u32x4*)(HG + (size_t)sl[q] * 1024); dst[lane] = a[q]; dst[64 + lane] = b[q]; }
    }
    for (int e = 0; e < 64; ++e) {
        const int c = tb[e] + tb[576 + e], n = tb[64 + e] - tb[576 + e];
        const unsigned z0 = (unsigned)tidx() >> 20;
        for (int r = gw; r < n; r += nw) { u32x4* dst = (u32x4*)(HG + (size_t)(c + r) * 1024); dst[lane] = (u32x4){z0, z0, z0, z0}; dst[64 + lane] = (u32x4){z0, z0, z0, z0}; }
    }
}
struct UnitsMoe1 { const bf16_t* W13; bf16_t* HM; const int* tb; int bid, nb, nunit;
    struct Info { size_t a; const bf16_t* b; bf16_t* o; };
    __device__ __forceinline__ bool get(int i, Info& u) const { const int t0 = bid + i * nb; if (t0 >= nunit) return false; const int t = xcd_remap(t0, nunit), rt = t >> 2, pn = t & 3; const int e = __builtin_amdgcn_readfirstlane(tb[192 + rt]);
        u.a = (size_t)rt * 256 * 1024; u.b = W13 + ((size_t)e * 1024 + pn * 256) * 1024; u.o = HM + (size_t)rt * 256 * 512 + pn * 128; return true; }
    __device__ __forceinline__ void epi(const f32x4 (&acc)[2][2][4][2], const Info& u, int wr, int wc, int fr, int fq) const { EpiSwiglu e{u.o}; e(acc, wr, wc, fr, fq); } };
__device__ __forceinline__ void ph_moe1(const Params& p) {
    unsigned char* ws = p.ws;
    moe_table(p);
    const int* tb = (const int*)(smem + MOE_TBL);
    UnitsMoe1 un{(const bf16_t*)(ws + WS_W13), (bf16_t*)(ws + WS_HMID), tb, bidx(), (int)gridDim.x, tb[128] * 4};
    gemm_stream<1024, 1024, 1024>((const bf16_t*)(ws + WS_HG), un);
}
struct UnitsMoe2 { const bf16_t* W2; bf16_t* YE; const int* tb; int bid, nb, nunit;
    struct Info { size_t a; const bf16_t* b; bf16_t* o; };
    __device__ __forceinline__ bool get(int i, Info& u) const { const int t0 = bid + i * nb; if (t0 >= nunit) return false; const int t = xcd_remap(t0, nunit), rt = t >> 2, pn = t & 3; const int e = __builtin_amdgcn_readfirstlane(tb[192 + rt]);
        u.a = (size_t)rt * 256 * 512; u.b = W2 + ((size_t)e * 1024 + pn * 256) * 512; u.o = YE + (size_t)rt * 256 * 1024 + pn * 256; return true; }
    __device__ __forceinline__ void epi(const f32x4 (&acc)[2][2][4][2], const Info& u, int wr, int wc, int fr, int fq) const { EpiBf16Store e{u.o, 1024}; e(acc, wr, wc, fr, fq); } };
__device__ __forceinline__ void ph_moe2(const Params& p) {
    unsigned char* ws = p.ws;
    moe_table(p);
    const int* tb = (const int*)(smem + MOE_TBL);
    UnitsMoe2 un{(const bf16_t*)(ws + WS_W2), (bf16_t*)(ws + WS_YEXP), tb, bidx(), (int)gridDim.x, tb[128] * 4};
    gemm_stream<512, 512, 512>((const bf16_t*)(ws + WS_HMID), un);
}

__device__ __forceinline__ void ph_final(const Params& p) {
    unsigned char* ws = p.ws;
    const bf16_t* X = (const bf16_t*)(ws + WS_X); const float* mods = (const float*)(ws + WS_MODS);
    const int* SLOT = (const int*)(ws + WS_SLOT); const float* GATE = (const float*)(ws + WS_GATE); const bf16_t* YE = (const bf16_t*)(ws + WS_YEXP);
    const int lane = tidx() & 63, gw = bidx() * 8 + wave_id(), nw = gridDim.x * 8;
    float* par = (float*)smem;
    __syncthreads();
    for (int i = tidx(); i < 3 * 1024; i += NTHREADS) { const int k = i >> 10, c = i & 1023; par[i] = k < 2 ? mods[(3 * 3 + k) * 6144 + 5 * 1024 + c] : p.final_norm_w[c]; }
    __syncthreads();
    int s0n = 0, s1n = 0; float gan = 0.f, gbn = 0.f;
    if (gw < NLAT) { s0n = SLOT[gw * 2]; s1n = SLOT[gw * 2 + 1]; gan = GATE[gw * 2]; gbn = GATE[gw * 2 + 1]; }
    for (int row = gw; row < NLAT; row += nw) {
        const int set = row_set(row);
        const float* g2 = par + set * 1024;
        const int s0 = s0n, s1 = s1n; const float ga = gan, gb = gbn;
        { const int rn = row + nw; if (rn < NLAT) { s0n = SLOT[rn * 2]; s1n = SLOT[rn * 2 + 1]; gan = GATE[rn * 2]; gbn = GATE[rn * 2 + 1]; } }
        f32x4 v[4]; float ss = 0.f;
#pragma unroll
        for (int i = 0; i < 4; ++i) { const int col = i * 256 + lane * 4;
            v[i] = ld4bf(X + (size_t)row * 1024 + col);
            const u32x2 ya = *(const u32x2*)(YE + (size_t)s0 * 1024 + col), yb = *(const u32x2*)(YE + (size_t)s1 * 1024 + col);
            const f32x4 gg = *(const f32x4*)(g2 + col);
            v[i][0] += gg[0] * (ga * __uint_as_float(ya[0] << 16) + gb * __uint_as_float(yb[0] << 16));
            v[i][1] += gg[1] * (ga * __uint_as_float(ya[0] & 0xffff0000u) + gb * __uint_as_float(yb[0] & 0xffff0000u));
            v[i][2] += gg[2] * (ga * __uint_as_float(ya[1] << 16) + gb * __uint_as_float(yb[1] << 16));
            v[i][3] += gg[3] * (ga * __uint_as_float(ya[1] & 0xffff0000u) + gb * __uint_as_float(yb[1] & 0xffff0000u));
            ss += v[i][0] * v[i][0] + v[i][1] * v[i][1] + v[i][2] * v[i][2] + v[i][3] * v[i][3]; }
        ss = wave_sum(ss);
        const float rs = rsqrtf(ss * (1.f / 1024.f) + NORM_EPS);
#pragma unroll
        for (int i = 0; i < 4; ++i) { const int col = i * 256 + lane * 4; const f32x4 w = *(const f32x4*)(par + 2048 + col);
            f32x4 o; o[0] = v[i][0] * rs * w[0]; o[1] = v[i][1] * rs * w[1]; o[2] = v[i][2] * rs * w[2]; o[3] = v[i][3] * rs * w[3];
            *(f32x4*)(p.out + (size_t)row * 1024 + col) = o; }
    }
}
struct WQ { unsigned* ctr; int pend; };
__device__ __forceinline__ void wq_init(WQ& q, unsigned* ctr) { q.ctr = ctr; q.pend = 0; if (tidx() == 0) q.pend = (int)__hip_atomic_fetch_add(ctr, 1u, __ATOMIC_RELAXED, __HIP_MEMORY_SCOPE_AGENT); }
__device__ __forceinline__ int wq_next(WQ& q) {
    volatile LAS int* slot = (volatile LAS int*)(LAS unsigned char*)(smem + LDS_MISC + 32);
    __syncthreads();
    if (tidx() == 0) { *slot = q.pend; q.pend = (int)__hip_atomic_fetch_add(q.ctr, 1u, __ATOMIC_RELAXED, __HIP_MEMORY_SCOPE_AGENT); }
    __syncthreads();
    return __builtin_amdgcn_readfirstlane(*slot);
}
__device__ __forceinline__ unsigned* wq_ctr(const Params& p, int L, int k) { return (unsigned*)(p.ws + WS_MISC) + 1024 + L * 16 + k; }

__device__ __forceinline__ void ph_mixA(const Params& p, int L) {
    unsigned char* ws = p.ws;
    const bf16_t* U = (const bf16_t*)(ws + WS_U); const bf16_t* W = (const bf16_t*)(ws + WS_WUP) + (size_t)L * UPW * UPK; bf16_t* QU = (bf16_t*)(ws + WS_QKVUP);
    constexpr int NS = SSD_UNITS, NR = RW_UNITS_PREP, NG = 130 * 6;
    WQ wq; wq_init(wq, wq_ctr(p, L, 0));
    int u = wq_next(wq);
    for (; u < NS; u = wq_next(wq)) QREP(1) { QSYNC ssd_pass1_unit(p, L, u); }
    for (; u < NS + NR; u = wq_next(wq)) QREP(2) { QSYNC rwkv_prep_unit(p, L, u - NS); }
    for (; u < NS + NR + NG; u = wq_next(wq)) QREP(3) { const int v = u - NS - NR, pm = v / 6, pn = v % 6; QSYNC
        ARowLin<UW> ar{(size_t)pm * 256 * UW + U_QD};
        EpiBf16Store ep{QU + (size_t)pm * 256 * UPW + pn * 256, UPW};
        gemm256<UPK, UPK>(U, ar, W + (size_t)pn * 256 * UPK, ep);
    }
}
__device__ __forceinline__ void ph_mixB(const Params& p, int L) {
    constexpr int NA = RW_UNITS, NM = NTOK / 32, NSC = (2 * 2 * 6 * 128 * 64) / NTHREADS;
    WQ wq; wq_init(wq, wq_ctr(p, L, 1));
    int u = wq_next(wq);
#if RW_UT
    for (; u < NA; u = wq_next(wq)) QREP(4) rwkv_ut_unit(p, u);
#else
    for (; u < NA; u = wq_next(wq)) rwkv_passA_unit(p, u);
#endif
    for (; u < NA + NM; u = wq_next(wq)) ph_mla_prep_rows(p, (u - NA) * 32, (u - NA) * 32 + 32, wave_id(), 8);
    for (; u < NA + NM + NSC; u = wq_next(wq)) ssd_scan_range(p, (u - NA - NM) * NTHREADS + tidx(), 0x40000000);
}
__device__ __forceinline__ void ph_mixD(const Params& p, int L) {
    unsigned char* ws = p.ws;
    const bf16_t* Q = (const bf16_t*)(ws + WS_Q); const bf16_t* Kb = (const bf16_t*)(ws + WS_K); const bf16_t* Vb = (const bf16_t*)(ws + WS_V); bf16_t* MIX = (bf16_t*)(ws + WS_MIX);
    unsigned* flag = (unsigned*)(ws + WS_MISC) + 1200 + L;
    if (bidx() < 64 && wave_id() == 0) {
        rwkv_passB_wave(p, bidx());
        asm volatile("s_waitcnt vmcnt(0)" ::: "memory");
        __builtin_amdgcn_fence(__ATOMIC_RELEASE, "agent");
        asm volatile("s_waitcnt vmcnt(0)" ::: "memory");
        if ((tidx() & 63) == 0) __hip_atomic_fetch_add(flag, 1u, __ATOMIC_RELAXED, __HIP_MEMORY_SCOPE_AGENT);
    }
    constexpr int NS = SSD_UNITS, NA = 768, NC = 12, NR = RW_UNITS / 2;
    WQ wq; wq_init(wq, wq_ctr(p, L, 3));
    int u = wq_next(wq);
    for (; u < NS; u = wq_next(wq)) QREP(7) { QSYNC ssd_pass3_unit(p, L, u); }
#ifdef PROBE_ATT
    for (int rep = 0; rep <= PROBE_ATT; ++rep) { const int samet = (rep < PROBE_ATT) && PROBE_ATT_SAME;
      for (int a = bidx(); a < NA + NC; a += gridDim.x) {
        int b, h, row0, seq;
        if (a < NA) { b = a / 384; h = (a / 64) % 6; row0 = b * SEQ + (a % 64) * 256; seq = KEYS; }
        else { const int c = a - NA; b = c / 6; h = c % 6; row0 = NLAT + b * CTXL; seq = CTXL; }
        __syncthreads();
        att::attn_body(Q + (size_t)row0 * 576 + h * 96, Kb + (size_t)(b * 6 + h) * KEYS * 96, Vb + (size_t)(b * 6 + h) * KEYS * 64,
                       MIX + (size_t)row0 * 1024 + 384 + h * 64, seq, (char*)smem, samet); } }
    u += NA + NC;
#define wq_next(c) (wq_next(c) + NA + NC)
#else
    for (; u < NS + NA + NC; u = wq_next(wq)) { const int a = u - NS;
        int b, h, row0, seq;
        if (a < NA) { b = a / 384; h = (a / 64) % 6; row0 = b * SEQ + (a % 64) * 256; seq = KEYS; }
        else { const int c = a - NA; b = c / 6; h = c % 6; row0 = NLAT + b * CTXL; seq = CTXL; }
        att::attn_body(Q + (size_t)row0 * 576 + h * 96, Kb + (size_t)(b * 6 + h) * KEYS * 96, Vb + (size_t)(b * 6 + h) * KEYS * 64,
                       MIX + (size_t)row0 * 1024 + 384 + h * 64, seq, (char*)smem);
    }
#endif
    if (u < NS + NA + NC + NR) {
        if (tidx() == 0) { unsigned sp = 0;
            while (__hip_atomic_load(flag, __ATOMIC_RELAXED, __HIP_MEMORY_SCOPE_AGENT) < 64u) { __builtin_amdgcn_s_sleep(2); if (++sp > (1u << 22)) break; }
            __builtin_amdgcn_fence(__ATOMIC_ACQUIRE, "agent");
            asm volatile("s_waitcnt vmcnt(0)" ::: "memory"); }
        __syncthreads();
    }
    for (; u < NS + NA + NC + NR; u = wq_next(wq)) rwkv_passC_unit(p, L, u - NS - NA - NC);
#ifdef PROBE_ATT
#undef wq_next
#endif
}

__device__ __forceinline__ void ph_moe_convert(const Params& p, int L) {
    constexpr int G = 4, NI = (MOE_CV_N13 + MOE_CV_N2) / G;
    WQ wq; wq_init(wq, wq_ctr(p, L, 4));
    for (int it = wq_next(wq); it < NI; it = wq_next(wq))
#pragma unroll 1
        for (int u = it * G; u < it * G + G; ++u) moe_convert_tile(p, L, u);
}
constexpr int PH_PER_LAYER = 10, PH_TOTAL = 2 + 4 * PH_PER_LAYER;
typedef const __attribute__((address_space(4))) Params* KParams;
__device__ __forceinline__ KParams kp_launder() { KParams q = (KParams)__builtin_amdgcn_kernarg_segment_ptr(); asm volatile("" : "+s"(q)); return q; }
#ifndef PROBE_REP_PH
#define PROBE_REP_PH (-1)
#define PROBE_REP_N 1
#endif
#define PHASE(k, call) do { if (lo <= (k) && (k) < hi) { const int nrep_ = (PROBE_REP_PH >= 0 && (k) >= 1 && ((k) - 1) % PH_PER_LAYER == PROBE_REP_PH && (k) < PH_TOTAL - 1) ? PROBE_REP_N : 1; \
    for (int rep_ = 0; rep_ < nrep_; ++rep_) { { const Params p = *(const Params*)kp_launder(); call; } if ((k) + 1 < hi) xcd_barrier(bar); \
        if (nrep_ > 1) { if (bidx() == 0 && tidx() < 64) ((unsigned*)(p_.ws + WS_MISC))[1024 + tidx()] = 0u; xcd_barrier(bar); } } } } while (0)
__global__ void __launch_bounds__(NTHREADS, 2) mega(Params p_) {
    volatile LAS unsigned* st = (volatile LAS unsigned*)(LAS unsigned char*)(smem + LDS_MISC);
    if (threadIdx.x < 4) st[threadIdx.x] = 0u;
    __syncthreads();
    const int lo = (int)p_.ph_lo, hi = (int)p_.ph_hi;
    XcdBarrier bar; bar.bar = (unsigned*)(p_.ws + WS_BAR); bar.x = 0; bar.st = st;
    if (hi - lo > 1) bar = xcd_barrier_post((unsigned*)(p_.ws + WS_BAR), st);
    PHASE(0, ph_prologue(p));
#ifdef PROBE_DUP
#define DUP(k, idx, call) do { if ((idx) == PROBE_DUP) { xcd_barrier(bar); if (bidx() == 0 && tidx() < 64) ((unsigned*)(p_.ws + WS_MISC))[1024 + tidx()] = 0u; xcd_barrier(bar); { const Params p = *(const Params*)kp_launder(); call; } xcd_barrier(bar); } } while (0)
#else
#define DUP(k, idx, call) do { } while (0)
#endif
    for (int L = 0; L < DEPTH; ++L) {
        const int pb = 1 + PH_PER_LAYER * L;
        PHASE(pb + 0, ph_norm1(p, L));
        PHASE(pb + 1, ph_gemm_in(p, L)); DUP(pb + 1, 1, ph_gemm_in(p, L));
        PHASE(pb + 2, ph_mixA(p, L)); DUP(pb + 2, 2, ph_mixA(p, L));
        PHASE(pb + 3, ph_mixB(p, L)); DUP(pb + 3, 3, ph_mixB(p, L));
        PHASE(pb + 4, ph_mixD(p, L)); DUP(pb + 4, 4, ph_mixD(p, L));
        PHASE(pb + 5, (ph_gemm_out(p, L), ph_moe_convert(p, L)));
        PHASE(pb + 6, ph_norm2_router(p, L));
        PHASE(pb + 7, ph_slots(p)); DUP(pb + 7, 8, ph_slots(p));
        PHASE(pb + 8, ph_moe1(p)); DUP(pb + 8, 9, ph_moe1(p));
        PHASE(pb + 9, ph_moe2(p)); DUP(pb + 9, 10, ph_moe2(p));
    }
    PHASE(PH_TOTAL - 1, ph_final(p));
#ifdef PROBE_PH
    for (int r = 0; r < PROBE_N; ++r) { xcd_barrier(bar); if (bidx() == 0 && tidx() < 64) ((unsigned*)(p_.ws + WS_MISC))[1024 + tidx()] = 0u; xcd_barrier(bar); const Params p = *(const Params*)kp_launder(); const int L = 3;
        if (PROBE_PH == 0) ph_norm1(p, L); if (PROBE_PH == 1) ph_gemm_in(p, L); if (PROBE_PH == 2) ph_mixA(p, L); if (PROBE_PH == 3) ph_mixB(p, L);
        if (PROBE_PH == 5) ph_mixD(p, L); if (PROBE_PH == 7) ph_gemm_out(p, L);
        if (PROBE_PH == 8) ph_norm2_router(p, L); if (PROBE_PH == 9) ph_slots(p); if (PROBE_PH == 10) ph_moe1(p); if (PROBE_PH == 11) ph_moe2(p);
        if (PROBE_PH == 12) ph_moe_convert(p, L); if (PROBE_PH == 13) ph_prologue(p);
        if (PROBE_PH == 14) { for (int u = bidx(); u < SSD_UNITS; u += gridDim.x) { __syncthreads(); ssd_pass1_unit(p, L, u); } }
        if (PROBE_PH == 15) { for (int u = bidx(); u < RW_UNITS_PREP; u += gridDim.x) { __syncthreads(); rwkv_prep_unit(p, L, u); } }
        if (PROBE_PH == 16) { for (int u = bidx(); u < SSD_UNITS; u += gridDim.x) { __syncthreads(); ssd_pass3_unit(p, L, u); } }
        if (PROBE_PH == 17) { for (int u = bidx(); u < RW_UNITS / 2; u += gridDim.x) { __syncthreads(); rwkv_passC_unit(p, L, u); } }
        if (PROBE_PH == 18) { ph_mla_prep_rows(p, 0, NTOK, bidx() * 8 + wave_id(), gridDim.x * 8); }
        if (PROBE_PH == 19) { ssd_scan_range(p, bidx() * NTHREADS + tidx(), gridDim.x * NTHREADS); }
        if (PROBE_PH == 20) { for (int u = bidx(); u < RW_UNITS; u += gridDim.x) { __syncthreads(); rwkv_ut_unit(p, u); } } }
#endif
}

extern "C" void kernel_launch(void* const* d_in, const int* in_sizes, int n_in, void* d_out, int out_size, void* d_ws, size_t ws_size, hipStream_t stream) {
    static int grid = 0;
    if (grid == 0) {
        if (n_in != 39 || in_sizes[0] != NLAT * DM || out_size != NLAT * DM || ws_size < WS_END) {
            fprintf(stderr, "kernel_launch: shape mismatch: n_in %d in0 %d out %d ws %zu (need %zu)\n", n_in, n_in > 0 ? in_sizes[0] : -1, out_size, ws_size, (size_t)WS_END); grid = -1; return; }
        int dev = 0, cus = 0, per_cu = 0;
        if (hipGetDevice(&dev) != hipSuccess || hipDeviceGetAttribute(&cus, hipDeviceAttributeMultiprocessorCount, dev) != hipSuccess) { fprintf(stderr, "kernel_launch: device query failed\n"); grid = -1; return; }
        if (hipFuncSetAttribute((const void*)mega, hipFuncAttributeMaxDynamicSharedMemorySize, LDS_BYTES) != hipSuccess) { fprintf(stderr, "kernel_launch: hipFuncSetAttribute failed\n"); grid = -1; return; }
        if (hipOccupancyMaxActiveBlocksPerMultiprocessor(&per_cu, (const void*)mega, NTHREADS, LDS_BYTES) != hipSuccess || per_cu < 1)
            fprintf(stderr, "kernel_launch: occupancy query reports %d workgroups per CU\n", per_cu);
        (void)hipGetLastError();
        grid = cus;
    }
    if (grid < 0) return;
    if (hipMemsetAsync((char*)d_ws + WS_BAR, 0, 32768, stream) != hipSuccess) { fprintf(stderr, "kernel_launch: memset failed\n"); return; }
    Params p{};
    { const float** pp = (const float**)&p; for (int i = 0; i < 39; ++i) pp[i] = (const float*)d_in[i]; }
    p.out = (float*)d_out; p.ws = (unsigned char*)d_ws;
#if MK_MULTI
    for (int k = 0; k < PH_TOTAL; ++k) {
        p.ph_lo = k; p.ph_hi = k + 1;
        hipLaunchKernelGGL(mega, dim3(grid), dim3(NTHREADS), LDS_BYTES, stream, p);
    }
#else
    p.ph_lo = 0; p.ph_hi = PH_TOTAL;
    hipLaunchKernelGGL(mega, dim3(grid), dim3(NTHREADS), LDS_BYTES, stream, p);
#endif
    const hipError_t le = hipPeekAtLastError();
    if (le != hipSuccess) fprintf(stderr, "kernel_launch: launch failed: %s\n", hipGetErrorName(le));
}
```

```cpp
#include <hip/hip_runtime.h>
#include <cstdio>
#include <cstdint>

#ifndef RW_UT
#define RW_UT 1
#endif
#ifndef MK_MULTI
#define MK_MULTI 0
#endif

typedef unsigned short bf16_t;
typedef short bf16x8 __attribute__((ext_vector_type(8)));
typedef short s16x4 __attribute__((ext_vector_type(4)));
typedef float f32x4 __attribute__((ext_vector_type(4)));
typedef float f32x16 __attribute__((ext_vector_type(16)));
typedef unsigned u32x4 __attribute__((ext_vector_type(4)));
typedef unsigned u32x2 __attribute__((ext_vector_type(2)));

constexpr int DM = 1024, NBATCH = 2, SEQ = 16384, DEPTH = 4, CTXL = 256;
constexpr int NLAT = NBATCH * SEQ;
constexpr int NCTX = NBATCH * CTXL;
constexpr int NTOK = NLAT + NCTX;
constexpr int KEYS = CTXL + SEQ;
constexpr int IN_W = 2796;
constexpr int UW = 2816;
constexpr int U_Z = 0, U_XBC = 384, U_QD = 1280, U_KVD = 1472, U_KR = 1600, U_DT = 1632, U_RW = 1664;
constexpr int UPW = 1536;
constexpr int UPK = 384;
constexpr int NTHREADS = 512;
constexpr int LDS_BYTES = 147456;
constexpr int LDS_MISC = LDS_BYTES - 256;
constexpr float NORM_EPS = 1e-6f;

constexpr size_t al256(size_t x) { return (x + 255) / 256 * 256; }
constexpr size_t WS_BAR   = 0;
constexpr size_t WS_MISC  = 16384;
constexpr size_t WS_MODS  = 32768;
constexpr size_t WS_WRT   = WS_MODS + al256((size_t)4 * 3 * 6144 * 4);
constexpr size_t WS_WRH   = WS_WRT + al256((size_t)4 * 72 * 1024 * 4);
constexpr size_t WS_WIN   = WS_WRH + (size_t)4 * 2 * 80 * 1024 * 2;
constexpr size_t WS_WOUT  = WS_WIN + (size_t)4 * UW * 1024 * 2;
constexpr size_t WS_WUP   = WS_WOUT + (size_t)4 * 1024 * 1024 * 2;
constexpr size_t WS_WLORA = WS_WUP + (size_t)4 * UPW * UPK * 2;
constexpr size_t WS_W13   = WS_WLORA + (size_t)4 * 98304 * 2;
constexpr size_t WS_W2    = WS_W13 + (size_t)64 * 1024 * 1024 * 2;
constexpr size_t WS_X     = WS_W2 + (size_t)64 * 1024 * 512 * 2;
constexpr size_t WS_H     = WS_X + (size_t)NTOK * 1024 * 4;
constexpr size_t WS_U     = WS_H + (size_t)NTOK * 1024 * 2;
constexpr size_t WS_MIX   = WS_U + (size_t)NTOK * UW * 2;
constexpr size_t WS_R0    = WS_MIX + (size_t)NTOK * 1024 * 2;
constexpr size_t WS_QKVUP = WS_R0;
constexpr size_t WS_Q     = WS_QKVUP + (size_t)NTOK * UPW * 2;
constexpr size_t WS_K     = WS_Q + (size_t)NTOK * 576 * 2;
constexpr size_t WS_V     = WS_K + (size_t)2 * 6 * KEYS * 96 * 2;
constexpr size_t WS_SST   = WS_V + (size_t)2 * 6 * KEYS * 64 * 2;
constexpr size_t WS_SDEC  = WS_SST + (size_t)2 * 2 * 130 * 6 * 128 * 64 * 4;
constexpr size_t WS_YS    = WS_SDEC + al256((size_t)2 * 2 * 130 * 8 * 4);
constexpr size_t WS_RWP   = WS_YS + (size_t)2 * NTOK * 384 * 4;
constexpr size_t WS_RPQ   = WS_RWP + (size_t)NTOK * 11 * 256 * 4;
constexpr size_t WS_RS0   = WS_RPQ + (size_t)2 * 2 * 260 * 4 * 2 * 4096 * 4;
constexpr size_t WS_YR    = WS_RS0 + (size_t)2 * 2 * 260 * 4 * 4096 * 4;
constexpr size_t WS_RY    = WS_YR + (size_t)2 * NTOK * 256 * 4;
constexpr size_t WS_SSTB  = WS_RY + (size_t)2 * 2 * 260 * 4 * 2 * 4096 * 4;
constexpr size_t WS_MIXEND= WS_SSTB + (size_t)2 * 2 * 130 * 6 * 64 * 128 * 2;
constexpr int MOE_MAXROWS = 83200;
constexpr size_t WS_EID   = WS_R0;
constexpr size_t WS_POS   = WS_EID + al256((size_t)NTOK * 2 * 4);
constexpr size_t WS_GATE  = WS_POS + al256((size_t)NTOK * 2 * 4);
constexpr size_t WS_SLOT  = WS_GATE + al256((size_t)NTOK * 2 * 4);
constexpr size_t WS_HG    = WS_SLOT + al256((size_t)NTOK * 2 * 4);
constexpr size_t WS_HMID  = WS_HG + (size_t)MOE_MAXROWS * 1024 * 2;
constexpr size_t WS_YEXP  = WS_HMID + (size_t)MOE_MAXROWS * 512 * 2;
constexpr size_t WS_MOEEND= WS_YEXP + (size_t)MOE_MAXROWS * 1024 * 2;
constexpr size_t WS_END   = WS_MIXEND > WS_MOEEND ? WS_MIXEND : WS_MOEEND;

struct Params {
    const float *x, *c, *ctx, *c_ctx, *mod_w, *mod_b, *norm1_w, *norm2_w, *w_in, *ssd_conv_w, *ssd_conv_b, *ssd_dt_bias,
        *ssd_a_log, *ssd_d, *ssd_norm_w, *mla_q_norm_w, *mla_w_uq, *mla_kv_norm_w, *mla_w_ukv, *rwkv_shift_w,
        *rwkv_w0, *rwkv_w2, *rwkv_a0, *rwkv_a2, *rwkv_g2, *rwkv_k_k, *rwkv_k_a, *rwkv_r_k, *rwkv_ln_w, *rwkv_ln_b,
        *w_out, *moe_w_rg, *moe_b_rg, *moe_w_re, *moe_b_re, *moe_w1, *moe_w3, *moe_w2, *final_norm_w;
    float* out;
    unsigned char* ws;
    long long ph_lo, ph_hi;
};

#define LAS __attribute__((address_space(3)))
extern __shared__ __attribute__((aligned(16))) unsigned char smem[];

__device__ __forceinline__ float bf2f(bf16_t v) { return __uint_as_float(((unsigned)v) << 16); }
__device__ __forceinline__ bf16_t f2bf(float f) { unsigned u = __float_as_uint(f); u += 0x7fffu + ((u >> 16) & 1u); return (bf16_t)(u >> 16); }
__device__ __forceinline__ unsigned cvtpk_bf16(float lo, float hi) { unsigned r; asm volatile("v_cvt_pk_bf16_f32 %0, %1, %2" : "=v"(r) : "v"(lo), "v"(hi)); return r; }
__device__ __forceinline__ f32x4 ld4bf(const bf16_t* p) { const u32x2 u = *(const u32x2*)p; f32x4 v = {__uint_as_float(u[0] << 16), __uint_as_float(u[0] & 0xffff0000u), __uint_as_float(u[1] << 16), __uint_as_float(u[1] & 0xffff0000u)}; return v; }
__device__ __forceinline__ void st4bf(bf16_t* p, const f32x4& v) { u32x2 o = {cvtpk_bf16(v[0], v[1]), cvtpk_bf16(v[2], v[3])}; *(u32x2*)p = o; }
__device__ __forceinline__ unsigned pack2bf(float lo, float hi) { return (unsigned)f2bf(lo) | ((unsigned)f2bf(hi) << 16); }
__device__ __forceinline__ float dpp_add(float v, const int ctrl_sel) {
    int r;
    if (ctrl_sel == 0) r = __builtin_amdgcn_update_dpp(0, __float_as_int(v), 0xB1, 0xF, 0xF, true);
    else if (ctrl_sel == 1) r = __builtin_amdgcn_update_dpp(0, __float_as_int(v), 0x4E, 0xF, 0xF, true);
    else if (ctrl_sel == 2) r = __builtin_amdgcn_update_dpp(0, __float_as_int(v), 0x141, 0xF, 0xF, true);
    else r = __builtin_amdgcn_update_dpp(0, __float_as_int(v), 0x140, 0xF, 0xF, true);
    return v + __int_as_float(r);
}
__device__ __forceinline__ float row16_sum(float v) { v = dpp_add(v, 0); v = dpp_add(v, 1); v = dpp_add(v, 2); v = dpp_add(v, 3); return v; }
__device__ __forceinline__ float wave_sum(float v) {
    v = row16_sum(v);
    v += __int_as_float(__builtin_amdgcn_ds_swizzle(__float_as_int(v), 0x401F));
    { auto rr = __builtin_amdgcn_permlane32_swap(__float_as_uint(v), __float_as_uint(v), false, false);
      v = __uint_as_float(rr[0]) + __uint_as_float(rr[1]); }
    return v;
}
__device__ __forceinline__ float wave_scan_incl(float v) {
    v += __int_as_float(__builtin_amdgcn_update_dpp(0, __float_as_int(v), 0x111, 0xF, 0xF, true));
    v += __int_as_float(__builtin_amdgcn_update_dpp(0, __float_as_int(v), 0x112, 0xF, 0xF, true));
    v += __int_as_float(__builtin_amdgcn_update_dpp(0, __float_as_int(v), 0x114, 0xF, 0xF, true));
    v += __int_as_float(__builtin_amdgcn_update_dpp(0, __float_as_int(v), 0x118, 0xF, 0xF, true));
    v += __int_as_float(__builtin_amdgcn_update_dpp(0, __float_as_int(v), 0x142, 0xA, 0xF, false));
    v += __int_as_float(__builtin_amdgcn_update_dpp(0, __float_as_int(v), 0x143, 0xC, 0xF, false));
    return v;
}
__device__ __forceinline__ float silu_f(float x) { return x * __builtin_amdgcn_rcpf(1.f + __expf(-x)); }
__device__ __forceinline__ float sigmoid_f(float x) { return __builtin_amdgcn_rcpf(1.f + __expf(-x)); }
__device__ __forceinline__ float softplus_f(float x) { return x > 15.f ? x : __logf(1.f + __expf(x)); }
__device__ __forceinline__ float tanh_f(float x) { const float e = __expf(-2.f * fabsf(x)); const float t = (1.f - e) * __builtin_amdgcn_rcpf(1.f + e); return x < 0.f ? -t : t; }
__device__ __forceinline__ int tidx() { int t = threadIdx.x; asm volatile("" : "+v"(t)); return t; }
__device__ __forceinline__ int bidx() { int b = blockIdx.x; asm volatile("" : "+s"(b)); return b; }
__device__ __forceinline__ int wave_id() { return __builtin_amdgcn_readfirstlane(tidx() >> 6); }

__device__ __forceinline__ int row_set(int row) { return row < NLAT ? (row >> 14) : 2; }
__device__ __forceinline__ void row_seq(int row, int& base, int& pos, int& len) {
    if (row < NLAT) { base = row & ~16383; pos = row & 16383; len = SEQ; }
    else { const int r = row - NLAT; base = NLAT + (r & ~255); pos = r & 255; len = CTXL; }
}

#define XB_TMO      128
#define XB_XCNT(j)  (256  + 64 * (j))
#define XB_XSUB(j)  (1280 + 64 * (j))
#define XB_XGEN(j)  (2304 + 64 * (j))
#define XB_TOP      3328
#define XB_TOPGEN   3392
#define XCD_BAR_WORDS 3456
#define XB_SPIN_CAP (1u << 18)

__device__ __forceinline__ unsigned xb_ld(unsigned* p)              { return __hip_atomic_load(p, __ATOMIC_RELAXED, __HIP_MEMORY_SCOPE_AGENT); }
__device__ __forceinline__ unsigned xb_add(unsigned* p, unsigned v) { return __hip_atomic_fetch_add(p, v, __ATOMIC_RELAXED, __HIP_MEMORY_SCOPE_AGENT); }
__device__ __forceinline__ unsigned xb_xcc_id() { return (unsigned)__builtin_amdgcn_s_getreg((3 << 11) | 20) & 0xFu; }
#define XB_SPIN(cond, bar) do { unsigned _sp = 0; while (cond) { __builtin_amdgcn_s_sleep(1); \
    if ((++_sp & 255u) == 0u) { if (xb_ld(&(bar)[XB_TMO])) break; if (_sp > XB_SPIN_CAP) { atomicAdd(&(bar)[XB_TMO], 1u); break; } } } } while (0)

struct XcdBarrier { unsigned* bar; unsigned x; volatile LAS unsigned* st; };

__device__ __forceinline__ XcdBarrier xcd_barrier_post(unsigned* bar, volatile LAS unsigned* st) {
    XcdBarrier b; b.bar = bar; b.x = xb_xcc_id(); b.st = st;
    if (threadIdx.x == 0) (void)xb_add(&bar[XB_XCNT(b.x)], 1u);
    return b;
}
__device__ __forceinline__ void xcd_barrier_complete(unsigned* bar, unsigned x, unsigned& nloc, unsigned& nx) {
    const unsigned G = gridDim.x * gridDim.y * gridDim.z;
    unsigned sum, cnt, mine, sp = 0u;
    for (;;) {
        sum = 0u; cnt = 0u; mine = 0u;
#pragma unroll
        for (unsigned j = 0; j < 16; ++j) { const unsigned c = xb_ld(&bar[XB_XCNT(j)]); sum += c; cnt += (c > 0u) ? 1u : 0u; mine = (j == x) ? c : mine; }
        if (sum == G) break;
        __builtin_amdgcn_s_sleep(1);
        if ((++sp & 255u) == 0u) { if (xb_ld(&bar[XB_TMO])) break; if (sp > XB_SPIN_CAP) { atomicAdd(&bar[XB_TMO], 1u); break; } }
    }
    nloc = mine > 0u ? mine : 1u; nx = cnt > 0u ? cnt : 1u;
}
__device__ __forceinline__ void xcd_barrier(const XcdBarrier& b) {
    asm volatile("s_waitcnt vmcnt(0)" ::: "memory");
    __syncthreads();
    if (threadIdx.x == 0) {
        unsigned* bar = b.bar; unsigned bx = b.x;
        asm volatile("" : "+s"(bar), "+s"(bx));
        __builtin_amdgcn_s_waitcnt(0);
        unsigned nloc = b.st[0], nx = b.st[1];
        if (nloc == 0u) { xcd_barrier_complete(bar, bx, nloc, nx); b.st[0] = nloc; b.st[1] = nx; }
        const unsigned old = xb_add(&bar[XB_XSUB(bx)], 1u);
        const unsigned gen = old / nloc;
        if (old + 1u == (gen + 1u) * nloc) {
            __builtin_amdgcn_fence(__ATOMIC_RELEASE, "agent");
            asm volatile("s_waitcnt vmcnt(0)" ::: "memory");
            const unsigned og = xb_add(&bar[XB_TOP], 1u);
            const unsigned tg = og / nx;
            if (og + 1u == (tg + 1u) * nx) xb_add(&bar[XB_TOPGEN], 1u);
            else XB_SPIN(xb_ld(&bar[XB_TOPGEN]) == tg, bar);
            __builtin_amdgcn_fence(__ATOMIC_ACQUIRE, "agent");
            xb_add(&bar[XB_XGEN(bx)], 1u);
            asm volatile("s_waitcnt vmcnt(0)" ::: "memory");
        } else {
            XB_SPIN(xb_ld(&bar[XB_XGEN(bx)]) == gen, bar);
            __builtin_amdgcn_fence(__ATOMIC_ACQUIRE, "agent");
            asm volatile("s_waitcnt vmcnt(0)" ::: "memory");
        }
    }
    __syncthreads();
}

#ifdef PROBE_KIND
__device__ __forceinline__ int qrep(int kind) { int r = (kind == PROBE_KIND) ? 2 : 1; asm volatile("" : "+s"(r)); return r; }
#define QREP(kind) for (int rep_ = 0, nrep_ = qrep(kind); rep_ < nrep_; ++rep_)
#define QSYNC __syncthreads();
#else
#define QREP(kind)
#define QSYNC
#endif
constexpr int G_BK = 64, G_HALF = 128, G_HT = G_HALF * G_BK;

__device__ __forceinline__ int lds_byte(int r, int c) { const int st = (r >> 4) * 2 + (c >> 5), rr = r & 15, cc = c & 31, ob = rr * 64 + cc * 2; return st * 1024 + (ob ^ (((ob >> 9) & 1) << 5)); }
__device__ __forceinline__ void stage_rc(int b, int& R, int& C) { const int st = b / 1024, sb = b % 1024, swz = sb ^ (((sb >> 9) & 1) << 5); R = (st >> 1) * 16 + swz / 64; C = (st & 1) * 32 + (swz % 64) / 2; }

#define G_SA(b, h) (shm + ((b) * 2 + (h)) * G_HT)
#define G_SB(b, h) (shm + (4 + (b) * 2 + (h)) * G_HT)
#define G_GLDS(src, dst) __builtin_amdgcn_global_load_lds((const unsigned*)(src), (LAS unsigned*)(dst), 16, 0, 0)
#define G_STAGE_A(P, h, kt) do { const bf16_t* _s = A + arow.half_off(h) + (size_t)(kt) * G_BK; \
    G_GLDS(_s + ao[0], (char*)(P) + tid16); G_GLDS(_s + ao[1], (char*)(P) + tid16 + 8192); } while (0)
#define G_STAGE_B(P, h, kt) do { const bf16_t* _s = Bt + (size_t)(h) * G_HALF * LDB + (size_t)(kt) * G_BK; \
    G_GLDS(_s + bo[0], (char*)(P) + tid16); G_GLDS(_s + bo[1], (char*)(P) + tid16 + 8192); } while (0)
#define G_LDA(dst, b, h) _Pragma("unroll") for (int m = 0; m < 4; ++m) _Pragma("unroll") for (int k = 0; k < 2; ++k) \
    dst[m][k] = *reinterpret_cast<const bf16x8*>((const char*)G_SA(b, h) + lds_byte(wr * 64 + m * 16 + fr, k * 32 + fq * 8))
#define G_LDB(dst, b, h) _Pragma("unroll") for (int n = 0; n < 2; ++n) _Pragma("unroll") for (int k = 0; k < 2; ++k) \
    dst[n][k] = *reinterpret_cast<const bf16x8*>((const char*)G_SB(b, h) + lds_byte(wc * 32 + n * 16 + fr, k * 32 + fq * 8))
#define G_MMA(ai, bj, At, Bf) do { __builtin_amdgcn_s_setprio(1); \
    _Pragma("unroll") for (int m = 0; m < 4; ++m) _Pragma("unroll") for (int n = 0; n < 2; ++n) _Pragma("unroll") for (int k = 0; k < 2; ++k) \
      acc[ai][bj][m][n] = __builtin_amdgcn_mfma_f32_16x16x32_bf16(Bf[n][k], At[m][k], acc[ai][bj][m][n], 0, 0, 0); \
    __builtin_amdgcn_s_setprio(0); } while (0)
#define G_WAIT_V(n) asm volatile("s_waitcnt vmcnt(" #n ")" ::: "memory")
#define G_WAIT_L(n) asm volatile("s_waitcnt lgkmcnt(" #n ")" ::: "memory")
#define G_BAR __builtin_amdgcn_s_barrier()
#define G_SCHED __builtin_amdgcn_sched_barrier(0)

template <int K, int LDB, class ARow, class Epi>
__device__ __forceinline__ void gemm256(const bf16_t* __restrict__ A, const ARow& arow, const bf16_t* __restrict__ Bt, const Epi& epi) {
    bf16_t* shm = (bf16_t*)smem;
    int tz0 = tidx();
    const int tid16 = tz0 * 16;
    unsigned ao[2], bo[2];
    {
        int R0, C0, R1, C1; stage_rc(tid16, R0, C0); stage_rc(tid16 + 8192, R1, C1);
        ao[0] = arow.lane_off(R0) + C0; ao[1] = arow.lane_off(R1) + C1;
        bo[0] = (unsigned)(R0 * LDB + C0); bo[1] = (unsigned)(R1 * LDB + C1);
    }
    int wid = tz0 >> 6, lane = tz0 & 63, wr = wid >> 2, wc = wid & 3, fr = lane & 15, fq = lane >> 4;
    f32x4 acc[2][2][4][2];
#pragma unroll
    for (int a = 0; a < 2; ++a)
#pragma unroll
        for (int b = 0; b < 2; ++b)
#pragma unroll
            for (int m = 0; m < 4; ++m)
#pragma unroll
                for (int n = 0; n < 2; ++n) acc[a][b][m][n] = (f32x4){0.f, 0.f, 0.f, 0.f};
    bf16x8 At[4][2], B0[2][2], B1[2][2];
    constexpr int nt = K / G_BK;
    G_STAGE_B(G_SB(0, 0), 0, 0); G_STAGE_A(G_SA(0, 0), 0, 0);
    G_STAGE_B(G_SB(0, 1), 1, 0); G_STAGE_A(G_SA(0, 1), 1, 0);
    if (wr == 1) G_BAR;
    G_WAIT_V(4); G_BAR;
    G_STAGE_B(G_SB(1, 0), 0, 1); G_STAGE_A(G_SA(1, 0), 0, 1); G_STAGE_B(G_SB(1, 1), 1, 1);
    G_WAIT_V(6); G_BAR;
    for (int t = 0; t < nt - 2; t += 2) {
        G_LDB(B0, 0, 0); G_SCHED; G_LDA(At, 0, 0); G_STAGE_A(G_SA(1, 1), 1, t + 1);
        G_WAIT_L(8); G_BAR; G_WAIT_L(0); G_MMA(0, 0, At, B0); G_BAR; G_SCHED;
        G_LDB(B1, 0, 1); G_STAGE_B(G_SB(0, 0), 0, t + 2);
        G_BAR; G_WAIT_L(0); G_MMA(0, 1, At, B1); G_BAR;
        G_LDA(At, 0, 1); G_STAGE_A(G_SA(0, 0), 0, t + 2);
        G_BAR; G_WAIT_L(0); G_MMA(1, 0, At, B0); G_BAR; G_SCHED;
        G_STAGE_B(G_SB(0, 1), 1, t + 2);
        G_WAIT_V(6); G_BAR; G_MMA(1, 1, At, B1); G_BAR;
        G_LDB(B0, 1, 0); G_SCHED; G_LDA(At, 1, 0); G_STAGE_A(G_SA(0, 1), 1, t + 2);
        G_WAIT_L(8); G_BAR; G_WAIT_L(0); G_MMA(0, 0, At, B0); G_BAR; G_SCHED;
        G_LDB(B1, 1, 1); G_STAGE_B(G_SB(1, 0), 0, t + 3);
        G_BAR; G_WAIT_L(0); G_MMA(0, 1, At, B1); G_BAR;
        G_LDA(At, 1, 1); G_STAGE_A(G_SA(1, 0), 0, t + 3);
        G_BAR; G_WAIT_L(0); G_MMA(1, 0, At, B0); G_BAR; G_SCHED;
        G_STAGE_B(G_SB(1, 1), 1, t + 3);
        G_WAIT_V(6); G_BAR; G_MMA(1, 1, At, B1); G_BAR;
    }
    { int tz = tidx(); asm volatile("" : "+v"(tz)); wid = tz >> 6; lane = tz & 63; wr = wid >> 2; wc = wid & 3; fr = lane & 15; fq = lane >> 4; }
    { G_LDB(B0, 0, 0); G_WAIT_V(0); G_LDA(At, 0, 0); G_STAGE_A(G_SA(1, 1), 1, nt - 1);
      G_BAR; G_WAIT_L(0); G_MMA(0, 0, At, B0); G_BAR;
      G_LDB(B1, 0, 1); G_BAR; G_WAIT_L(0); G_MMA(0, 1, At, B1); G_BAR;
      G_LDA(At, 0, 1); G_WAIT_V(4); G_BAR; G_WAIT_L(0); G_MMA(1, 0, At, B0); G_MMA(1, 1, At, B1); G_BAR; }
    { G_LDB(B0, 1, 0); G_LDA(At, 1, 0); G_WAIT_V(2); G_BAR; G_WAIT_L(0); G_MMA(0, 0, At, B0); G_BAR;
      G_LDB(B1, 1, 1); G_WAIT_V(0); G_BAR; G_WAIT_L(0); G_MMA(0, 1, At, B1); G_BAR;
      G_LDA(At, 1, 1); G_BAR; G_WAIT_L(0); G_MMA(1, 0, At, B0); G_MMA(1, 1, At, B1); G_BAR; }
    if (wr == 0) G_BAR;
    epi(acc, wr, wc, fr, fq);
}

__device__ __forceinline__ int xcd_remap(int L, int nwg) { const int q = nwg / 8, r = nwg % 8, xcd = L % 8, off = L / 8; return (xcd < r ? xcd * (q + 1) : r * (q + 1) + (xcd - r) * q) + off; }
__device__ __forceinline__ void tile_of(int wgid, int nM, int nN, int& pm, int& pn) { const int nig = 8 * nN, gid = wgid / nig, fm = gid * 8, gsz = (nM - fm) < 8 ? (nM - fm) : 8; pm = fm + ((wgid % nig) % gsz); pn = (wgid % nig) / gsz; }

template <int K, int LDA, int LDB, class Units>
__device__ __forceinline__ void gemm_stream(const bf16_t* __restrict__ A, const Units& U) {
    bf16_t* shm = (bf16_t*)smem;
    typename Units::Info cur, nxt;
    if (!U.get(0, cur)) return;
    __syncthreads();
    int tz0 = tidx();
    const int tid16 = tz0 * 16;
    unsigned va[2], vb[2];
    { int R0, C0, R1, C1; stage_rc(tid16, R0, C0); stage_rc(tid16 + 8192, R1, C1);
      va[0] = (unsigned)(R0 * LDA + C0); va[1] = (unsigned)(R1 * LDA + C1); vb[0] = (unsigned)(R0 * LDB + C0); vb[1] = (unsigned)(R1 * LDB + C1); }
    const int wr = __builtin_amdgcn_readfirstlane(tz0 >> 8);
    int aoff, boff;
    { const int wid = tz0 >> 6, lane = tz0 & 63, wc = wid & 3, fr = lane & 15, fq = lane >> 4; aoff = lds_byte((wid >> 2) * 64 + fr, fq * 8); boff = lds_byte(wc * 32 + fr, fq * 8); }
#define GS_LDA(dst, b, h) _Pragma("unroll") for (int m = 0; m < 4; ++m) _Pragma("unroll") for (int k = 0; k < 2; ++k) \
    dst[m][k] = *reinterpret_cast<const bf16x8*>((const char*)G_SA(b, h) + aoff + m * 2048 + k * 1024)
#define GS_LDB(dst, b, h) _Pragma("unroll") for (int n = 0; n < 2; ++n) _Pragma("unroll") for (int k = 0; k < 2; ++k) \
    dst[n][k] = *reinterpret_cast<const bf16x8*>((const char*)G_SB(b, h) + boff + n * 2048 + k * 1024)
#define GS_STAGE_A(P, base, h) do { const bf16_t* _s = (base) + (size_t)(h) * G_HALF * LDA; G_GLDS(_s + va[0], (char*)(P) + tid16); G_GLDS(_s + va[1], (char*)(P) + tid16 + 8192); } while (0)
#define GS_STAGE_B(P, base, h) do { const bf16_t* _s = (base) + (size_t)(h) * G_HALF * LDB; G_GLDS(_s + vb[0], (char*)(P) + tid16); G_GLDS(_s + vb[1], (char*)(P) + tid16 + 8192); } while (0)
    f32x4 acc[2][2][4][2];
#pragma unroll
    for (int a = 0; a < 2; ++a)
#pragma unroll
        for (int b = 0; b < 2; ++b)
#pragma unroll
            for (int m = 0; m < 4; ++m)
#pragma unroll
                for (int n = 0; n < 2; ++n) acc[a][b][m][n] = (f32x4){0.f, 0.f, 0.f, 0.f};
    bf16x8 At[4][2], B0[2][2], B1[2][2];
    constexpr int nt = K / G_BK;
    const bf16_t* cA = A + cur.a; const bf16_t* cB = cur.b;
    GS_STAGE_B(G_SB(0, 0), cB, 0); GS_STAGE_A(G_SA(0, 0), cA, 0); GS_STAGE_B(G_SB(0, 1), cB, 1); GS_STAGE_A(G_SA(0, 1), cA, 1);
    if (wr == 1) G_BAR;
    G_WAIT_V(4); G_BAR;
    GS_STAGE_B(G_SB(1, 0), cB + G_BK, 0); GS_STAGE_A(G_SA(1, 0), cA + G_BK, 0); GS_STAGE_B(G_SB(1, 1), cB + G_BK, 1);
    G_WAIT_V(6); G_BAR;
    for (int ui = 0;; ++ui) {
        const bool has_next = U.get(ui + 1, nxt);
        const bf16_t* nA = has_next ? A + nxt.a : cA; const bf16_t* nB = has_next ? nxt.b : cB;
        for (int t = 0; t < nt; t += 2) {
            const bool last = (t == nt - 2);
            const bf16_t* a1 = cA + (size_t)(t + 1) * G_BK;
            const bf16_t* a2 = last ? nA : cA + (size_t)(t + 2) * G_BK; const bf16_t* b2 = last ? nB : cB + (size_t)(t + 2) * G_BK;
            const bf16_t* a3 = a2 + G_BK; const bf16_t* b3 = b2 + G_BK;
            GS_LDB(B0, 0, 0); G_SCHED; GS_LDA(At, 0, 0); GS_STAGE_A(G_SA(1, 1), a1, 1);
            G_WAIT_L(8); G_BAR; G_WAIT_L(0); G_MMA(0, 0, At, B0); G_BAR; G_SCHED;
            GS_LDB(B1, 0, 1); GS_STAGE_B(G_SB(0, 0), b2, 0);
            G_BAR; G_WAIT_L(0); G_MMA(0, 1, At, B1); G_BAR;
            GS_LDA(At, 0, 1); GS_STAGE_A(G_SA(0, 0), a2, 0);
            G_BAR; G_WAIT_L(0); G_MMA(1, 0, At, B0); G_BAR; G_SCHED;
            GS_STAGE_B(G_SB(0, 1), b2, 1);
            G_WAIT_V(6); G_BAR; G_MMA(1, 1, At, B1); G_BAR;
            GS_LDB(B0, 1, 0); G_SCHED; GS_LDA(At, 1, 0); GS_STAGE_A(G_SA(0, 1), a2, 1);
            G_WAIT_L(8); G_BAR; G_WAIT_L(0); G_MMA(0, 0, At, B0); G_BAR; G_SCHED;
            GS_LDB(B1, 1, 1); GS_STAGE_B(G_SB(1, 0), b3, 0);
            G_BAR; G_WAIT_L(0); G_MMA(0, 1, At, B1); G_BAR;
            GS_LDA(At, 1, 1); GS_STAGE_A(G_SA(1, 0), a3, 0);
            G_BAR; G_WAIT_L(0); G_MMA(1, 0, At, B0); G_BAR; G_SCHED;
            GS_STAGE_B(G_SB(1, 1), b3, 1);
            G_WAIT_V(6); G_BAR; G_MMA(1, 1, At, B1); G_BAR;
        }
        { const int tz = tidx(), wid = tz >> 6, lane = tz & 63; U.epi(acc, cur, wid >> 2, wid & 3, lane & 15, lane >> 4); }
        if (!has_next) break;
#pragma unroll
        for (int a = 0; a < 2; ++a)
#pragma unroll
            for (int b = 0; b < 2; ++b)
#pragma unroll
                for (int m = 0; m < 4; ++m)
#pragma unroll
                    for (int n = 0; n < 2; ++n) acc[a][b][m][n] = (f32x4){0.f, 0.f, 0.f, 0.f};
        cur = nxt; cA = nA; cB = nB;
    }
    G_WAIT_V(0);
    if (wr == 0) G_BAR;
    G_BAR;
#undef GS_STAGE_A
#undef GS_STAGE_B
#undef GS_LDA
#undef GS_LDB
}
namespace att {
constexpr int DQ = 96, DV = 64, NW = 8, QBLK = 32, KVBLK = 64;
constexpr float SCALE = 0.10206207261596575f;
constexpr float THR = 8.f;
constexpr int LDQ = 576, LDK = 96, LDV = 64, LDO = 1024;
constexpr int SHM_V = KVBLK * DV * 2;
constexpr int SHM_K = KVBLK * 128 * 2;
constexpr int NBUF = 3;
constexpr int SHM_ATTN = NBUF * SHM_V + NBUF * SHM_K + NW * 64 * 4;
#define KSWZ(row, colB) ((row) * 256 + ((colB) ^ (((row) & 7) << 4)))
#define SBAR() __builtin_amdgcn_sched_barrier(0)
__device__ __forceinline__ int crow(int r, int hi) { return (r & 3) + 8 * (r >> 2) + 4 * hi; }
__device__ __forceinline__ unsigned cvtpk(float lo, float hi) { unsigned r; asm volatile("v_cvt_pk_bf16_f32 %0, %1, %2" : "=v"(r) : "v"(lo), "v"(hi)); return r; }

constexpr float THRL = 11.5f;
__device__ __forceinline__ float bf16_exact(float x) { return __uint_as_float(cvtpk_bf16(x, 0.f) << 16); }
template <bool FIRST>
__device__ __forceinline__ void partialSM(f32x16& p0, f32x16& p1, float& m_reg, float& alpha) {
  float pmax = p0[0];
#pragma unroll
  for (int r = 1; r < 16; ++r) pmax = fmaxf(pmax, p0[r]);
#pragma unroll
  for (int r = 0; r < 16; ++r) pmax = fmaxf(pmax, p1[r]);
  { auto rr = __builtin_amdgcn_permlane32_swap(__float_as_uint(pmax), __float_as_uint(pmax), false, false);
    pmax = fmaxf(__uint_as_float(rr[0]), __uint_as_float(rr[1])); }
  if (!FIRST && __builtin_expect(__all(pmax <= THRL), 1)) { alpha = 1.f; }
  else {
    const float mn = FIRST ? bf16_exact(pmax) : bf16_exact(m_reg + fmaxf(pmax, 0.f));
    const float delta = mn - m_reg;
    alpha = __builtin_amdgcn_exp2f(-delta); m_reg = mn;
#pragma unroll
    for (int r = 0; r < 16; ++r) { p0[r] -= delta; p1[r] -= delta; }
  }
#pragma unroll
  for (int r = 0; r < 16; ++r) p0[r] = __builtin_amdgcn_exp2f(p0[r]);
}
__device__ __forceinline__ void finishSM(f32x16& p0, f32x16& p1, float alpha, float& l_reg, bf16x8& pa0, bf16x8& pa1, bf16x8& pa2, bf16x8& pa3) {
#pragma unroll
  for (int r = 0; r < 16; ++r) p1[r] = __builtin_amdgcn_exp2f(p1[r]);
  float ps = 0;
#pragma unroll
  for (int r = 0; r < 16; ++r) ps += p0[r];
#pragma unroll
  for (int r = 0; r < 16; ++r) ps += p1[r];
  { auto rr = __builtin_amdgcn_permlane32_swap(__float_as_uint(ps), __float_as_uint(ps), false, false);
    ps = __uint_as_float(rr[0]) + __uint_as_float(rr[1]); }
  l_reg = l_reg * alpha + ps;
#define PK4(P, BASE, OUT) do { unsigned a0 = cvtpk(P[BASE + 0], P[BASE + 1]), a1 = cvtpk(P[BASE + 2], P[BASE + 3]);   \
    unsigned b0 = cvtpk(P[BASE + 4], P[BASE + 5]), b1 = cvtpk(P[BASE + 6], P[BASE + 7]);                              \
    auto r0 = __builtin_amdgcn_permlane32_swap(a0, b0, false, false); auto r1 = __builtin_amdgcn_permlane32_swap(a1, b1, false, false); \
    u32x4 w = {r0[0], r1[0], r0[1], r1[1]}; OUT = *reinterpret_cast<bf16x8*>(&w); } while (0)
  PK4(p0, 0, pa0); PK4(p0, 8, pa1); PK4(p1, 0, pa2); PK4(p1, 8, pa3);
#undef PK4
}
__device__ __forceinline__ void qkt(f32x16& p0, f32x16& p1, const char* Ks, const bf16x8* qr, bf16x8 kaug, bf16x8 qaug, int r32, int hi) {
  p0 = f32x16{}; p1 = f32x16{};
#pragma unroll
  for (int d0 = 0; d0 < 6; ++d0) { int cb = (d0 * 16 + hi * 8) * 2;
    bf16x8 b0 = *reinterpret_cast<const bf16x8*>(Ks + KSWZ(r32, cb));
    bf16x8 b1 = *reinterpret_cast<const bf16x8*>(Ks + KSWZ(32 + r32, cb));
    p0 = __builtin_amdgcn_mfma_f32_32x32x16_bf16(b0, qr[d0], p0, 0, 0, 0);
    p1 = __builtin_amdgcn_mfma_f32_32x32x16_bf16(b1, qr[d0], p1, 0, 0, 0); }
  p0 = __builtin_amdgcn_mfma_f32_32x32x16_bf16(kaug, qaug, p0, 0, 0, 0);
  p1 = __builtin_amdgcn_mfma_f32_32x32x16_bf16(kaug, qaug, p1, 0, 0, 0);
}
__device__ __forceinline__ int v_st(int k, int c) { const int kk = (k & ~0xC) | ((k & 4) << 1) | ((k & 8) >> 1); return ((kk >> 3) * 2 + (c >> 5)) * 512 + ((kk & 7) * 32 + (c & 31)) * 2; }
__device__ __forceinline__ int v_rd_base(int lane) { return ((lane & 3) << 3) | (((lane >> 2) & 3) << 6) | (((lane >> 4) & 1) << 5) | (((lane >> 5) & 1) << 8); }
constexpr int v_rd_off(int d0, int ks, int half) { return d0 * 512 + ks * 2048 + half * 1024; }
template <int OFF> __device__ __forceinline__ s16x4 tr_read(int vb) {
  s16x4 r; asm volatile("ds_read_b64_tr_b16 %0, %1 offset:%2" : "=&v"(r) : "v"(vb), "i"(OFF) : "memory"); return r;
}
template <int D0> __device__ __forceinline__ void pv_one(f32x16& od, int vb, bf16x8 pa0, bf16x8 pa1, bf16x8 pa2, bf16x8 pa3) {
  const s16x4 l0 = tr_read<v_rd_off(D0, 0, 0)>(vb), h0 = tr_read<v_rd_off(D0, 0, 1)>(vb), l1 = tr_read<v_rd_off(D0, 1, 0)>(vb), h1 = tr_read<v_rd_off(D0, 1, 1)>(vb);
  const s16x4 l2 = tr_read<v_rd_off(D0, 2, 0)>(vb), h2 = tr_read<v_rd_off(D0, 2, 1)>(vb), l3 = tr_read<v_rd_off(D0, 3, 0)>(vb), h3 = tr_read<v_rd_off(D0, 3, 1)>(vb);
  asm volatile("s_waitcnt lgkmcnt(0)" ::: "memory"); SBAR();
#define PK(L, H) (bf16x8){L[0], L[1], L[2], L[3], H[0], H[1], H[2], H[3]}
  od = __builtin_amdgcn_mfma_f32_32x32x16_bf16(pa0, PK(l0, h0), od, 0, 0, 0);
  od = __builtin_amdgcn_mfma_f32_32x32x16_bf16(pa1, PK(l1, h1), od, 0, 0, 0);
  od = __builtin_amdgcn_mfma_f32_32x32x16_bf16(pa2, PK(l2, h2), od, 0, 0, 0);
  od = __builtin_amdgcn_mfma_f32_32x32x16_bf16(pa3, PK(l3, h3), od, 0, 0, 0);
#undef PK
}
__device__ __forceinline__ void pv_d0(f32x16* o, int vb, bf16x8 pa0, bf16x8 pa1, bf16x8 pa2, bf16x8 pa3) {
  pv_one<0>(o[0], vb, pa0, pa1, pa2, pa3); pv_one<1>(o[1], vb, pa0, pa1, pa2, pa3);
}

__device__ __forceinline__ void attn_body(const bf16_t* __restrict__ Qb, const bf16_t* __restrict__ Kh, const bf16_t* __restrict__ Vh, bf16_t* __restrict__ Ob, int seq, char* lds, const int samet = 0) {
  const int tid = tidx(), wid = tid >> 6, lane = tid & 63, r32 = lane & 31, hi = lane >> 5;
  char* V_lds = lds; char* K_lds = lds + NBUF * SHM_V;
  float* ws = (float*)(lds + NBUF * SHM_V + NBUF * SHM_K) + wid * 64; float* li_l = ws; float* al_l = ws + 32;
  float m_reg = 0.f, l_reg = 0.f; f32x16 o[2] = {}; bf16x8 qr[6];
  const bf16_t* Qw = Qb + (long)(wid * QBLK + r32) * LDQ + hi * 8;
#pragma unroll
  for (int d0 = 0; d0 < 6; ++d0) qr[d0] = *reinterpret_cast<const bf16x8*>(Qw + d0 * 16);
  bf16x8 kaug = {0, 0, 0, 0, 0, 0, 0, 0}; if (hi == 0) kaug[0] = 0x3F80;
  bf16x8 qaug = {0, 0, 0, 0, 0, 0, 0, 0};
#define QAUG() do { if (hi == 0) qaug[0] = (short)(cvtpk(-m_reg, 0.f) & 0xffffu); } while (0)
  const int kc0 = tid, kc1 = 512 + (tid & 255);
  const int kr0 = kc0 / 12, kcc0 = kc0 % 12, kr1 = kc1 / 12, kcc1 = kc1 % 12;
  const int vr = tid >> 3, vcc = tid & 7;
  const int kst0 = KSWZ(kr0, kcc0 * 16), kst1 = KSWZ(kr1, kcc1 * 16), vst = v_st(vr, vcc * 8);
  const int vb0 = (int)(uintptr_t)(LAS char*)V_lds + v_rd_base(lane);
  struct { bf16x8 vs0, ks0, ks1; } sr_[2];
#define SLOAD(i, k0_) do { const int k0 = samet ? 0 : (k0_); sr_[i].vs0 = *reinterpret_cast<const bf16x8*>(&Vh[(long)((k0) + vr) * LDV + vcc * 8]); \
    sr_[i].ks0 = *reinterpret_cast<const bf16x8*>(&Kh[(long)((k0) + kr0) * LDK + kcc0 * 8]); \
    sr_[i].ks1 = *reinterpret_cast<const bf16x8*>(&Kh[(long)((k0) + kr1) * LDK + kcc1 * 8]); } while (0)
#define SWRITE(b, i) do { *(bf16x8*)(V_lds + (b) * SHM_V + vst) = sr_[i].vs0; \
    *(bf16x8*)(K_lds + (b) * SHM_K + kst0) = sr_[i].ks0; *(bf16x8*)(K_lds + (b) * SHM_K + kst1) = sr_[i].ks1; } while (0)
#define SWAIT() asm volatile("s_waitcnt vmcnt(3)" ::: "memory")
#define RESC(a) do { if (__any((a) < 1.f)) { if (hi == 0) al_l[r32] = (a); asm volatile("s_waitcnt lgkmcnt(0)" ::: "memory"); \
    _Pragma("unroll") for (int r = 0; r < 16; ++r) { const float f_ = al_l[crow(r, hi)]; o[0][r] *= f_; o[1][r] *= f_; } QAUG(); } } while (0)
  f32x16 pA0, pA1, pB0, pB1; float alA, alB; bf16x8 pa0, pa1, pa2, pa3; const int NT = seq / KVBLK;
  constexpr int SE = 0, SO = 1;
  SLOAD(SE, 0); asm volatile("s_waitcnt vmcnt(0)" ::: "memory"); SWRITE(0, SE); __syncthreads();
  qkt(pA0, pA1, K_lds, qr, kaug, qaug, r32, hi); partialSM<true>(pA0, pA1, m_reg, alA); QAUG(); alA = 1.f;
  SLOAD(SO, KVBLK); if (2 < NT) SLOAD(SE, 2 * KVBLK);
  SWAIT(); SWRITE(1, SO); __syncthreads();
  int bp = 0, bc = 1, bn = 2;
  for (int j = 1; j + 1 < NT; j += 2) {
    SBAR(); qkt(pB0, pB1, K_lds + bc * SHM_K, qr, kaug, qaug, r32, hi);
    finishSM(pA0, pA1, alA, l_reg, pa0, pa1, pa2, pa3); SBAR();
    SLOAD(SO, (j + 2) * KVBLK); SBAR();
    pv_d0(o, vb0 + bp * SHM_V, pa0, pa1, pa2, pa3); partialSM<false>(pB0, pB1, m_reg, alB);
    SWAIT(); SWRITE(bn, SE);
    RESC(alB); __syncthreads();
    bp = bc; bc = bn; bn = bn == 2 ? 0 : bn + 1;
    SBAR(); qkt(pA0, pA1, K_lds + bc * SHM_K, qr, kaug, qaug, r32, hi);
    finishSM(pB0, pB1, alB, l_reg, pa0, pa1, pa2, pa3); SBAR();
    if (j + 3 < NT) SLOAD(SE, (j + 3) * KVBLK); SBAR();
    pv_d0(o, vb0 + bp * SHM_V, pa0, pa1, pa2, pa3); partialSM<false>(pA0, pA1, m_reg, alA);
    SWAIT(); SWRITE(bn, SO);
    RESC(alA); __syncthreads();
    bp = bc; bc = bn; bn = bn == 2 ? 0 : bn + 1;
  }
  SBAR(); qkt(pB0, pB1, K_lds + bc * SHM_K, qr, kaug, qaug, r32, hi);
  finishSM(pA0, pA1, alA, l_reg, pa0, pa1, pa2, pa3); SBAR();
  pv_d0(o, vb0 + bp * SHM_V, pa0, pa1, pa2, pa3); partialSM<false>(pB0, pB1, m_reg, alB);
  RESC(alB);
  finishSM(pB0, pB1, alB, l_reg, pa0, pa1, pa2, pa3); SBAR();
  pv_d0(o, vb0 + bc * SHM_V, pa0, pa1, pa2, pa3);
  if (hi == 0) li_l[r32] = l_reg; asm volatile("s_waitcnt lgkmcnt(0)" ::: "memory");
  float rli[16];
#pragma unroll
  for (int r = 0; r < 16; ++r) rli[r] = __builtin_amdgcn_rcpf(li_l[crow(r, hi)]);
  bf16_t* Ow = Ob + (long)(wid * QBLK) * LDO;
#pragma unroll
  for (int r = 0; r < 16; ++r) { int orow = crow(r, hi);
#pragma unroll
    for (int d0 = 0; d0 < 2; ++d0) Ow[(long)orow * LDO + d0 * 32 + r32] = f2bf(o[d0][r] * rli[r]); }
  __syncthreads();
#undef QAUG
#undef SLOAD
#undef SWRITE
#undef SWAIT
#undef RESC
}
}
template <class ColMap>
__device__ __forceinline__ void tr_tile(const ColMap& cm, int n0, int k0, int ksrc  , bf16_t* __restrict__ dst, long ldo) {
    float* tile = (float*)smem;
    const int tid = tidx();
    __syncthreads();
    {
        const int n = tid & 63; long ld; const float* base = cm(n0 + n, ld);
#pragma unroll
        for (int i = 0; i < 8; ++i) { const int k = (tid >> 6) + 8 * i;
            tile[k * 65 + n] = (base != nullptr && (k0 + k) < ksrc) ? base[(long)(k0 + k) * ld] : 0.f; }
    }
    __syncthreads();
    {
        const int n = tid >> 3, ks = (tid & 7) * 8;
        u32x4 w;
        w[0] = pack2bf(tile[(ks + 0) * 65 + n], tile[(ks + 1) * 65 + n]); w[1] = pack2bf(tile[(ks + 2) * 65 + n], tile[(ks + 3) * 65 + n]);
        w[2] = pack2bf(tile[(ks + 4) * 65 + n], tile[(ks + 5) * 65 + n]); w[3] = pack2bf(tile[(ks + 6) * 65 + n], tile[(ks + 7) * 65 + n]);
        *reinterpret_cast<u32x4*>(dst + (long)(n0 + n) * ldo + k0 + ks) = w;
    }
}

struct CmWin { const float* w; __device__ __forceinline__ const float* operator()(int n, long& ld) const {
    ld = IN_W; int s;
    if (n < 1280) s = n; else if (n < 1472) s = n - 1280 + 1292; else if (n < 1600) s = n - 1472 + 1484; else if (n < 1632) s = n - 1600 + 1612;
    else if (n < 1644) s = n - 1632 + 1280; else if (n < 1664) s = -1; else s = n - 1664 + 1644;
    return s < 0 ? nullptr : w + s; } };
struct CmPlain { const float* w; long ldw; __device__ __forceinline__ const float* operator()(int n, long& ld) const { ld = ldw; return w + n; } };
struct CmW13 { const float *w1, *w3; __device__ __forceinline__ const float* operator()(int n, long& ld) const {
    ld = 512; const int pn = n >> 8, half = (n >> 7) & 1, c = n & 127; return (half ? w3 : w1) + pn * 128 + c; } };

__device__ __forceinline__ void ph_prologue(const Params& p) {
    const int bid = bidx(), nb = gridDim.x, tid = tidx();
    unsigned char* ws = p.ws;
    {
        const int nIn = 4 * 44 * 16, nOut = 4 * 16 * 16;
        for (int u = bid; u < nIn + nOut; u += nb) {
            if (u < nIn) { const int L = u / (44 * 16), r = u % (44 * 16), nt = r / 16, kt = r % 16;
                CmWin cm{p.w_in + (size_t)L * 1024 * IN_W};
                tr_tile(cm, nt * 64, kt * 64, 1024, (bf16_t*)(ws + WS_WIN) + (size_t)L * UW * 1024, 1024);
            } else { const int v = u - nIn, L = v / 256, r = v % 256, nt = r / 16, kt = r % 16;
                CmPlain cm{p.w_out + (size_t)L * 1024 * 1024, 1024};
                tr_tile(cm, nt * 64, kt * 64, 1024, (bf16_t*)(ws + WS_WOUT) + (size_t)L * 1024 * 1024, 1024);
            }
        }
    }
    {
        bf16_t* wup = (bf16_t*)(ws + WS_WUP);
        const long total = (long)4 * UPW * UPK;
        for (long i = (long)bid * NTHREADS + tid; i < total; i += (long)nb * NTHREADS) {
            const int L = (int)(i / (UPW * UPK)), r = (int)(i % (UPW * UPK)), n = r / UPK, k = r % UPK;
            float v = 0.f;
            if (n < 576) { if (k < 192) v = p.mla_q_norm_w[L * 192 + k] * p.mla_w_uq[((size_t)L * 192 + k) * 576 + n]; }
            else if (n >= 768) { if (k >= 192 && k < 320) v = p.mla_kv_norm_w[L * 128 + (k - 192)] * p.mla_w_ukv[((size_t)L * 128 + (k - 192)) * 768 + (n - 768)]; }
            wup[i] = f2bf(v);
        }
    }
    {
        bf16_t* wl = (bf16_t*)(ws + WS_WLORA);
        const long total = (long)4 * 98304;
        for (long i = (long)bid * NTHREADS + tid; i < total; i += (long)nb * NTHREADS) {
            const int L = (int)(i / 98304), r = (int)(i % 98304); float v;
            if (r < 32768) { const int d = r / 16384, n = (r / 64) % 256, k = r % 64; v = p.rwkv_w2[(((size_t)L * 2 + d) * 64 + k) * 256 + n]; }
            else if (r < 65536) { const int q = r - 32768, d = q / 16384, n = (q / 64) % 256, k = q % 64; v = p.rwkv_a2[(((size_t)L * 2 + d) * 64 + k) * 256 + n]; }
            else { const int q = r - 65536, n = q / 128, k = q % 128; v = p.rwkv_g2[((size_t)L * 128 + k) * 256 + n]; }
            wl[i] = f2bf(v);
        }
    }
    {
        float* wrt = (float*)(ws + WS_WRT);
        const long total = (long)4 * 72 * 1024;
        for (long i = (long)bid * NTHREADS + tid; i < total; i += (long)nb * NTHREADS) {
            const int L = (int)(i / (72 * 1024)), r = (int)(i % (72 * 1024)), o = r / 1024, k = r % 1024;
            wrt[i] = o < 8 ? p.moe_w_rg[((size_t)L * 1024 + k) * 8 + o] : p.moe_w_re[((size_t)L * 1024 + k) * 64 + (o - 8)];
        }
    }
    {
        bf16_t* wr = (bf16_t*)(ws + WS_WRH);
        const long total = (long)4 * 80 * 1024;
        for (long i = (long)bid * NTHREADS + tid; i < total; i += (long)nb * NTHREADS) {
            const int L = (int)(i / (80 * 1024)), r = (int)(i % (80 * 1024)), o = r / 1024, k = r % 1024;
            const float v = o < 8 ? p.moe_w_rg[((size_t)L * 1024 + k) * 8 + o] : (o < 72 ? p.moe_w_re[((size_t)L * 1024 + k) * 64 + (o - 8)] : 0.f);
            const bf16_t hi = f2bf(v);
            wr[((size_t)L * 2 + 0) * 80 * 1024 + r] = hi; wr[((size_t)L * 2 + 1) * 80 * 1024 + r] = f2bf(v - bf2f(hi));
        }
    }
    {
        float* cs = (float*)smem;
        __syncthreads();
        for (int i = tid; i < 3 * 1024; i += NTHREADS) { const int s = i >> 10, k = i & 1023; const float v = s < 2 ? p.c[s * 1024 + k] : p.c_ctx[k]; cs[i] = silu_f(v); }
        __syncthreads();
        float* mods = (float*)(ws + WS_MODS);
        float* red = cs + 3 * 1024;
        const int lane = tid & 63, wid = tid >> 6;
        for (int task = bid; task < 4 * 96; task += nb) {
            const int L = task / 96, col = (task % 96) * 64 + lane;
            const float* w = p.mod_w + (size_t)L * 1024 * 6144 + (size_t)(128 * wid) * 6144 + col;
            const float* c0 = cs + 128 * wid;
            float a0 = 0.f, a1 = 0.f, a2 = 0.f;
#pragma unroll 16
            for (int k = 0; k < 128; ++k) { const float wv = w[(size_t)k * 6144]; a0 = fmaf(c0[k], wv, a0); a1 = fmaf(c0[1024 + k], wv, a1); a2 = fmaf(c0[2048 + k], wv, a2); }
            red[(wid * 3 + 0) * 64 + lane] = a0; red[(wid * 3 + 1) * 64 + lane] = a1; red[(wid * 3 + 2) * 64 + lane] = a2;
            __syncthreads();
            if (tid < 192) { const int s3 = tid >> 6; float acc = p.mod_b[L * 6144 + (task % 96) * 64 + lane];
#pragma unroll
                for (int w8 = 0; w8 < 8; ++w8) acc += red[(w8 * 3 + s3) * 64 + lane];
                mods[(L * 3 + s3) * 6144 + (task % 96) * 64 + lane] = acc; }
            __syncthreads();
        }
        __syncthreads();
    }
    {
        bf16_t* Xb = (bf16_t*)(ws + WS_X);
        const f32x4* x4 = (const f32x4*)p.x; const f32x4* c4 = (const f32x4*)p.ctx;
        const long nl = (long)NLAT * 256, nt = (long)NTOK * 256;
        for (long i = (long)bid * NTHREADS + tid; i < nt; i += (long)nb * NTHREADS) st4bf(Xb + i * 4, i < nl ? x4[i] : c4[i - nl]);
    }
}

__device__ __forceinline__ void tr_tile256(const float* __restrict__ srcA, const float* __restrict__ srcB, long ldsrc, bf16_t* __restrict__ dst, long ldo) {
    unsigned* tl = (unsigned*)smem;
    const int tid = tidx(), lane = tid & 63, w = tid >> 6;
    __syncthreads();
    f32x4 v0[4], v1[4];
    const float* sp = (lane < 32 ? srcA + lane * 4 : srcB + (lane - 32) * 4);
#pragma unroll
    for (int it = 0; it < 4; ++it) { const int kp = w + 8 * it;
        v0[it] = *(const f32x4*)(sp + (long)(2 * kp) * ldsrc); v1[it] = *(const f32x4*)(sp + (long)(2 * kp + 1) * ldsrc); }
#pragma unroll
    for (int it = 0; it < 4; ++it) { const int kp = w + 8 * it;
#pragma unroll
        for (int i = 0; i < 4; ++i) tl[(4 * lane + i) * 33 + kp] = cvtpk_bf16(v0[it][i], v1[it][i]); }
    __syncthreads();
#pragma unroll
    for (int it = 0; it < 4; ++it) { const int n = (tid >> 3) + 64 * it, ks = tid & 7;
        u32x4 o; o[0] = tl[n * 33 + ks * 4 + 0]; o[1] = tl[n * 33 + ks * 4 + 1]; o[2] = tl[n * 33 + ks * 4 + 2]; o[3] = tl[n * 33 + ks * 4 + 3];
        *(u32x4*)(dst + (long)n * ldo + ks * 8) = o; }
}
constexpr int MOE_CV_N13 = 64 * 4 * 16, MOE_CV_N2 = 64 * 4 * 8;
__device__ __forceinline__ void moe_convert_tile(const Params& p, int L, int u) {
    unsigned char* ws = p.ws;
    constexpr int n13 = MOE_CV_N13;
    {
        if (u < n13) { const int e = u / 64, r = u % 64, pn = r / 16, kt = r % 16;
            const size_t eo = ((size_t)L * 64 + e) * 1024 * 512 + (size_t)kt * 64 * 512 + pn * 128;
            tr_tile256(p.moe_w1 + eo, p.moe_w3 + eo, 512, (bf16_t*)(ws + WS_W13) + ((size_t)e * 1024 + pn * 256) * 1024 + kt * 64, 1024);
        } else { const int v = u - n13, e = v / 32, r = v % 32, nt = r / 8, kt = r % 8;
            const float* sb = p.moe_w2 + ((size_t)L * 64 + e) * 512 * 1024 + (size_t)kt * 64 * 1024 + nt * 256;
            tr_tile256(sb, sb + 128, 1024, (bf16_t*)(ws + WS_W2) + ((size_t)e * 1024 + nt * 256) * 512 + kt * 64, 512);
        }
    }
}
__device__ __forceinline__ void ph_norm1(const Params& p, int L) {
    unsigned char* ws = p.ws;
    bf16_t* X = (bf16_t*)(ws + WS_X); bf16_t* H = (bf16_t*)(ws + WS_H);
    const float* mods = (const float*)(ws + WS_MODS);
    const int* SLOT = (const int*)(ws + WS_SLOT); const float* GATE = (const float*)(ws + WS_GATE); const bf16_t* YE = (const bf16_t*)(ws + WS_YEXP);
    const int lane = tidx() & 63, gw = bidx() * 8 + wave_id(), nw = gridDim.x * 8;
    if (bidx() == 0) { ((int*)(ws + WS_MISC))[tidx()] = 0; ((int*)(ws + WS_MISC))[512 + tidx()] = 0; }
    const float* n1w = p.norm1_w + L * 1024;
    float* par = (float*)smem;
    __syncthreads();
    for (int i = tidx(); i < 3 * 1024; i += NTHREADS) { const int set = i >> 10, c = i & 1023; const float* md = mods + (L * 3 + set) * 6144;
        par[(set * 3 + 0) * 1024 + c] = n1w[c] * (1.f + md[1024 + c]); par[(set * 3 + 1) * 1024 + c] = md[c];
        par[(set * 3 + 2) * 1024 + c] = L > 0 ? mods[((L - 1) * 3 + set) * 6144 + 5 * 1024 + c] : 0.f; }
    __syncthreads();
    constexpr int RB = 2;
    int s0n[RB], s1n[RB]; float gan[RB], gbn[RB];
#pragma unroll
    for (int q = 0; q < RB; ++q) { s0n[q] = 0; s1n[q] = 0; gan[q] = 0.f; gbn[q] = 0.f; }
    if (L > 0 && gw * RB < NTOK) {
#pragma unroll
        for (int q = 0; q < RB; ++q) { const int r = gw * RB + q; s0n[q] = SLOT[r * 2]; s1n[q] = SLOT[r * 2 + 1]; gan[q] = GATE[r * 2]; gbn[q] = GATE[r * 2 + 1]; } }
    for (int r0 = gw * RB; r0 < NTOK; r0 += nw * RB) {
        f32x4 v[RB][4];
#pragma unroll
        for (int q = 0; q < RB; ++q)
#pragma unroll
            for (int i = 0; i < 4; ++i) v[q][i] = ld4bf(X + (size_t)(r0 + q) * 1024 + i * 256 + lane * 4);
        if (L > 0) {
            int s0[RB], s1[RB]; float ga[RB], gb[RB];
#pragma unroll
            for (int q = 0; q < RB; ++q) { s0[q] = s0n[q]; s1[q] = s1n[q]; ga[q] = gan[q]; gb[q] = gbn[q]; }
            { const int rn = r0 + nw * RB;
              if (rn < NTOK) {
#pragma unroll
                  for (int q = 0; q < RB; ++q) { s0n[q] = SLOT[(rn + q) * 2]; s1n[q] = SLOT[(rn + q) * 2 + 1]; gan[q] = GATE[(rn + q) * 2]; gbn[q] = GATE[(rn + q) * 2 + 1]; } } }
            u32x2 ya[RB][4], yb[RB][4];
#pragma unroll
            for (int q = 0; q < RB; ++q)
#pragma unroll
                for (int i = 0; i < 4; ++i) { const int col = i * 256 + lane * 4; ya[q][i] = *(const u32x2*)(YE + (size_t)s0[q] * 1024 + col); yb[q][i] = *(const u32x2*)(YE + (size_t)s1[q] * 1024 + col); }
#pragma unroll
            for (int q = 0; q < RB; ++q) { const float* g2 = par + (row_set(r0 + q) * 3 + 2) * 1024;
#pragma unroll
                for (int i = 0; i < 4; ++i) { const int col = i * 256 + lane * 4; const f32x4 gg = *(const f32x4*)(g2 + col);
                    v[q][i][0] += gg[0] * (ga[q] * __uint_as_float(ya[q][i][0] << 16) + gb[q] * __uint_as_float(yb[q][i][0] << 16));
                    v[q][i][1] += gg[1] * (ga[q] * __uint_as_float(ya[q][i][0] & 0xffff0000u) + gb[q] * __uint_as_float(yb[q][i][0] & 0xffff0000u));
                    v[q][i][2] += gg[2] * (ga[q] * __uint_as_float(ya[q][i][1] << 16) + gb[q] * __uint_as_float(yb[q][i][1] << 16));
                    v[q][i][3] += gg[3] * (ga[q] * __uint_as_float(ya[q][i][1] & 0xffff0000u) + gb[q] * __uint_as_float(yb[q][i][1] & 0xffff0000u));
                    st4bf(X + (size_t)(r0 + q) * 1024 + col, v[q][i]); } }
        }
#pragma unroll
        for (int q = 0; q < RB; ++q) { const int row = r0 + q, set = row_set(row);
            float ss = 0.f;
#pragma unroll
            for (int i = 0; i < 4; ++i) ss += v[q][i][0] * v[q][i][0] + v[q][i][1] * v[q][i][1] + v[q][i][2] * v[q][i][2] + v[q][i][3] * v[q][i][3];
            ss = wave_sum(ss);
            const float rs = rsqrtf(ss * (1.f / 1024.f) + NORM_EPS);
            const float* pa = par + (set * 3) * 1024;
#pragma unroll
            for (int i = 0; i < 4; ++i) { const int col = i * 256 + lane * 4;
                const f32x4 w = *(const f32x4*)(pa + col), sh = *(const f32x4*)(pa + 1024 + col);
                u32x2 o;
                o[0] = cvtpk_bf16(v[q][i][0] * rs * w[0] + sh[0], v[q][i][1] * rs * w[1] + sh[1]);
                o[1] = cvtpk_bf16(v[q][i][2] * rs * w[2] + sh[2], v[q][i][3] * rs * w[3] + sh[3]);
                *(u32x2*)(H + (size_t)row * 1024 + col) = o; } }
    }
}

template <int LD> struct ARowLin { size_t base;
    __device__ __forceinline__ size_t half_off(int h) const { return base + (size_t)h * G_HALF * LD; }
    __device__ __forceinline__ unsigned lane_off(int r) const { return (unsigned)(r * LD); } };

#define EPI_FENCE() asm volatile("" ::: "memory")
struct EpiBf16Store {
    bf16_t* O; long ld;
    __device__ __forceinline__ void operator()(const f32x4 (&acc)[2][2][4][2], int wr, int wc, int fr, int fq) const {
#pragma unroll
        for (int ai = 0; ai < 2; ++ai)
#pragma unroll
            for (int m = 0; m < 4; ++m) { bf16_t* rp = O + (long)(ai * 128 + wr * 64 + m * 16 + fr) * ld + wc * 32 + fq * 4;
#pragma unroll
                for (int bj = 0; bj < 2; ++bj)
#pragma unroll
                    for (int n = 0; n < 2; ++n) { const f32x4 a = acc[ai][bj][m][n]; u32x2 o; o[0] = cvtpk_bf16(a[0], a[1]); o[1] = cvtpk_bf16(a[2], a[3]);
                        *(u32x2*)(rp + bj * 128 + n * 16) = o; }
                EPI_FENCE(); }
    }
};
struct EpiResid {
    bf16_t* X; const float* mods_g; int row0, col0;
    __device__ __forceinline__ void operator()(const f32x4 (&acc)[2][2][4][2], int wr, int wc, int fr, int fq) const {
        const float* gp = mods_g + row_set(row0) * 6144 + col0 + wc * 32 + fq * 4;
#pragma unroll
        for (int bj = 0; bj < 2; ++bj)
#pragma unroll
            for (int n = 0; n < 2; ++n) { const f32x4 g = *(const f32x4*)(gp + bj * 128 + n * 16);
#pragma unroll
                for (int ai = 0; ai < 2; ++ai)
#pragma unroll
                    for (int m = 0; m < 4; ++m) { const int row = row0 + ai * 128 + wr * 64 + m * 16 + fr;
                        bf16_t* rp = X + (size_t)row * 1024 + col0 + wc * 32 + fq * 4 + bj * 128 + n * 16;
                        f32x4 x = ld4bf(rp); x += g * acc[ai][bj][m][n]; st4bf(rp, x); }
                EPI_FENCE(); }
    }
};
struct EpiSwiglu {
    bf16_t* O;
    __device__ __forceinline__ void operator()(const f32x4 (&acc)[2][2][4][2], int wr, int wc, int fr, int fq) const {
#pragma unroll
        for (int ai = 0; ai < 2; ++ai)
#pragma unroll
            for (int m = 0; m < 4; ++m) { bf16_t* rp = O + (long)(ai * 128 + wr * 64 + m * 16 + fr) * 512 + wc * 32 + fq * 4;
#pragma unroll
                for (int n = 0; n < 2; ++n) { const f32x4 a = acc[ai][0][m][n], b = acc[ai][1][m][n]; u32x2 o;
                    o[0] = cvtpk_bf16(silu_f(a[0]) * b[0], silu_f(a[1]) * b[1]); o[1] = cvtpk_bf16(silu_f(a[2]) * b[2], silu_f(a[3]) * b[3]);
                    *(u32x2*)(rp + n * 16) = o; }
                EPI_FENCE(); }
    }
};

struct UnitsIn { const bf16_t* W; bf16_t* U; int bid, nb;
    struct Info { size_t a; const bf16_t* b; bf16_t* o; };
    __device__ __forceinline__ bool get(int i, Info& u) const { const int t = bid + i * nb; if (t >= 130 * 11) return false; int pm, pn; tile_of(xcd_remap(t, 130 * 11), 130, 11, pm, pn);
        u.a = (size_t)pm * 256 * 1024; u.b = W + (size_t)pn * 256 * 1024; u.o = U + (size_t)pm * 256 * UW + pn * 256; return true; }
    __device__ __forceinline__ void epi(const f32x4 (&acc)[2][2][4][2], const Info& u, int wr, int wc, int fr, int fq) const { EpiBf16Store e{u.o, UW}; e(acc, wr, wc, fr, fq); } };
__device__ __forceinline__ void ph_gemm_in(const Params& p, int L) {
    unsigned char* ws = p.ws;
    UnitsIn un{(const bf16_t*)(ws + WS_WIN) + (size_t)L * UW * 1024, (bf16_t*)(ws + WS_U), bidx(), (int)gridDim.x};
    gemm_stream<1024, 1024, 1024>((const bf16_t*)(ws + WS_H), un);
}
struct UnitsOut { const bf16_t* W; bf16_t* X; const float* mg; int bid, nb, ntile;
    struct Info { size_t a; const bf16_t* b; int row0, col0; };
    __device__ __forceinline__ bool get(int i, Info& u) const { const int t = bid + i * nb; if (t >= ntile) return false; int pm, pn; tile_of(xcd_remap(t, ntile), ntile / 4, 4, pm, pn);
        u.a = (size_t)pm * 256 * 1024; u.b = W + (size_t)pn * 256 * 1024; u.row0 = pm * 256; u.col0 = pn * 256; return true; }
    __device__ __forceinline__ void epi(const f32x4 (&acc)[2][2][4][2], const Info& u, int wr, int wc, int fr, int fq) const { EpiResid e{X, mg, u.row0, u.col0}; e(acc, wr, wc, fr, fq); } };
__device__ __forceinline__ void ph_gemm_out(const Params& p, int L) {
    unsigned char* ws = p.ws;
    UnitsOut un{(const bf16_t*)(ws + WS_WOUT) + (size_t)L * 1024 * 1024, (bf16_t*)(ws + WS_X), (const float*)(ws + WS_MODS) + L * 3 * 6144 + 2 * 1024, bidx(), (int)gridDim.x,
                (L == DEPTH - 1 ? 128 : 130) * 4};
    gemm_stream<1024, 1024, 1024>((const bf16_t*)(ws + WS_MIX), un);
}

constexpr float QSC = 0.10206207261596575f * 1.4426950408889634f;
struct MlaRow { u32x4 nv, c0, c1, c2; };
__device__ __forceinline__ void mla_load(MlaRow& o, const bf16_t* U, const bf16_t* QU, int row, int lane) {
    o.nv = *(const u32x4*)(U + (size_t)row * UW + U_QD + 8 * (lane < 44 ? lane : 43));
    const bf16_t* qu = QU + (size_t)row * UPW + 8 * lane;
    o.c0 = *(const u32x4*)qu; o.c1 = *(const u32x4*)(qu + 512); o.c2 = *(const u32x4*)(qu + 1024);
}
__device__ __forceinline__ void mla_unpack(const u32x4& v, float (&f)[8]) {
#pragma unroll
    for (int i = 0; i < 4; ++i) { f[2 * i] = __uint_as_float(v[i] << 16); f[2 * i + 1] = __uint_as_float(v[i] & 0xffff0000u); } }
__device__ __forceinline__ u32x4 mla_pack(const float (&f)[8]) { u32x4 r = {cvtpk_bf16(f[0], f[1]), cvtpk_bf16(f[2], f[3]), cvtpk_bf16(f[4], f[5]), cvtpk_bf16(f[6], f[7])}; return r; }
__device__ __forceinline__ u32x4 mla_partner(const u32x4& v) { u32x4 r;
#pragma unroll
    for (int i = 0; i < 4; ++i) r[i] = (unsigned)__builtin_amdgcn_update_dpp(0, (int)v[i], 0xB1, 0xF, 0xF, true);
    return r; }
__device__ __forceinline__ u32x4 mla_rot(const u32x4& own, const u32x4& par, const float (&cs)[8], const float (&sn)[8], float scale) {
    float x[8], y[8], o[8]; mla_unpack(own, x); mla_unpack(par, y);
#pragma unroll
    for (int i = 0; i < 8; ++i) o[i] = (x[i] * cs[i] + y[i] * sn[i]) * scale;
    return mla_pack(o); }
__device__ __forceinline__ u32x4 mla_scale(const u32x4& v, float scale) { float x[8]; mla_unpack(v, x);
#pragma unroll
    for (int i = 0; i < 8; ++i) x[i] *= scale;
    return mla_pack(x); }
__device__ __forceinline__ void ph_mla_prep_rows(const Params& p, int row_lo, int row_hi, int wave_lin, int nwaves) {
    unsigned char* ws = p.ws;
    const bf16_t* U = (const bf16_t*)(ws + WS_U); const bf16_t* QU = (const bf16_t*)(ws + WS_QKVUP);
    bf16_t* Q = (bf16_t*)(ws + WS_Q); bf16_t* Kb = (bf16_t*)(ws + WS_K); bf16_t* Vb = (bf16_t*)(ws + WS_V);
    const int lane = tidx() & 63;
    const int l12 = lane % 12;
    const bool rope0 = l12 >= 8, rope1 = (lane >> 2) == 1, ropek = (lane >> 2) == 10;
    const int ropeg = rope0 ? (l12 - 8) >> 1 : (lane & 3) >> 1;
    const float sgn = (lane & 1) ? 1.f : -1.f;
    int row = row_lo + wave_lin;
    if (row >= row_hi) return;
    MlaRow cur; mla_load(cur, U, QU, row, lane);
    for (; row < row_hi; row += nwaves) {
        MlaRow nxt; { const int rn = row + nwaves < row_hi ? row + nwaves : row; mla_load(nxt, U, QU, rn, lane); }
        float ss = 0.f;
        { float f[8]; mla_unpack(cur.nv, f);
#pragma unroll
          for (int i = 0; i < 8; ++i) ss += f[i] * f[i]; }
        const float sq = wave_sum(lane < 24 ? ss : 0.f), sk = wave_sum((lane >= 24 && lane < 40) ? ss : 0.f);
        const float rq = rsqrtf(sq * (1.f / 192.f) + NORM_EPS), rk = rsqrtf(sk * (1.f / 128.f) + NORM_EPS);
        int b, pos; bool lat;
        if (row < NLAT) { b = row >> 14; pos = row & 16383; lat = true; } else { const int r = row - NLAT; b = r >> 8; pos = r & 255; lat = false; }
        const int kpos = lat ? CTXL + pos : pos;
        const float ax = (float)(ropeg ? (pos & 63) : (pos >> 6));
        float cs[8], sn[8];
        { const float inv[8] = {1.f, 0.31622776601683794f, 0.1f, 0.03162277660168379f, 0.01f, 0.003162277660168379f, 0.001f, 0.00031622776601683794f};
#pragma unroll
          for (int i = 0; i < 8; ++i) { const float rev = ax * inv[i] * 0.15915494309189535f;
              cs[i] = lat ? __builtin_amdgcn_cosf(rev) : 1.f; sn[i] = lat ? sgn * __builtin_amdgcn_sinf(rev) : 0.f; } }
        { const u32x4 par = mla_partner(cur.c0);
          const u32x4 o = rope0 ? mla_rot(cur.c0, par, cs, sn, rq * QSC) : mla_scale(cur.c0, rq * QSC);
          *(u32x4*)(Q + (size_t)row * 576 + 8 * lane) = o; }
        { const u32x4 par = mla_partner(cur.c1);
          if (lane < 8) { const u32x4 o = rope1 ? mla_rot(cur.c1, par, cs, sn, rq * QSC) : mla_scale(cur.c1, rq * QSC);
              *(u32x4*)(Q + (size_t)row * 576 + 512 + 8 * lane) = o; } }
        if (lane >= 32) { const int c = lane - 32, hd = c >> 4, cc = c & 15; const size_t base = (size_t)(b * 6 + hd) * KEYS + kpos;
            bf16_t* dst = cc < 8 ? Kb + base * 96 + 8 * cc : Vb + base * 64 + 8 * (cc - 8);
            *(u32x4*)dst = mla_scale(cur.c1, rk); }
        { const int c = lane + 32, hd = c >> 4, cc = c & 15; const size_t base = (size_t)(b * 6 + hd) * KEYS + kpos;
            bf16_t* dst = cc < 8 ? Kb + base * 96 + 8 * cc : Vb + base * 64 + 8 * (cc - 8);
            *(u32x4*)dst = mla_scale(cur.c2, rk); }
        { const u32x4 par = mla_partner(cur.nv);
          if (ropek) { const u32x4 o = mla_rot(cur.nv, par, cs, sn, 1.f);
#pragma unroll
              for (int hd = 0; hd < 6; ++hd) *(u32x4*)(Kb + ((size_t)(b * 6 + hd) * KEYS + kpos) * 96 + 64 + 8 * (lane & 3)) = o; } }
        cur = nxt;
    }
}
constexpr int SSD_UNITS = 2 * 130;
constexpr int SSD_RS = 136;
constexpr int SSD_XT = 0;
constexpr int SSD_B  = SSD_XT + 192 * SSD_RS * 2;
constexpr int SSD_C  = SSD_B + 128 * SSD_RS * 2;
constexpr int SSD_V  = SSD_C + 128 * SSD_RS * 2;
static_assert(SSD_V + 6 * 3 * 128 * 4 <= LDS_MISC, "SSD LDS map");

__device__ __forceinline__ void ssd_unit_rows(int unit, int& b, int& row0, int& qf, int& qb) {
    b = unit / 130; const int c = unit % 130;
    if (c < 2) { row0 = NLAT + b * CTXL + c * 128; qf = c; qb = 1 - c; }
    else { row0 = b * SEQ + (c - 2) * 128; qf = c; qb = 2 + 127 - (c - 2); }
}

template <int PASS>
__device__ __forceinline__ void ssd_stage(const Params& p, int L, int row0, int grp) {
    const bf16_t* U = (const bf16_t*)(p.ws + WS_U);
    bf16_t* XT = (bf16_t*)(smem + SSD_XT); bf16_t* Bl = (bf16_t*)(smem + SSD_B); bf16_t* Cl = (bf16_t*)(smem + SSD_C); float* Vv = (float*)(smem + SSD_V);
    const int tid = tidx();
    int sbase, spos0, slen; row_seq(row0, sbase, spos0, slen);
    if (tid < 448) {
        const int cp = tid % 224, rh = tid / 224, c2 = cp * 2;
        const int src = c2 < 192 ? grp * 192 + c2 : (c2 < 320 ? 384 + grp * 128 + (c2 - 192) : 640 + grp * 128 + (c2 - 320));
        if (PASS == 3 || c2 < 320) {
            const float* cw = p.ssd_conv_w + (size_t)L * 5 * 896 + src; const float* cb = p.ssd_conv_b + L * 896 + src;
            float w0[5], w1[5];
#pragma unroll
            for (int j = 0; j < 5; ++j) { w0[j] = cw[j * 896]; w1[j] = cw[j * 896 + 1]; }
            const float b0 = cb[0], b1 = cb[1];
            const int pos_lo = spos0 + rh * 64;
            const bf16_t* ub = U + (size_t)sbase * UW + U_XBC + src;
            unsigned xr[68];
#pragma unroll
            for (int j = 0; j < 68; ++j) { const int ps = pos_lo - 2 + j; xr[j] = (ps >= 0 && ps < slen) ? *(const unsigned*)(ub + (size_t)ps * UW) : 0u; }
#pragma unroll
            for (int i4 = 0; i4 < 64; i4 += 4) {
                float q0[4], q1[4];
#pragma unroll
                for (int ii = 0; ii < 4; ++ii) { const int i = i4 + ii;
                    float s0 = b0, s1 = b1;
#pragma unroll
                    for (int j = 0; j < 5; ++j) { s0 = fmaf(w0[j], __uint_as_float(xr[i + j] << 16), s0); s1 = fmaf(w1[j], __uint_as_float(xr[i + j] & 0xffff0000u), s1); }
                    q0[ii] = silu_f(s0); q1[ii] = silu_f(s1); }
                const int s = rh * 64 + i4;
                if (c2 < 192 || (PASS == 1 && c2 < 320)) {
                    bf16_t* T = c2 < 192 ? XT + c2 * SSD_RS + s : Bl + (c2 - 192) * SSD_RS + s;
                    u32x2 a = {cvtpk_bf16(q0[0], q0[1]), cvtpk_bf16(q0[2], q0[3])}, b = {cvtpk_bf16(q1[0], q1[1]), cvtpk_bf16(q1[2], q1[3])};
                    *(u32x2*)T = a; *(u32x2*)(T + SSD_RS) = b;
                } else {
                    bf16_t* T = c2 < 320 ? Bl + s * SSD_RS + (c2 - 192) : Cl + s * SSD_RS + (c2 - 320);
#pragma unroll
                    for (int ii = 0; ii < 4; ++ii) *(unsigned*)(T + ii * SSD_RS) = cvtpk_bf16(q0[ii], q1[ii]);
                }
            }
        }
    } else {
        float raw[12];
#pragma unroll
        for (int j = 0; j < 12; ++j) { const int e = tid - 448 + 64 * j, d = e / 384, hh = (e / 128) % 3, s = e % 128; raw[j] = bf2f(U[(size_t)(row0 + s) * UW + U_DT + d * 6 + grp * 3 + hh]); }
#pragma unroll
        for (int j = 0; j < 12; ++j) { const int e = tid - 448 + 64 * j, d = e / 384, hh = (e / 128) % 3, s = e % 128;
            Vv[(d * 3 + hh) * 128 + s] = softplus_f(raw[j] + p.ssd_dt_bias[(L * 2 + d) * 6 + grp * 3 + hh]); }
    }
    __syncthreads();
    if (tid < 384) {
        const int wv = tid >> 6, l = tid & 63, d = wv / 3, hh = wv % 3, h = grp * 3 + hh;
        const float a = -__expf(p.ssd_a_log[(L * 2 + d) * 6 + h]);
        const float* dt = Vv + (d * 3 + hh) * 128; float* cs = Vv + ((2 + d) * 3 + hh) * 128;
        const int s0 = d ? 127 - 2 * l : 2 * l, s1 = d ? 126 - 2 * l : 2 * l + 1;
        const float v0 = dt[s0] * a, v1 = dt[s1] * a;
        const float incl = wave_scan_incl(v0 + v1), excl = incl - (v0 + v1);
        cs[s0] = excl + v0; cs[s1] = incl;
    }
    __syncthreads();
    if (PASS == 1) {
        for (int e = tid; e < 2 * 3 * 128; e += NTHREADS) { const int d = e / 384, hh = (e / 128) % 3, s = e % 128;
            const float* cs = Vv + ((2 + d) * 3 + hh) * 128; const float tot = d ? cs[0] : cs[127];
            Vv[((4 + d) * 3 + hh) * 128 + s] = Vv[(d * 3 + hh) * 128 + s] * __expf(tot - cs[s]); }
        __syncthreads();
    }
}

__device__ void ssd_pass1_unit(const Params& p, int L, int unit) {
    float* SST = (float*)(p.ws + WS_SST); float* SDEC = (float*)(p.ws + WS_SDEC);
    const bf16_t* XT = (const bf16_t*)(smem + SSD_XT); const bf16_t* BT = (const bf16_t*)(smem + SSD_B); const float* Vv = (const float*)(smem + SSD_V);
    int b, row0, qf, qb; ssd_unit_rows(unit, b, row0, qf, qb);
    for (int grp = 0; grp < 2; ++grp) {
        __syncthreads();
        ssd_stage<1>(p, L, row0, grp);
        const int tid = tidx(), lane = tid & 63, w = tid >> 6, fr = lane & 15, g = lane >> 4;
        if (tid < 6) { const int d = tid / 3, hh = tid % 3; const float* cs = Vv + ((2 + d) * 3 + hh) * 128;
            SDEC[((size_t)(d * 2 + b) * 130 + (d ? qb : qf)) * 8 + grp * 3 + hh] = __expf(d ? cs[0] : cs[127]); }
#pragma unroll 1
        for (int dh = 0; dh < 6; ++dh) {
            const int d = dh / 3, hh = dh % 3, h = grp * 3 + hh;
            const float* wd = Vv + ((4 + d) * 3 + hh) * 128;
            bf16x8 bfr[4];
#pragma unroll
            for (int ks = 0; ks < 4; ++ks) {
                const u32x4 raw = *(const u32x4*)(BT + (16 * w + fr) * SSD_RS + 32 * ks + 8 * g);
                const f32x4 wa = *(const f32x4*)(wd + 32 * ks + 8 * g), wb = *(const f32x4*)(wd + 32 * ks + 8 * g + 4);
                u32x4 o;
                o[0] = cvtpk_bf16(__uint_as_float(raw[0] << 16) * wa[0], __uint_as_float(raw[0] & 0xffff0000u) * wa[1]);
                o[1] = cvtpk_bf16(__uint_as_float(raw[1] << 16) * wa[2], __uint_as_float(raw[1] & 0xffff0000u) * wa[3]);
                o[2] = cvtpk_bf16(__uint_as_float(raw[2] << 16) * wb[0], __uint_as_float(raw[2] & 0xffff0000u) * wb[1]);
                o[3] = cvtpk_bf16(__uint_as_float(raw[3] << 16) * wb[2], __uint_as_float(raw[3] & 0xffff0000u) * wb[3]);
                bfr[ks] = *reinterpret_cast<bf16x8*>(&o);
            }
            float* so = SST + ((((size_t)(d * 2 + b) * 130 + (d ? qb : qf)) * 6 + h) * 64) * 128 + 16 * w + fr;
#pragma unroll
            for (int mp = 0; mp < 4; ++mp) {
                f32x4 acc = {0.f, 0.f, 0.f, 0.f};
#pragma unroll
                for (int ks = 0; ks < 4; ++ks) {
                    const bf16x8 af = *(const bf16x8*)(XT + (hh * 64 + 16 * mp + fr) * SSD_RS + 32 * ks + 8 * g);
                    acc = __builtin_amdgcn_mfma_f32_16x16x32_bf16(af, bfr[ks], acc, 0, 0, 0);
                }
#pragma unroll
                for (int r = 0; r < 4; ++r) so[(size_t)(16 * mp + 4 * g + r) * 128] = acc[r];
            }
        }
    }
}

__device__ void ssd_scan_range(const Params& p, int thread_lin, int nthreads_total) {
    const float* SST = (const float*)(p.ws + WS_SST); const float* SDEC = (const float*)(p.ws + WS_SDEC); bf16_t* SB = (bf16_t*)(p.ws + WS_SSTB);
    for (int e = thread_lin; e < 2 * 2 * 6 * 128 * 64; e += nthreads_total) {
        const int db = e / (6 * 128 * 64), r = e % (6 * 128 * 64), h = r / (128 * 64);
        const float* sp = SST + (size_t)db * 130 * 6 * 128 * 64 + r; bf16_t* ob = SB + (size_t)db * 130 * 6 * 128 * 64 + r;
        const float* dp = SDEC + (size_t)db * 130 * 8 + h;
        float cur = 0.f;
#pragma unroll 10
        for (int q = 0; q < 130; ++q) {
            const float tmp = sp[(size_t)q * 6 * 128 * 64];
            ob[(size_t)q * 6 * 128 * 64] = f2bf(cur);
            cur = fmaf(cur, dp[q * 8], tmp);
        }
    }
}

__device__ void ssd_pass3_unit(const Params& p, int L, int unit) {
    const bf16_t* SB = (const bf16_t*)(p.ws + WS_SSTB); const bf16_t* U = (const bf16_t*)(p.ws + WS_U); bf16_t* MIX = (bf16_t*)(p.ws + WS_MIX); float* YS = (float*)(p.ws + WS_YS);
    const bf16_t* XT = (const bf16_t*)(smem + SSD_XT); const bf16_t* Bn = (const bf16_t*)(smem + SSD_B); const bf16_t* Cn = (const bf16_t*)(smem + SSD_C);
    const float* Vv = (const float*)(smem + SSD_V);
    int b, row0, qf, qb; ssd_unit_rows(unit, b, row0, qf, qb);
    float ss = 0.f;
#pragma unroll 1
    for (int grp = 0; grp < 2; ++grp) {
        const size_t hs_f = ((((size_t)(0 * 2 + b) * 130 + qf) * 6 + grp * 3) * 64) * 128, hs_b = ((((size_t)(1 * 2 + b) * 130 + qb) * 6 + grp * 3) * 64) * 128;
        u32x4 es[4];
#define SSD_ES_LOAD(hh_) { const int tid_ = tidx(); _Pragma("unroll") for (int i_ = 0; i_ < 4; ++i_) { const int idx_ = tid_ + 512 * i_, rem_ = idx_ & 1023; \
            es[i_] = *(const u32x4*)(SB + ((idx_ >> 10) ? hs_b : hs_f) + (size_t)(hh_) * 64 * 128 + (rem_ >> 4) * 128 + (rem_ & 15) * 8); } }
        SSD_ES_LOAD(0)
        QREP(10) {
        __syncthreads();
        ssd_stage<3>(p, L, row0, grp);
        }
        const int tid = tidx(), lane = tid & 63, w = tid >> 6, fr = lane & 15, g = lane >> 4;
        const int t = 16 * w + fr;
        const int row = row0 + t;
        bf16x8 cf[4];
#pragma unroll
        for (int ks = 0; ks < 4; ++ks) cf[ks] = *(const bf16x8*)(Cn + t * SSD_RS + 32 * ks + 8 * g);
        f32x4 gt[8];
#pragma unroll
        for (int mt = 0; mt < 8; ++mt) { f32x4 a = {0.f, 0.f, 0.f, 0.f};
#pragma unroll
            for (int ks = 0; ks < 4; ++ks) { const bf16x8 af = *(const bf16x8*)(Bn + (16 * mt + fr) * SSD_RS + 32 * ks + 8 * g);
                a = __builtin_amdgcn_mfma_f32_16x16x32_bf16(af, cf[ks], a, 0, 0, 0); }
            gt[mt] = a; }
        bf16_t* HS = (bf16_t*)(smem + SSD_B);
        const float ss_in = ss;
        { ss = ss_in;
#pragma unroll 1
        for (int hh = 0; hh < 3; ++hh) {
            const int h = grp * 3 + hh;
            const float* dt0 = Vv + (0 * 3 + hh) * 128; const float* dt1 = Vv + (1 * 3 + hh) * 128;
            const float* Av = Vv + (2 * 3 + hh) * 128; const float* Rv = Vv + (3 * 3 + hh) * 128;
            const float tA = Av[t], tR = Rv[t];
            __syncthreads();
            { const int tid_ = tidx();
#pragma unroll
              for (int i_ = 0; i_ < 4; ++i_) { const int idx_ = tid_ + 512 * i_, rem_ = idx_ & 1023; *(u32x4*)(HS + ((idx_ >> 10) * 64 + (rem_ >> 4)) * SSD_RS + (rem_ & 15) * 8) = es[i_]; } }
            __syncthreads();
            if (hh < 2) SSD_ES_LOAD(hh + 1)
            u32x2 zq[4];
#pragma unroll
            for (int mp = 0; mp < 4; ++mp) zq[mp] = *(const u32x2*)(U + (size_t)row * UW + U_Z + h * 64 + 16 * mp + 4 * g);
            bf16x8 wf[4];
#pragma unroll
            for (int ks = 0; ks < 4; ++ks) { u32x4 o;
#pragma unroll
                for (int half = 0; half < 2; ++half) { const int mt = 2 * ks + half, s0 = 16 * mt + 4 * g;
                    const f32x4 sA = *(const f32x4*)(Av + s0), sR = *(const f32x4*)(Rv + s0), d0 = *(const f32x4*)(dt0 + s0), d1 = *(const f32x4*)(dt1 + s0);
                    float wv[4];
#pragma unroll
                    for (int r = 0; r < 4; ++r) { const int s = s0 + r;
                        const float ef = __expf(s < t ? tA - sA[r] : tR - sR[r]);
                        const float m = s < t ? d0[r] * ef : (s > t ? d1[r] * ef : d0[r] + d1[r]);
                        wv[r] = gt[mt][r] * m; }
                    o[half * 2 + 0] = cvtpk_bf16(wv[0], wv[1]); o[half * 2 + 1] = cvtpk_bf16(wv[2], wv[3]); }
                wf[ks] = *reinterpret_cast<bf16x8*>(&o); }
            const float eA = __expf(tA), eR = __expf(tR);
            const float dsk = p.ssd_d[L * 6 + h];
#pragma unroll 1
            for (int mp = 0; mp < 4; ++mp) {
                bf16x8 hc[8];
                { const bf16_t* hl = HS + (16 * mp + fr) * SSD_RS + 8 * g;
#pragma unroll
                  for (int ks = 0; ks < 4; ++ks) { hc[2 * ks] = *(const bf16x8*)(hl + 32 * ks); hc[2 * ks + 1] = *(const bf16x8*)(hl + 64 * SSD_RS + 32 * ks); } }
                f32x4 acc = {0.f, 0.f, 0.f, 0.f};
                const bf16_t* xr = XT + (hh * 64 + 16 * mp + fr) * SSD_RS;
#pragma unroll
                for (int ks = 0; ks < 4; ++ks) {
                    const u32x2 lo = *(const u32x2*)(xr + 32 * ks + 4 * g), hi = *(const u32x2*)(xr + 32 * ks + 16 + 4 * g);
                    u32x4 aw = {lo[0], lo[1], hi[0], hi[1]};
                    acc = __builtin_amdgcn_mfma_f32_16x16x32_bf16(*reinterpret_cast<bf16x8*>(&aw), wf[ks], acc, 0, 0, 0); }
                f32x4 zf = {0.f, 0.f, 0.f, 0.f}, zb = {0.f, 0.f, 0.f, 0.f};
#pragma unroll
                for (int ks = 0; ks < 4; ++ks) {
                    zf = __builtin_amdgcn_mfma_f32_16x16x32_bf16(hc[2 * ks], cf[ks], zf, 0, 0, 0);
                    zb = __builtin_amdgcn_mfma_f32_16x16x32_bf16(hc[2 * ks + 1], cf[ks], zb, 0, 0, 0); }
                const int c = h * 64 + 16 * mp + 4 * g;
                const u32x2 zz = mp == 0 ? zq[0] : (mp == 1 ? zq[1] : (mp == 2 ? zq[2] : zq[3]));
                const float zg[4] = {__uint_as_float(zz[0] << 16), __uint_as_float(zz[0] & 0xffff0000u), __uint_as_float(zz[1] << 16), __uint_as_float(zz[1] & 0xffff0000u)};
#pragma unroll
                for (int r = 0; r < 4; ++r) { float v = acc[r] + eA * zf[r] + eR * zb[r] + dsk * bf2f(XT[(hh * 64 + 16 * mp + 4 * g + r) * SSD_RS + t]);
                    v *= silu_f(zg[r]); ss += v * v; acc[r] = v; }
                *(f32x4*)(YS + (size_t)row * 384 + c) = acc;
            }
        }
        }
    }
    {
        const int tid = tidx(), lane = tid & 63, w = tid >> 6, fr = lane & 15, g = lane >> 4;
        const int row = row0 + 16 * w + fr;
        ss += __int_as_float(__builtin_amdgcn_ds_swizzle(__float_as_int(ss), 0x401F));
        { auto rr = __builtin_amdgcn_permlane32_swap(__float_as_uint(ss), __float_as_uint(ss), false, false); ss = __uint_as_float(rr[0]) + __uint_as_float(rr[1]); }
        const float rs = rsqrtf(ss * (1.f / 384.f) + NORM_EPS);
        const float* nw = p.ssd_norm_w + L * 384;
#pragma unroll 12
        for (int i = 0; i < 24; ++i) { const int c = (i >> 2) * 64 + 16 * (i & 3) + 4 * g; const f32x4 wv = *(const f32x4*)(nw + c); const f32x4 v = *(const f32x4*)(YS + (size_t)row * 384 + c);
            u32x2 o; o[0] = cvtpk_bf16(v[0] * rs * wv[0], v[1] * rs * wv[1]); o[1] = cvtpk_bf16(v[2] * rs * wv[2], v[3] * rs * wv[3]);
            *(u32x2*)(MIX + (size_t)row * 1024 + c) = o; }
    }
}
constexpr size_t WS_RWPW = WS_RWP + (size_t)NTOK * 9 * 256 * 2;
constexpr int RW_UNITS_PREP = NTOK / 16;
__device__ __forceinline__ int rw_perm(int c) { return (c & ~63) | ((c & 15) << 2) | ((c >> 4) & 3); }
constexpr int RW_UCS = 1160;
__device__ void rwkv_prep_unit(const Params& p, int L, int unit) {
    unsigned char* ws = p.ws;
    const bf16_t* U = (const bf16_t*)(ws + WS_U); bf16_t* RWPH = (bf16_t*)(ws + WS_RWP); float* RWPW = (float*)(ws + WS_RWPW);
    const bf16_t* WL = (const bf16_t*)(ws + WS_WLORA) + (size_t)L * 98304;
    float* UC = (float*)smem;
    const int tid = tidx(), lane = tid & 63, w = tid >> 6, fr = lane & 15, g = lane >> 4;
    const int row0 = unit * 16;
    int sbase, spos0, slen; row_seq(row0, sbase, spos0, slen);
    {
        const int c2 = tid * 2;
        const float* sw = p.rwkv_shift_w + (size_t)L * 3 * 1152 + c2;
        const float w00 = sw[0], w01 = sw[1], w10 = sw[1152], w11 = sw[1153], w20 = sw[2304], w21 = sw[2305];
        unsigned xr[18];
#pragma unroll
        for (int j = 0; j < 18; ++j) { const int ps = spos0 - 1 + j; xr[j] = (ps >= 0 && ps < slen) ? *(const unsigned*)(U + (size_t)(row0 - 1 + j) * UW + U_RW + c2) : 0u; }
        const int c2b = 1024 + (tid & 63) * 2, rb = 2 * (tid >> 6);
        const float* swb = p.rwkv_shift_w + (size_t)L * 3 * 1152 + c2b;
        const float v00 = swb[0], v01 = swb[1], v10 = swb[1152], v11 = swb[1153], v20 = swb[2304], v21 = swb[2305];
        unsigned yr[4];
#pragma unroll
        for (int j = 0; j < 4; ++j) { const int ps = spos0 + rb - 1 + j; yr[j] = (ps >= 0 && ps < slen) ? *(const unsigned*)(U + (size_t)(row0 + rb - 1 + j) * UW + U_RW + c2b) : 0u; }
#pragma unroll
        for (int i = 0; i < 16; ++i) {
            float o0 = w00 * __uint_as_float(xr[i] << 16) + w10 * __uint_as_float(xr[i + 1] << 16) + w20 * __uint_as_float(xr[i + 2] << 16);
            float o1 = w01 * __uint_as_float(xr[i] & 0xffff0000u) + w11 * __uint_as_float(xr[i + 1] & 0xffff0000u) + w21 * __uint_as_float(xr[i + 2] & 0xffff0000u);
            if (c2 >= 768 && c2 < 896) { o0 = tanh_f(o0); o1 = tanh_f(o1); }
            UC[i * RW_UCS + c2] = o0; UC[i * RW_UCS + c2 + 1] = o1;
        }
#pragma unroll
        for (int i = 0; i < 2; ++i) {
            const float o0 = v00 * __uint_as_float(yr[i] << 16) + v10 * __uint_as_float(yr[i + 1] << 16) + v20 * __uint_as_float(yr[i + 2] << 16);
            const float o1 = v01 * __uint_as_float(yr[i] & 0xffff0000u) + v11 * __uint_as_float(yr[i + 1] & 0xffff0000u) + v21 * __uint_as_float(yr[i + 2] & 0xffff0000u);
            UC[(rb + i) * RW_UCS + c2b] = sigmoid_f(o0); UC[(rb + i) * RW_UCS + c2b + 1] = sigmoid_f(o1);
        }
    }
    __syncthreads();
    const int h = w & 3, half = w >> 2;
    f32x4 aw[2][4], aa[2][4], ag[4];
#pragma unroll
    for (int nt = 0; nt < 4; ++nt) { ag[nt] = (f32x4){0.f, 0.f, 0.f, 0.f};
#pragma unroll
        for (int d = 0; d < 2; ++d) { aw[d][nt] = (f32x4){0.f, 0.f, 0.f, 0.f}; aa[d][nt] = (f32x4){0.f, 0.f, 0.f, 0.f}; } }
    {
        const float* ur = UC + fr * RW_UCS + 8 * g;
        const bf16_t* wb = WL + (size_t)(h * 64 + fr) * 64 + 8 * g;
        const bf16_t* gb = WL + 65536 + (size_t)(h * 64 + fr) * 128 + 8 * g;
#pragma unroll
        for (int d = 0; d < 2; ++d)
#pragma unroll
            for (int ks = 0; ks < 2; ++ks) {
                const f32x4 x0 = *(const f32x4*)(ur + 768 + d * 64 + 32 * ks), x1 = *(const f32x4*)(ur + 768 + d * 64 + 32 * ks + 4);
                const f32x4 y0 = *(const f32x4*)(ur + 896 + d * 64 + 32 * ks), y1 = *(const f32x4*)(ur + 896 + d * 64 + 32 * ks + 4);
                u32x4 xw = {cvtpk_bf16(x0[0], x0[1]), cvtpk_bf16(x0[2], x0[3]), cvtpk_bf16(x1[0], x1[1]), cvtpk_bf16(x1[2], x1[3])};
                u32x4 yw = {cvtpk_bf16(y0[0], y0[1]), cvtpk_bf16(y0[2], y0[3]), cvtpk_bf16(y1[0], y1[1]), cvtpk_bf16(y1[2], y1[3])};
#pragma unroll
                for (int nt = 0; nt < 4; ++nt) {
                    const bf16x8 bw = *(const bf16x8*)(wb + d * 16384 + nt * 1024 + ks * 32), ba = *(const bf16x8*)(wb + 32768 + d * 16384 + nt * 1024 + ks * 32);
                    aw[d][nt] = __builtin_amdgcn_mfma_f32_16x16x32_bf16(*reinterpret_cast<bf16x8*>(&xw), bw, aw[d][nt], 0, 0, 0);
                    aa[d][nt] = __builtin_amdgcn_mfma_f32_16x16x32_bf16(*reinterpret_cast<bf16x8*>(&yw), ba, aa[d][nt], 0, 0, 0); }
            }
#pragma unroll
        for (int ks = 0; ks < 4; ++ks) {
            const f32x4 x0 = *(const f32x4*)(ur + 1024 + 32 * ks), x1 = *(const f32x4*)(ur + 1024 + 32 * ks + 4);
            u32x4 xw = {cvtpk_bf16(x0[0], x0[1]), cvtpk_bf16(x0[2], x0[3]), cvtpk_bf16(x1[0], x1[1]), cvtpk_bf16(x1[2], x1[3])};
#pragma unroll
            for (int nt = 0; nt < 4; ++nt) { const bf16x8 bg = *(const bf16x8*)(gb + nt * 2048 + ks * 32);
                ag[nt] = __builtin_amdgcn_mfma_f32_16x16x32_bf16(*reinterpret_cast<bf16x8*>(&xw), bg, ag[nt], 0, 0, 0); }
        }
    }
    float w0a[4], w0b[4], a0a[4], a0b[4], kkw[4], kaw[4], rkw[4];
#pragma unroll
    for (int nt = 0; nt < 4; ++nt) { const int c = h * 64 + 16 * nt + fr;
        w0a[nt] = p.rwkv_w0[(L * 2 + 0) * 256 + c]; w0b[nt] = p.rwkv_w0[(L * 2 + 1) * 256 + c];
        a0a[nt] = p.rwkv_a0[(L * 2 + 0) * 256 + c]; a0b[nt] = p.rwkv_a0[(L * 2 + 1) * 256 + c];
        kkw[nt] = p.rwkv_k_k[L * 256 + c]; kaw[nt] = p.rwkv_k_a[L * 256 + c]; rkw[nt] = p.rwkv_r_k[L * 256 + c]; }
#pragma unroll
    for (int rr = 0; rr < 2; ++rr) {
        const int reg = 2 * half + rr, t = 4 * g + reg;
        const float* uc = UC + t * RW_UCS + h * 64 + fr;
        float r[4], k[4], v[4], kr[4], as0[4], as1[4], kd0[4], kd1[4];
        float ss = 0.f, bs = 0.f;
#pragma unroll
        for (int nt = 0; nt < 4; ++nt) {
            r[nt] = uc[16 * nt]; k[nt] = uc[256 + 16 * nt]; v[nt] = uc[512 + 16 * nt];
            as0[nt] = sigmoid_f(a0a[nt] + aa[0][nt][reg]); as1[nt] = sigmoid_f(a0b[nt] + aa[1][nt][reg]);
            kr[nt] = k[nt] * kkw[nt]; ss += kr[nt] * kr[nt];
            kd0[nt] = k[nt] * (1.f + (as0[nt] - 1.f) * kaw[nt]); kd1[nt] = k[nt] * (1.f + (as1[nt] - 1.f) * kaw[nt]);
            bs += r[nt] * (kd0[nt] + kd1[nt]) * rkw[nt]; }
        ss = row16_sum(ss); bs = row16_sum(bs);
        const float rn = 1.f / fmaxf(__builtin_amdgcn_sqrtf(ss), 1e-12f);
        bf16_t* orow = RWPH + (size_t)(row0 + t) * 9 * 256;
        bf16_t* op = orow + h * 64 + fr * 4;
        float* opw = RWPW + (size_t)(row0 + t) * 512 + h * 64 + fr * 4;
#define RW_ST4(F, a0_, a1_, a2_, a3_) { u32x2 o_ = {cvtpk_bf16(a0_, a1_), cvtpk_bf16(a2_, a3_)}; *(u32x2*)(op + (F) * 256) = o_; }
        RW_ST4(0, r[0], r[1], r[2], r[3])
        float kn[4];
#pragma unroll
        for (int nt = 0; nt < 4; ++nt) kn[nt] = kr[nt] * rn;
        RW_ST4(2, kn[0], kn[1], kn[2], kn[3])
        RW_ST4(7, kn[0] * as0[0], kn[1] * as0[1], kn[2] * as0[2], kn[3] * as0[3])
        RW_ST4(8, kn[0] * as1[0], kn[1] * as1[1], kn[2] * as1[2], kn[3] * as1[3])
        f32x4 q;
#pragma unroll
        for (int nt = 0; nt < 4; ++nt) { const float wl0 = -softplus_f(-(w0a[nt] + aw[0][nt][reg])) - 0.5f; q[nt] = __expf(-__expf(wl0)); }
        *(f32x4*)(opw + 0 * 256) = q;
#pragma unroll
        for (int nt = 0; nt < 4; ++nt) { const float wl1 = -softplus_f(-(w0b[nt] + aw[1][nt][reg])) - 0.5f; q[nt] = __expf(-__expf(wl1)); }
        *(f32x4*)(opw + 1 * 256) = q;
        RW_ST4(5, kd0[0], kd0[1], kd0[2], kd0[3])
        RW_ST4(6, kd1[0], kd1[1], kd1[2], kd1[3])
#pragma unroll
        for (int nt = 0; nt < 4; ++nt) { bf16_t* o = orow + h * 64 + 16 * nt + fr; o[1 * 256] = f2bf(v[nt]); o[3 * 256] = f2bf(bs * v[nt]); o[4 * 256] = f2bf(ag[nt][reg]); }
    }
}

__device__ __forceinline__ int rw_chunk_row0(int d, int b, int q) {
    if (d == 0) return q < 4 ? NLAT + b * CTXL + q * 64 : b * SEQ + (q - 4) * 64;
    return q < 4 ? NLAT + b * CTXL + (3 - q) * 64 : b * SEQ + (255 - (q - 4)) * 64;
}
constexpr int RW_UNITS = 2 * 2 * 260;

#define RW_FMAC(acc, vec, n, x) asm("v_fmac_f32_dpp %0, %1, %2 row_newbcast:" #n " row_mask:0xf bank_mask:0xf" : "+v"(acc) : "v"(vec), "v"(x))
#define RW_MUL(d, vec, n, x) asm("v_mul_f32_dpp %0, %1, %2 row_newbcast:" #n " row_mask:0xf bank_mask:0xf" : "=v"(d) : "v"(vec), "v"(x))
#define RW_HAZ() asm volatile("s_nop 1" ::: "memory")

#if !RW_UT
__device__ void rwkv_passA_unit(const Params& p, int unit) {
    const float* RWP = (const float*)(p.ws + WS_RWP); float* RPQ = (float*)(p.ws + WS_RPQ); float* RY = (float*)(p.ws + WS_RY);
    const int lane = tidx() & 63, wid = wave_id(), h = wid & 3, kind = wid >> 2;
    const int d = unit / 520, b = (unit / 260) & 1, q = unit % 260;
    const int row0 = rw_chunk_row0(d, b, q);
    float s[64];
#pragma unroll
    for (int k = 0; k < 64; ++k) s[k] = (kind == 0 && k == lane) ? 1.f : 0.f;
    const int rstep = d ? -1 : 1; int row = d ? row0 + 63 : row0;
    const float* lb = RWP + h * 64 + (lane & 15) * 4;
    const size_t cs = ((size_t)(d * 2 + b) * 260 + q) * 4 + h;
    float* yo = RY + (cs * 2 + kind) * 4096 + lane;
    f32x4 wv = *(const f32x4*)(lb + ((size_t)row * 11 + 5 + d) * 256), av = *(const f32x4*)(lb + ((size_t)row * 11 + 2) * 256);
    f32x4 bv = *(const f32x4*)(lb + ((size_t)row * 11 + 9 + d) * 256), kv = *(const f32x4*)(lb + ((size_t)row * 11 + 7 + d) * 256);
    f32x4 rv = *(const f32x4*)(lb + ((size_t)row * 11 + 0) * 256);
    float vv = kind ? RWP[((size_t)row * 11 + 1) * 256 + h * 64 + lane] : 0.f;
    if (kind) {
#pragma unroll 1
        for (int i = 0; i < 64; ++i) {
            row += rstep; const int rn = i < 63 ? row : row - rstep;
            const f32x4 wn = *(const f32x4*)(lb + ((size_t)rn * 11 + 5 + d) * 256), an = *(const f32x4*)(lb + ((size_t)rn * 11 + 2) * 256);
            const f32x4 bn = *(const f32x4*)(lb + ((size_t)rn * 11 + 9 + d) * 256), kn = *(const f32x4*)(lb + ((size_t)rn * 11 + 7 + d) * 256);
            const f32x4 rnv = *(const f32x4*)(lb + ((size_t)rn * 11 + 0) * 256);
            const float vn = RWP[((size_t)rn * 11 + 1) * 256 + h * 64 + lane];
            float sa0 = 0.f, sa1 = 0.f, sa2 = 0.f, sa3 = 0.f, sa4 = 0.f, sa5 = 0.f, sa6 = 0.f, sa7 = 0.f;
            RW_HAZ();
            { const float a_ = av[0]; RW_FMAC(sa0, a_, 0, s[0]); }
            { const float a_ = av[0]; RW_FMAC(sa1, a_, 1, s[1]); }
            { const float a_ = av[0]; RW_FMAC(sa2, a_, 2, s[2]); }
            { const float a_ = av[0]; RW_FMAC(sa3, a_, 3, s[3]); }
            { const float a_ = av[0]; RW_FMAC(sa4, a_, 4, s[4]); }
            { const float a_ = av[0]; RW_FMAC(sa5, a_, 5, s[5]); }
            { const float a_ = av[0]; RW_FMAC(sa6, a_, 6, s[6]); }
            { const float a_ = av[0]; RW_FMAC(sa7, a_, 7, s[7]); }
            { const float a_ = av[0]; RW_FMAC(sa0, a_, 8, s[8]); }
            { const float a_ = av[0]; RW_FMAC(sa1, a_, 9, s[9]); }
            { const float a_ = av[0]; RW_FMAC(sa2, a_, 10, s[10]); }
            { const float a_ = av[0]; RW_FMAC(sa3, a_, 11, s[11]); }
            { const float a_ = av[0]; RW_FMAC(sa4, a_, 12, s[12]); }
            { const float a_ = av[0]; RW_FMAC(sa5, a_, 13, s[13]); }
            { const float a_ = av[0]; RW_FMAC(sa6, a_, 14, s[14]); }
            { const float a_ = av[0]; RW_FMAC(sa7, a_, 15, s[15]); }
            { const float a_ = av[1]; RW_FMAC(sa0, a_, 0, s[16]); }
            { const float a_ = av[1]; RW_FMAC(sa1, a_, 1, s[17]); }
            { const float a_ = av[1]; RW_FMAC(sa2, a_, 2, s[18]); }
            { const float a_ = av[1]; RW_FMAC(sa3, a_, 3, s[19]); }
            { const float a_ = av[1]; RW_FMAC(sa4, a_, 4, s[20]); }
            { const float a_ = av[1]; RW_FMAC(sa5, a_, 5, s[21]); }
            { const float a_ = av[1]; RW_FMAC(sa6, a_, 6, s[22]); }
            { const float a_ = av[1]; RW_FMAC(sa7, a_, 7, s[23]); }
            { const float a_ = av[1]; RW_FMAC(sa0, a_, 8, s[24]); }
            { const float a_ = av[1]; RW_FMAC(sa1, a_, 9, s[25]); }
            { const float a_ = av[1]; RW_FMAC(sa2, a_, 10, s[26]); }
            { const float a_ = av[1]; RW_FMAC(sa3, a_, 11, s[27]); }
            { const float a_ = av[1]; RW_FMAC(sa4, a_, 12, s[28]); }
            { const float a_ = av[1]; RW_FMAC(sa5, a_, 13, s[29]); }
            { const float a_ = av[1]; RW_FMAC(sa6, a_, 14, s[30]); }
            { const float a_ = av[1]; RW_FMAC(sa7, a_, 15, s[31]); }
            { const float a_ = av[2]; RW_FMAC(sa0, a_, 0, s[32]); }
            { const float a_ = av[2]; RW_FMAC(sa1, a_, 1, s[33]); }
            { const float a_ = av[2]; RW_FMAC(sa2, a_, 2, s[34]); }
            { const float a_ = av[2]; RW_FMAC(sa3, a_, 3, s[35]); }
            { const float a_ = av[2]; RW_FMAC(sa4, a_, 4, s[36]); }
            { const float a_ = av[2]; RW_FMAC(sa5, a_, 5, s[37]); }
            { const float a_ = av[2]; RW_FMAC(sa6, a_, 6, s[38]); }
            { const float a_ = av[2]; RW_FMAC(sa7, a_, 7, s[39]); }
            { const float a_ = av[2]; RW_FMAC(sa0, a_, 8, s[40]); }
            { const float a_ = av[2]; RW_FMAC(sa1, a_, 9, s[41]); }
            { const float a_ = av[2]; RW_FMAC(sa2, a_, 10, s[42]); }
            { const float a_ = av[2]; RW_FMAC(sa3, a_, 11, s[43]); }
            { const float a_ = av[2]; RW_FMAC(sa4, a_, 12, s[44]); }
            { const float a_ = av[2]; RW_FMAC(sa5, a_, 13, s[45]); }
            { const float a_ = av[2]; RW_FMAC(sa6, a_, 14, s[46]); }
            { const float a_ = av[2]; RW_FMAC(sa7, a_, 15, s[47]); }
            { const float a_ = av[3]; RW_FMAC(sa0, a_, 0, s[48]); }
            { const float a_ = av[3]; RW_FMAC(sa1, a_, 1, s[49]); }
            { const float a_ = av[3]; RW_FMAC(sa2, a_, 2, s[50]); }
            { const float a_ = av[3]; RW_FMAC(sa3, a_, 3, s[51]); }
            { const float a_ = av[3]; RW_FMAC(sa4, a_, 4, s[52]); }
            { const float a_ = av[3]; RW_FMAC(sa5, a_, 5, s[53]); }
            { const float a_ = av[3]; RW_FMAC(sa6, a_, 6, s[54]); }
            { const float a_ = av[3]; RW_FMAC(sa7, a_, 7, s[55]); }
            { const float a_ = av[3]; RW_FMAC(sa0, a_, 8, s[56]); }
            { const float a_ = av[3]; RW_FMAC(sa1, a_, 9, s[57]); }
            { const float a_ = av[3]; RW_FMAC(sa2, a_, 10, s[58]); }
            { const float a_ = av[3]; RW_FMAC(sa3, a_, 11, s[59]); }
            { const float a_ = av[3]; RW_FMAC(sa4, a_, 12, s[60]); }
            { const float a_ = av[3]; RW_FMAC(sa5, a_, 13, s[61]); }
            { const float a_ = av[3]; RW_FMAC(sa6, a_, 14, s[62]); }
            { const float a_ = av[3]; RW_FMAC(sa7, a_, 15, s[63]); }
            const float sa = -(((sa0 + sa1) + (sa2 + sa3)) + ((sa4 + sa5) + (sa6 + sa7)));
            { const float w_ = wv[0]; float t_; RW_MUL(t_, w_, 0, s[0]); s[0] = t_; }
            { const float w_ = wv[0]; float t_; RW_MUL(t_, w_, 1, s[1]); s[1] = t_; }
            { const float w_ = wv[0]; float t_; RW_MUL(t_, w_, 2, s[2]); s[2] = t_; }
            { const float w_ = wv[0]; float t_; RW_MUL(t_, w_, 3, s[3]); s[3] = t_; }
            { const float w_ = wv[0]; float t_; RW_MUL(t_, w_, 4, s[4]); s[4] = t_; }
            { const float w_ = wv[0]; float t_; RW_MUL(t_, w_, 5, s[5]); s[5] = t_; }
            { const float w_ = wv[0]; float t_; RW_MUL(t_, w_, 6, s[6]); s[6] = t_; }
            { const float w_ = wv[0]; float t_; RW_MUL(t_, w_, 7, s[7]); s[7] = t_; }
            { const float w_ = wv[0]; float t_; RW_MUL(t_, w_, 8, s[8]); s[8] = t_; }
            { const float w_ = wv[0]; float t_; RW_MUL(t_, w_, 9, s[9]); s[9] = t_; }
            { const float w_ = wv[0]; float t_; RW_MUL(t_, w_, 10, s[10]); s[10] = t_; }
            { const float w_ = wv[0]; float t_; RW_MUL(t_, w_, 11, s[11]); s[11] = t_; }
            { const float w_ = wv[0]; float t_; RW_MUL(t_, w_, 12, s[12]); s[12] = t_; }
            { const float w_ = wv[0]; float t_; RW_MUL(t_, w_, 13, s[13]); s[13] = t_; }
            { const float w_ = wv[0]; float t_; RW_MUL(t_, w_, 14, s[14]); s[14] = t_; }
            { const float w_ = wv[0]; float t_; RW_MUL(t_, w_, 15, s[15]); s[15] = t_; }
            { const float w_ = wv[1]; float t_; RW_MUL(t_, w_, 0, s[16]); s[16] = t_; }
            { const float w_ = wv[1]; float t_; RW_MUL(t_, w_, 1, s[17]); s[17] = t_; }
            { const float w_ = wv[1]; float t_; RW_MUL(t_, w_, 2, s[18]); s[18] = t_; }
            { const float w_ = wv[1]; float t_; RW_MUL(t_, w_, 3, s[19]); s[19] = t_; }
            { const float w_ = wv[1]; float t_; RW_MUL(t_, w_, 4, s[20]); s[20] = t_; }
            { const float w_ = wv[1]; float t_; RW_MUL(t_, w_, 5, s[21]); s[21] = t_; }
            { const float w_ = wv[1]; float t_; RW_MUL(t_, w_, 6, s[22]); s[22] = t_; }
            { const float w_ = wv[1]; float t_; RW_MUL(t_, w_, 7, s[23]); s[23] = t_; }
            { const float w_ = wv[1]; float t_; RW_MUL(t_, w_, 8, s[24]); s[24] = t_; }
            { const float w_ = wv[1]; float t_; RW_MUL(t_, w_, 9, s[25]); s[25] = t_; }
            { const float w_ = wv[1]; float t_; RW_MUL(t_, w_, 10, s[26]); s[26] = t_; }
            { const float w_ = wv[1]; float t_; RW_MUL(t_, w_, 11, s[27]); s[27] = t_; }
            { const float w_ = wv[1]; float t_; RW_MUL(t_, w_, 12, s[28]); s[28] = t_; }
            { const float w_ = wv[1]; float t_; RW_MUL(t_, w_, 13, s[29]); s[29] = t_; }
            { const float w_ = wv[1]; float t_; RW_MUL(t_, w_, 14, s[30]); s[30] = t_; }
            { const float w_ = wv[1]; float t_; RW_MUL(t_, w_, 15, s[31]); s[31] = t_; }
            { const float w_ = wv[2]; float t_; RW_MUL(t_, w_, 0, s[32]); s[32] = t_; }
            { const float w_ = wv[2]; float t_; RW_MUL(t_, w_, 1, s[33]); s[33] = t_; }
            { const float w_ = wv[2]; float t_; RW_MUL(t_, w_, 2, s[34]); s[34] = t_; }
            { const float w_ = wv[2]; float t_; RW_MUL(t_, w_, 3, s[35]); s[35] = t_; }
            { const float w_ = wv[2]; float t_; RW_MUL(t_, w_, 4, s[36]); s[36] = t_; }
            { const float w_ = wv[2]; float t_; RW_MUL(t_, w_, 5, s[37]); s[37] = t_; }
            { const float w_ = wv[2]; float t_; RW_MUL(t_, w_, 6, s[38]); s[38] = t_; }
            { const float w_ = wv[2]; float t_; RW_MUL(t_, w_, 7, s[39]); s[39] = t_; }
            { const float w_ = wv[2]; float t_; RW_MUL(t_, w_, 8, s[40]); s[40] = t_; }
            { const float w_ = wv[2]; float t_; RW_MUL(t_, w_, 9, s[41]); s[41] = t_; }
            { const float w_ = wv[2]; float t_; RW_MUL(t_, w_, 10, s[42]); s[42] = t_; }
            { const float w_ = wv[2]; float t_; RW_MUL(t_, w_, 11, s[43]); s[43] = t_; }
            { const float w_ = wv[2]; float t_; RW_MUL(t_, w_, 12, s[44]); s[44] = t_; }
            { const float w_ = wv[2]; float t_; RW_MUL(t_, w_, 13, s[45]); s[45] = t_; }
            { const float w_ = wv[2]; float t_; RW_MUL(t_, w_, 14, s[46]); s[46] = t_; }
            { const float w_ = wv[2]; float t_; RW_MUL(t_, w_, 15, s[47]); s[47] = t_; }
            { const float w_ = wv[3]; float t_; RW_MUL(t_, w_, 0, s[48]); s[48] = t_; }
            { const float w_ = wv[3]; float t_; RW_MUL(t_, w_, 1, s[49]); s[49] = t_; }
            { const float w_ = wv[3]; float t_; RW_MUL(t_, w_, 2, s[50]); s[50] = t_; }
            { const float w_ = wv[3]; float t_; RW_MUL(t_, w_, 3, s[51]); s[51] = t_; }
            { const float w_ = wv[3]; float t_; RW_MUL(t_, w_, 4, s[52]); s[52] = t_; }
            { const float w_ = wv[3]; float t_; RW_MUL(t_, w_, 5, s[53]); s[53] = t_; }
            { const float w_ = wv[3]; float t_; RW_MUL(t_, w_, 6, s[54]); s[54] = t_; }
            { const float w_ = wv[3]; float t_; RW_MUL(t_, w_, 7, s[55]); s[55] = t_; }
            { const float w_ = wv[3]; float t_; RW_MUL(t_, w_, 8, s[56]); s[56] = t_; }
            { const float w_ = wv[3]; float t_; RW_MUL(t_, w_, 9, s[57]); s[57] = t_; }
            { const float w_ = wv[3]; float t_; RW_MUL(t_, w_, 10, s[58]); s[58] = t_; }
            { const float w_ = wv[3]; float t_; RW_MUL(t_, w_, 11, s[59]); s[59] = t_; }
            { const float w_ = wv[3]; float t_; RW_MUL(t_, w_, 12, s[60]); s[60] = t_; }
            { const float w_ = wv[3]; float t_; RW_MUL(t_, w_, 13, s[61]); s[61] = t_; }
            { const float w_ = wv[3]; float t_; RW_MUL(t_, w_, 14, s[62]); s[62] = t_; }
            { const float w_ = wv[3]; float t_; RW_MUL(t_, w_, 15, s[63]); s[63] = t_; }
            { const float b_ = bv[0]; RW_FMAC(s[0], b_, 0, sa); }
            { const float b_ = bv[0]; RW_FMAC(s[1], b_, 1, sa); }
            { const float b_ = bv[0]; RW_FMAC(s[2], b_, 2, sa); }
            { const float b_ = bv[0]; RW_FMAC(s[3], b_, 3, sa); }
            { const float b_ = bv[0]; RW_FMAC(s[4], b_, 4, sa); }
            { const float b_ = bv[0]; RW_FMAC(s[5], b_, 5, sa); }
            { const float b_ = bv[0]; RW_FMAC(s[6], b_, 6, sa); }
            { const float b_ = bv[0]; RW_FMAC(s[7], b_, 7, sa); }
            { const float b_ = bv[0]; RW_FMAC(s[8], b_, 8, sa); }
            { const float b_ = bv[0]; RW_FMAC(s[9], b_, 9, sa); }
            { const float b_ = bv[0]; RW_FMAC(s[10], b_, 10, sa); }
            { const float b_ = bv[0]; RW_FMAC(s[11], b_, 11, sa); }
            { const float b_ = bv[0]; RW_FMAC(s[12], b_, 12, sa); }
            { const float b_ = bv[0]; RW_FMAC(s[13], b_, 13, sa); }
            { const float b_ = bv[0]; RW_FMAC(s[14], b_, 14, sa); }
            { const float b_ = bv[0]; RW_FMAC(s[15], b_, 15, sa); }
            { const float b_ = bv[1]; RW_FMAC(s[16], b_, 0, sa); }
            { const float b_ = bv[1]; RW_FMAC(s[17], b_, 1, sa); }
            { const float b_ = bv[1]; RW_FMAC(s[18], b_, 2, sa); }
            { const float b_ = bv[1]; RW_FMAC(s[19], b_, 3, sa); }
            { const float b_ = bv[1]; RW_FMAC(s[20], b_, 4, sa); }
            { const float b_ = bv[1]; RW_FMAC(s[21], b_, 5, sa); }
            { const float b_ = bv[1]; RW_FMAC(s[22], b_, 6, sa); }
            { const float b_ = bv[1]; RW_FMAC(s[23], b_, 7, sa); }
            { const float b_ = bv[1]; RW_FMAC(s[24], b_, 8, sa); }
            { const float b_ = bv[1]; RW_FMAC(s[25], b_, 9, sa); }
            { const float b_ = bv[1]; RW_FMAC(s[26], b_, 10, sa); }
            { const float b_ = bv[1]; RW_FMAC(s[27], b_, 11, sa); }
            { const float b_ = bv[1]; RW_FMAC(s[28], b_, 12, sa); }
            { const float b_ = bv[1]; RW_FMAC(s[29], b_, 13, sa); }
            { const float b_ = bv[1]; RW_FMAC(s[30], b_, 14, sa); }
            { const float b_ = bv[1]; RW_FMAC(s[31], b_, 15, sa); }
            { const float b_ = bv[2]; RW_FMAC(s[32], b_, 0, sa); }
            { const float b_ = bv[2]; RW_FMAC(s[33], b_, 1, sa); }
            { const float b_ = bv[2]; RW_FMAC(s[34], b_, 2, sa); }
            { const float b_ = bv[2]; RW_FMAC(s[35], b_, 3, sa); }
            { const float b_ = bv[2]; RW_FMAC(s[36], b_, 4, sa); }
            { const float b_ = bv[2]; RW_FMAC(s[37], b_, 5, sa); }
            { const float b_ = bv[2]; RW_FMAC(s[38], b_, 6, sa); }
            { const float b_ = bv[2]; RW_FMAC(s[39], b_, 7, sa); }
            { const float b_ = bv[2]; RW_FMAC(s[40], b_, 8, sa); }
            { const float b_ = bv[2]; RW_FMAC(s[41], b_, 9, sa); }
            { const float b_ = bv[2]; RW_FMAC(s[42], b_, 10, sa); }
            { const float b_ = bv[2]; RW_FMAC(s[43], b_, 11, sa); }
            { const float b_ = bv[2]; RW_FMAC(s[44], b_, 12, sa); }
            { const float b_ = bv[2]; RW_FMAC(s[45], b_, 13, sa); }
            { const float b_ = bv[2]; RW_FMAC(s[46], b_, 14, sa); }
            { const float b_ = bv[2]; RW_FMAC(s[47], b_, 15, sa); }
            { const float b_ = bv[3]; RW_FMAC(s[48], b_, 0, sa); }
            { const float b_ = bv[3]; RW_FMAC(s[49], b_, 1, sa); }
            { const float b_ = bv[3]; RW_FMAC(s[50], b_, 2, sa); }
            { const float b_ = bv[3]; RW_FMAC(s[51], b_, 3, sa); }
            { const float b_ = bv[3]; RW_FMAC(s[52], b_, 4, sa); }
            { const float b_ = bv[3]; RW_FMAC(s[53], b_, 5, sa); }
            { const float b_ = bv[3]; RW_FMAC(s[54], b_, 6, sa); }
            { const float b_ = bv[3]; RW_FMAC(s[55], b_, 7, sa); }
            { const float b_ = bv[3]; RW_FMAC(s[56], b_, 8, sa); }
            { const float b_ = bv[3]; RW_FMAC(s[57], b_, 9, sa); }
            { const float b_ = bv[3]; RW_FMAC(s[58], b_, 10, sa); }
            { const float b_ = bv[3]; RW_FMAC(s[59], b_, 11, sa); }
            { const float b_ = bv[3]; RW_FMAC(s[60], b_, 12, sa); }
            { const float b_ = bv[3]; RW_FMAC(s[61], b_, 13, sa); }
            { const float b_ = bv[3]; RW_FMAC(s[62], b_, 14, sa); }
            { const float b_ = bv[3]; RW_FMAC(s[63], b_, 15, sa); }
            { const float k_ = kv[0]; RW_FMAC(s[0], k_, 0, vv); }
            { const float k_ = kv[0]; RW_FMAC(s[1], k_, 1, vv); }
            { const float k_ = kv[0]; RW_FMAC(s[2], k_, 2, vv); }
            { const float k_ = kv[0]; RW_FMAC(s[3], k_, 3, vv); }
            { const float k_ = kv[0]; RW_FMAC(s[4], k_, 4, vv); }
            { const float k_ = kv[0]; RW_FMAC(s[5], k_, 5, vv); }
            { const float k_ = kv[0]; RW_FMAC(s[6], k_, 6, vv); }
            { const float k_ = kv[0]; RW_FMAC(s[7], k_, 7, vv); }
            { const float k_ = kv[0]; RW_FMAC(s[8], k_, 8, vv); }
            { const float k_ = kv[0]; RW_FMAC(s[9], k_, 9, vv); }
            { const float k_ = kv[0]; RW_FMAC(s[10], k_, 10, vv); }
            { const float k_ = kv[0]; RW_FMAC(s[11], k_, 11, vv); }
            { const float k_ = kv[0]; RW_FMAC(s[12], k_, 12, vv); }
            { const float k_ = kv[0]; RW_FMAC(s[13], k_, 13, vv); }
            { const float k_ = kv[0]; RW_FMAC(s[14], k_, 14, vv); }
            { const float k_ = kv[0]; RW_FMAC(s[15], k_, 15, vv); }
            { const float k_ = kv[1]; RW_FMAC(s[16], k_, 0, vv); }
            { const float k_ = kv[1]; RW_FMAC(s[17], k_, 1, vv); }
            { const float k_ = kv[1]; RW_FMAC(s[18], k_, 2, vv); }
            { const float k_ = kv[1]; RW_FMAC(s[19], k_, 3, vv); }
            { const float k_ = kv[1]; RW_FMAC(s[20], k_, 4, vv); }
            { const float k_ = kv[1]; RW_FMAC(s[21], k_, 5, vv); }
            { const float k_ = kv[1]; RW_FMAC(s[22], k_, 6, vv); }
            { const float k_ = kv[1]; RW_FMAC(s[23], k_, 7, vv); }
            { const float k_ = kv[1]; RW_FMAC(s[24], k_, 8, vv); }
            { const float k_ = kv[1]; RW_FMAC(s[25], k_, 9, vv); }
            { const float k_ = kv[1]; RW_FMAC(s[26], k_, 10, vv); }
            { const float k_ = kv[1]; RW_FMAC(s[27], k_, 11, vv); }
            { const float k_ = kv[1]; RW_FMAC(s[28], k_, 12, vv); }
            { const float k_ = kv[1]; RW_FMAC(s[29], k_, 13, vv); }
            { const float k_ = kv[1]; RW_FMAC(s[30], k_, 14, vv); }
            { const float k_ = kv[1]; RW_FMAC(s[31], k_, 15, vv); }
            { const float k_ = kv[2]; RW_FMAC(s[32], k_, 0, vv); }
            { const float k_ = kv[2]; RW_FMAC(s[33], k_, 1, vv); }
            { const float k_ = kv[2]; RW_FMAC(s[34], k_, 2, vv); }
            { const float k_ = kv[2]; RW_FMAC(s[35], k_, 3, vv); }
            { const float k_ = kv[2]; RW_FMAC(s[36], k_, 4, vv); }
            { const float k_ = kv[2]; RW_FMAC(s[37], k_, 5, vv); }
            { const float k_ = kv[2]; RW_FMAC(s[38], k_, 6, vv); }
            { const float k_ = kv[2]; RW_FMAC(s[39], k_, 7, vv); }
            { const float k_ = kv[2]; RW_FMAC(s[40], k_, 8, vv); }
            { const float k_ = kv[2]; RW_FMAC(s[41], k_, 9, vv); }
            { const float k_ = kv[2]; RW_FMAC(s[42], k_, 10, vv); }
            { const float k_ = kv[2]; RW_FMAC(s[43], k_, 11, vv); }
            { const float k_ = kv[2]; RW_FMAC(s[44], k_, 12, vv); }
            { const float k_ = kv[2]; RW_FMAC(s[45], k_, 13, vv); }
            { const float k_ = kv[2]; RW_FMAC(s[46], k_, 14, vv); }
            { const float k_ = kv[2]; RW_FMAC(s[47], k_, 15, vv); }
            { const float k_ = kv[3]; RW_FMAC(s[48], k_, 0, vv); }
            { const float k_ = kv[3]; RW_FMAC(s[49], k_, 1, vv); }
            { const float k_ = kv[3]; RW_FMAC(s[50], k_, 2, vv); }
            { const float k_ = kv[3]; RW_FMAC(s[51], k_, 3, vv); }
            { const float k_ = kv[3]; RW_FMAC(s[52], k_, 4, vv); }
            { const float k_ = kv[3]; RW_FMAC(s[53], k_, 5, vv); }
            { const float k_ = kv[3]; RW_FMAC(s[54], k_, 6, vv); }
            { const float k_ = kv[3]; RW_FMAC(s[55], k_, 7, vv); }
            { const float k_ = kv[3]; RW_FMAC(s[56], k_, 8, vv); }
            { const float k_ = kv[3]; RW_FMAC(s[57], k_, 9, vv); }
            { const float k_ = kv[3]; RW_FMAC(s[58], k_, 10, vv); }
            { const float k_ = kv[3]; RW_FMAC(s[59], k_, 11, vv); }
            { const float k_ = kv[3]; RW_FMAC(s[60], k_, 12, vv); }
            { const float k_ = kv[3]; RW_FMAC(s[61], k_, 13, vv); }
            { const float k_ = kv[3]; RW_FMAC(s[62], k_, 14, vv); }
            { const float k_ = kv[3]; RW_FMAC(s[63], k_, 15, vv); }
            float y0 = 0.f, y1 = 0.f, y2 = 0.f, y3 = 0.f, y4 = 0.f, y5 = 0.f, y6 = 0.f, y7 = 0.f;
            { const float a_ = rv[0]; RW_FMAC(y0, a_, 0, s[0]); }
            { const float a_ = rv[0]; RW_FMAC(y1, a_, 1, s[1]); }
            { const float a_ = rv[0]; RW_FMAC(y2, a_, 2, s[2]); }
            { const float a_ = rv[0]; RW_FMAC(y3, a_, 3, s[3]); }
            { const float a_ = rv[0]; RW_FMAC(y4, a_, 4, s[4]); }
            { const float a_ = rv[0]; RW_FMAC(y5, a_, 5, s[5]); }
            { const float a_ = rv[0]; RW_FMAC(y6, a_, 6, s[6]); }
            { const float a_ = rv[0]; RW_FMAC(y7, a_, 7, s[7]); }
            { const float a_ = rv[0]; RW_FMAC(y0, a_, 8, s[8]); }
            { const float a_ = rv[0]; RW_FMAC(y1, a_, 9, s[9]); }
            { const float a_ = rv[0]; RW_FMAC(y2, a_, 10, s[10]); }
            { const float a_ = rv[0]; RW_FMAC(y3, a_, 11, s[11]); }
            { const float a_ = rv[0]; RW_FMAC(y4, a_, 12, s[12]); }
            { const float a_ = rv[0]; RW_FMAC(y5, a_, 13, s[13]); }
            { const float a_ = rv[0]; RW_FMAC(y6, a_, 14, s[14]); }
            { const float a_ = rv[0]; RW_FMAC(y7, a_, 15, s[15]); }
            { const float a_ = rv[1]; RW_FMAC(y0, a_, 0, s[16]); }
            { const float a_ = rv[1]; RW_FMAC(y1, a_, 1, s[17]); }
            { const float a_ = rv[1]; RW_FMAC(y2, a_, 2, s[18]); }
            { const float a_ = rv[1]; RW_FMAC(y3, a_, 3, s[19]); }
            { const float a_ = rv[1]; RW_FMAC(y4, a_, 4, s[20]); }
            { const float a_ = rv[1]; RW_FMAC(y5, a_, 5, s[21]); }
            { const float a_ = rv[1]; RW_FMAC(y6, a_, 6, s[22]); }
            { const float a_ = rv[1]; RW_FMAC(y7, a_, 7, s[23]); }
            { const float a_ = rv[1]; RW_FMAC(y0, a_, 8, s[24]); }
            { const float a_ = rv[1]; RW_FMAC(y1, a_, 9, s[25]); }
            { const float a_ = rv[1]; RW_FMAC(y2, a_, 10, s[26]); }
            { const float a_ = rv[1]; RW_FMAC(y3, a_, 11, s[27]); }
            { const float a_ = rv[1]; RW_FMAC(y4, a_, 12, s[28]); }
            { const float a_ = rv[1]; RW_FMAC(y5, a_, 13, s[29]); }
            { const float a_ = rv[1]; RW_FMAC(y6, a_, 14, s[30]); }
            { const float a_ = rv[1]; RW_FMAC(y7, a_, 15, s[31]); }
            { const float a_ = rv[2]; RW_FMAC(y0, a_, 0, s[32]); }
            { const float a_ = rv[2]; RW_FMAC(y1, a_, 1, s[33]); }
            { const float a_ = rv[2]; RW_FMAC(y2, a_, 2, s[34]); }
            { const float a_ = rv[2]; RW_FMAC(y3, a_, 3, s[35]); }
            { const float a_ = rv[2]; RW_FMAC(y4, a_, 4, s[36]); }
            { const float a_ = rv[2]; RW_FMAC(y5, a_, 5, s[37]); }
            { const float a_ = rv[2]; RW_FMAC(y6, a_, 6, s[38]); }
            { const float a_ = rv[2]; RW_FMAC(y7, a_, 7, s[39]); }
            { const float a_ = rv[2]; RW_FMAC(y0, a_, 8, s[40]); }
            { const float a_ = rv[2]; RW_FMAC(y1, a_, 9, s[41]); }
            { const float a_ = rv[2]; RW_FMAC(y2, a_, 10, s[42]); }
            { const float a_ = rv[2]; RW_FMAC(y3, a_, 11, s[43]); }
            { const float a_ = rv[2]; RW_FMAC(y4, a_, 12, s[44]); }
            { const float a_ = rv[2]; RW_FMAC(y5, a_, 13, s[45]); }
            { const float a_ = rv[2]; RW_FMAC(y6, a_, 14, s[46]); }
            { const float a_ = rv[2]; RW_FMAC(y7, a_, 15, s[47]); }
            { const float a_ = rv[3]; RW_FMAC(y0, a_, 0, s[48]); }
            { const float a_ = rv[3]; RW_FMAC(y1, a_, 1, s[49]); }
            { const float a_ = rv[3]; RW_FMAC(y2, a_, 2, s[50]); }
            { const float a_ = rv[3]; RW_FMAC(y3, a_, 3, s[51]); }
            { const float a_ = rv[3]; RW_FMAC(y4, a_, 4, s[52]); }
            { const float a_ = rv[3]; RW_FMAC(y5, a_, 5, s[53]); }
            { const float a_ = rv[3]; RW_FMAC(y6, a_, 6, s[54]); }
            { const float a_ = rv[3]; RW_FMAC(y7, a_, 7, s[55]); }
            { const float a_ = rv[3]; RW_FMAC(y0, a_, 8, s[56]); }
            { const float a_ = rv[3]; RW_FMAC(y1, a_, 9, s[57]); }
            { const float a_ = rv[3]; RW_FMAC(y2, a_, 10, s[58]); }
            { const float a_ = rv[3]; RW_FMAC(y3, a_, 11, s[59]); }
            { const float a_ = rv[3]; RW_FMAC(y4, a_, 12, s[60]); }
            { const float a_ = rv[3]; RW_FMAC(y5, a_, 13, s[61]); }
            { const float a_ = rv[3]; RW_FMAC(y6, a_, 14, s[62]); }
            { const float a_ = rv[3]; RW_FMAC(y7, a_, 15, s[63]); }
            yo[i * 64] = ((y0 + y1) + (y2 + y3)) + ((y4 + y5) + (y6 + y7));
            wv = wn; av = an; bv = bn; kv = kn; rv = rnv; vv = vn;
        }
    } else {
#pragma unroll 1
        for (int i = 0; i < 64; ++i) {
            row += rstep; const int rn = i < 63 ? row : row - rstep;
            const f32x4 wn = *(const f32x4*)(lb + ((size_t)rn * 11 + 5 + d) * 256), an = *(const f32x4*)(lb + ((size_t)rn * 11 + 2) * 256);
            const f32x4 bn = *(const f32x4*)(lb + ((size_t)rn * 11 + 9 + d) * 256), rnv = *(const f32x4*)(lb + ((size_t)rn * 11 + 0) * 256);
            float sa0 = 0.f, sa1 = 0.f, sa2 = 0.f, sa3 = 0.f, sa4 = 0.f, sa5 = 0.f, sa6 = 0.f, sa7 = 0.f;
            RW_HAZ();
            { const float a_ = av[0]; RW_FMAC(sa0, a_, 0, s[0]); }
            { const float a_ = av[0]; RW_FMAC(sa1, a_, 1, s[1]); }
            { const float a_ = av[0]; RW_FMAC(sa2, a_, 2, s[2]); }
            { const float a_ = av[0]; RW_FMAC(sa3, a_, 3, s[3]); }
            { const float a_ = av[0]; RW_FMAC(sa4, a_, 4, s[4]); }
            { const float a_ = av[0]; RW_FMAC(sa5, a_, 5, s[5]); }
            { const float a_ = av[0]; RW_FMAC(sa6, a_, 6, s[6]); }
            { const float a_ = av[0]; RW_FMAC(sa7, a_, 7, s[7]); }
            { const float a_ = av[0]; RW_FMAC(sa0, a_, 8, s[8]); }
            { const float a_ = av[0]; RW_FMAC(sa1, a_, 9, s[9]); }
            { const float a_ = av[0]; RW_FMAC(sa2, a_, 10, s[10]); }
            { const float a_ = av[0]; RW_FMAC(sa3, a_, 11, s[11]); }
            { const float a_ = av[0]; RW_FMAC(sa4, a_, 12, s[12]); }
            { const float a_ = av[0]; RW_FMAC(sa5, a_, 13, s[13]); }
            { const float a_ = av[0]; RW_FMAC(sa6, a_, 14, s[14]); }
            { const float a_ = av[0]; RW_FMAC(sa7, a_, 15, s[15]); }
            { const float a_ = av[1]; RW_FMAC(sa0, a_, 0, s[16]); }
            { const float a_ = av[1]; RW_FMAC(sa1, a_, 1, s[17]); }
            { const float a_ = av[1]; RW_FMAC(sa2, a_, 2, s[18]); }
            { const float a_ = av[1]; RW_FMAC(sa3, a_, 3, s[19]); }
            { const float a_ = av[1]; RW_FMAC(sa4, a_, 4, s[20]); }
            { const float a_ = av[1]; RW_FMAC(sa5, a_, 5, s[21]); }
            { const float a_ = av[1]; RW_FMAC(sa6, a_, 6, s[22]); }
            { const float a_ = av[1]; RW_FMAC(sa7, a_, 7, s[23]); }
            { const float a_ = av[1]; RW_FMAC(sa0, a_, 8, s[24]); }
            { const float a_ = av[1]; RW_FMAC(sa1, a_, 9, s[25]); }
            { const float a_ = av[1]; RW_FMAC(sa2, a_, 10, s[26]); }
            { const float a_ = av[1]; RW_FMAC(sa3, a_, 11, s[27]); }
            { const float a_ = av[1]; RW_FMAC(sa4, a_, 12, s[28]); }
            { const float a_ = av[1]; RW_FMAC(sa5, a_, 13, s[29]); }
            { const float a_ = av[1]; RW_FMAC(sa6, a_, 14, s[30]); }
            { const float a_ = av[1]; RW_FMAC(sa7, a_, 15, s[31]); }
            { const float a_ = av[2]; RW_FMAC(sa0, a_, 0, s[32]); }
            { const float a_ = av[2]; RW_FMAC(sa1, a_, 1, s[33]); }
            { const float a_ = av[2]; RW_FMAC(sa2, a_, 2, s[34]); }
            { const float a_ = av[2]; RW_FMAC(sa3, a_, 3, s[35]); }
            { const float a_ = av[2]; RW_FMAC(sa4, a_, 4, s[36]); }
            { const float a_ = av[2]; RW_FMAC(sa5, a_, 5, s[37]); }
            { const float a_ = av[2]; RW_FMAC(sa6, a_, 6, s[38]); }
            { const float a_ = av[2]; RW_FMAC(sa7, a_, 7, s[39]); }
            { const float a_ = av[2]; RW_FMAC(sa0, a_, 8, s[40]); }
            { const float a_ = av[2]; RW_FMAC(sa1, a_, 9, s[41]); }
            { const float a_ = av[2]; RW_FMAC(sa2, a_, 10, s[42]); }
            { const float a_ = av[2]; RW_FMAC(sa3, a_, 11, s[43]); }
            { const float a_ = av[2]; RW_FMAC(sa4, a_, 12, s[44]); }
            { const float a_ = av[2]; RW_FMAC(sa5, a_, 13, s[45]); }
            { const float a_ = av[2]; RW_FMAC(sa6, a_, 14, s[46]); }
            { const float a_ = av[2]; RW_FMAC(sa7, a_, 15, s[47]); }
            { const float a_ = av[3]; RW_FMAC(sa0, a_, 0, s[48]); }
            { const float a_ = av[3]; RW_FMAC(sa1, a_, 1, s[49]); }
            { const float a_ = av[3]; RW_FMAC(sa2, a_, 2, s[50]); }
            { const float a_ = av[3]; RW_FMAC(sa3, a_, 3, s[51]); }
            { const float a_ = av[3]; RW_FMAC(sa4, a_, 4, s[52]); }
            { const float a_ = av[3]; RW_FMAC(sa5, a_, 5, s[53]); }
            { const float a_ = av[3]; RW_FMAC(sa6, a_, 6, s[54]); }
            { const float a_ = av[3]; RW_FMAC(sa7, a_, 7, s[55]); }
            { const float a_ = av[3]; RW_FMAC(sa0, a_, 8, s[56]); }
            { const float a_ = av[3]; RW_FMAC(sa1, a_, 9, s[57]); }
            { const float a_ = av[3]; RW_FMAC(sa2, a_, 10, s[58]); }
            { const float a_ = av[3]; RW_FMAC(sa3, a_, 11, s[59]); }
            { const float a_ = av[3]; RW_FMAC(sa4, a_, 12, s[60]); }
            { const float a_ = av[3]; RW_FMAC(sa5, a_, 13, s[61]); }
            { const float a_ = av[3]; RW_FMAC(sa6, a_, 14, s[62]); }
            { const float a_ = av[3]; RW_FMAC(sa7, a_, 15, s[63]); }
            const float sa = -(((sa0 + sa1) + (sa2 + sa3)) + ((sa4 + sa5) + (sa6 + sa7)));
            { const float w_ = wv[0]; float t_; RW_MUL(t_, w_, 0, s[0]); s[0] = t_; }
            { const float w_ = wv[0]; float t_; RW_MUL(t_, w_, 1, s[1]); s[1] = t_; }
            { const float w_ = wv[0]; float t_; RW_MUL(t_, w_, 2, s[2]); s[2] = t_; }
            { const float w_ = wv[0]; float t_; RW_MUL(t_, w_, 3, s[3]); s[3] = t_; }
            { const float w_ = wv[0]; float t_; RW_MUL(t_, w_, 4, s[4]); s[4] = t_; }
            { const float w_ = wv[0]; float t_; RW_MUL(t_, w_, 5, s[5]); s[5] = t_; }
            { const float w_ = wv[0]; float t_; RW_MUL(t_, w_, 6, s[6]); s[6] = t_; }
            { const float w_ = wv[0]; float t_; RW_MUL(t_, w_, 7, s[7]); s[7] = t_; }
            { const float w_ = wv[0]; float t_; RW_MUL(t_, w_, 8, s[8]); s[8] = t_; }
            { const float w_ = wv[0]; float t_; RW_MUL(t_, w_, 9, s[9]); s[9] = t_; }
            { const float w_ = wv[0]; float t_; RW_MUL(t_, w_, 10, s[10]); s[10] = t_; }
            { const float w_ = wv[0]; float t_; RW_MUL(t_, w_, 11, s[11]); s[11] = t_; }
            { const float w_ = wv[0]; float t_; RW_MUL(t_, w_, 12, s[12]); s[12] = t_; }
            { const float w_ = wv[0]; float t_; RW_MUL(t_, w_, 13, s[13]); s[13] = t_; }
            { const float w_ = wv[0]; float t_; RW_MUL(t_, w_, 14, s[14]); s[14] = t_; }
            { const float w_ = wv[0]; float t_; RW_MUL(t_, w_, 15, s[15]); s[15] = t_; }
            { const float w_ = wv[1]; float t_; RW_MUL(t_, w_, 0, s[16]); s[16] = t_; }
            { const float w_ = wv[1]; float t_; RW_MUL(t_, w_, 1, s[17]); s[17] = t_; }
            { const float w_ = wv[1]; float t_; RW_MUL(t_, w_, 2, s[18]); s[18] = t_; }
            { const float w_ = wv[1]; float t_; RW_MUL(t_, w_, 3, s[19]); s[19] = t_; }
            { const float w_ = wv[1]; float t_; RW_MUL(t_, w_, 4, s[20]); s[20] = t_; }
            { const float w_ = wv[1]; float t_; RW_MUL(t_, w_, 5, s[21]); s[21] = t_; }
            { const float w_ = wv[1]; float t_; RW_MUL(t_, w_, 6, s[22]); s[22] = t_; }
            { const float w_ = wv[1]; float t_; RW_MUL(t_, w_, 7, s[23]); s[23] = t_; }
            { const float w_ = wv[1]; float t_; RW_MUL(t_, w_, 8, s[24]); s[24] = t_; }
            { const float w_ = wv[1]; float t_; RW_MUL(t_, w_, 9, s[25]); s[25] = t_; }
            { const float w_ = wv[1]; float t_; RW_MUL(t_, w_, 10, s[26]); s[26] = t_; }
            { const float w_ = wv[1]; float t_; RW_MUL(t_, w_, 11, s[27]); s[27] = t_; }
            { const float w_ = wv[1]; float t_; RW_MUL(t_, w_, 12, s[28]); s[28] = t_; }
            { const float w_ = wv[1]; float t_; RW_MUL(t_, w_, 13, s[29]); s[29] = t_; }
            { const float w_ = wv[1]; float t_; RW_MUL(t_, w_, 14, s[30]); s[30] = t_; }
            { const float w_ = wv[1]; float t_; RW_MUL(t_, w_, 15, s[31]); s[31] = t_; }
            { const float w_ = wv[2]; float t_; RW_MUL(t_, w_, 0, s[32]); s[32] = t_; }
            { const float w_ = wv[2]; float t_; RW_MUL(t_, w_, 1, s[33]); s[33] = t_; }
            { const float w_ = wv[2]; float t_; RW_MUL(t_, w_, 2, s[34]); s[34] = t_; }
            { const float w_ = wv[2]; float t_; RW_MUL(t_, w_, 3, s[35]); s[35] = t_; }
            { const float w_ = wv[2]; float t_; RW_MUL(t_, w_, 4, s[36]); s[36] = t_; }
            { const float w_ = wv[2]; float t_; RW_MUL(t_, w_, 5, s[37]); s[37] = t_; }
            { const float w_ = wv[2]; float t_; RW_MUL(t_, w_, 6, s[38]); s[38] = t_; }
            { const float w_ = wv[2]; float t_; RW_MUL(t_, w_, 7, s[39]); s[39] = t_; }
            { const float w_ = wv[2]; float t_; RW_MUL(t_, w_, 8, s[40]); s[40] = t_; }
            { const float w_ = wv[2]; float t_; RW_MUL(t_, w_, 9, s[41]); s[41] = t_; }
            { const float w_ = wv[2]; float t_; RW_MUL(t_, w_, 10, s[42]); s[42] = t_; }
            { const float w_ = wv[2]; float t_; RW_MUL(t_, w_, 11, s[43]); s[43] = t_; }
            { const float w_ = wv[2]; float t_; RW_MUL(t_, w_, 12, s[44]); s[44] = t_; }
            { const float w_ = wv[2]; float t_; RW_MUL(t_, w_, 13, s[45]); s[45] = t_; }
            { const float w_ = wv[2]; float t_; RW_MUL(t_, w_, 14, s[46]); s[46] = t_; }
            { const float w_ = wv[2]; float t_; RW_MUL(t_, w_, 15, s[47]); s[47] = t_; }
            { const float w_ = wv[3]; float t_; RW_MUL(t_, w_, 0, s[48]); s[48] = t_; }
            { const float w_ = wv[3]; float t_; RW_MUL(t_, w_, 1, s[49]); s[49] = t_; }
            { const float w_ = wv[3]; float t_; RW_MUL(t_, w_, 2, s[50]); s[50] = t_; }
            { const float w_ = wv[3]; float t_; RW_MUL(t_, w_, 3, s[51]); s[51] = t_; }
            { const float w_ = wv[3]; float t_; RW_MUL(t_, w_, 4, s[52]); s[52] = t_; }
            { const float w_ = wv[3]; float t_; RW_MUL(t_, w_, 5, s[53]); s[53] = t_; }
            { const float w_ = wv[3]; float t_; RW_MUL(t_, w_, 6, s[54]); s[54] = t_; }
            { const float w_ = wv[3]; float t_; RW_MUL(t_, w_, 7, s[55]); s[55] = t_; }
            { const float w_ = wv[3]; float t_; RW_MUL(t_, w_, 8, s[56]); s[56] = t_; }
            { const float w_ = wv[3]; float t_; RW_MUL(t_, w_, 9, s[57]); s[57] = t_; }
            { const float w_ = wv[3]; float t_; RW_MUL(t_, w_, 10, s[58]); s[58] = t_; }
            { const float w_ = wv[3]; float t_; RW_MUL(t_, w_, 11, s[59]); s[59] = t_; }
            { const float w_ = wv[3]; float t_; RW_MUL(t_, w_, 12, s[60]); s[60] = t_; }
            { const float w_ = wv[3]; float t_; RW_MUL(t_, w_, 13, s[61]); s[61] = t_; }
            { const float w_ = wv[3]; float t_; RW_MUL(t_, w_, 14, s[62]); s[62] = t_; }
            { const float w_ = wv[3]; float t_; RW_MUL(t_, w_, 15, s[63]); s[63] = t_; }
            { const float b_ = bv[0]; RW_FMAC(s[0], b_, 0, sa); }
            { const float b_ = bv[0]; RW_FMAC(s[1], b_, 1, sa); }
            { const float b_ = bv[0]; RW_FMAC(s[2], b_, 2, sa); }
            { const float b_ = bv[0]; RW_FMAC(s[3], b_, 3, sa); }
            { const float b_ = bv[0]; RW_FMAC(s[4], b_, 4, sa); }
            { const float b_ = bv[0]; RW_FMAC(s[5], b_, 5, sa); }
            { const float b_ = bv[0]; RW_FMAC(s[6], b_, 6, sa); }
            { const float b_ = bv[0]; RW_FMAC(s[7], b_, 7, sa); }
            { const float b_ = bv[0]; RW_FMAC(s[8], b_, 8, sa); }
            { const float b_ = bv[0]; RW_FMAC(s[9], b_, 9, sa); }
            { const float b_ = bv[0]; RW_FMAC(s[10], b_, 10, sa); }
            { const float b_ = bv[0]; RW_FMAC(s[11], b_, 11, sa); }
            { const float b_ = bv[0]; RW_FMAC(s[12], b_, 12, sa); }
            { const float b_ = bv[0]; RW_FMAC(s[13], b_, 13, sa); }
            { const float b_ = bv[0]; RW_FMAC(s[14], b_, 14, sa); }
            { const float b_ = bv[0]; RW_FMAC(s[15], b_, 15, sa); }
            { const float b_ = bv[1]; RW_FMAC(s[16], b_, 0, sa); }
            { const float b_ = bv[1]; RW_FMAC(s[17], b_, 1, sa); }
            { const float b_ = bv[1]; RW_FMAC(s[18], b_, 2, sa); }
            { const float b_ = bv[1]; RW_FMAC(s[19], b_, 3, sa); }
            { const float b_ = bv[1]; RW_FMAC(s[20], b_, 4, sa); }
            { const float b_ = bv[1]; RW_FMAC(s[21], b_, 5, sa); }
            { const float b_ = bv[1]; RW_FMAC(s[22], b_, 6, sa); }
            { const float b_ = bv[1]; RW_FMAC(s[23], b_, 7, sa); }
            { const float b_ = bv[1]; RW_FMAC(s[24], b_, 8, sa); }
            { const float b_ = bv[1]; RW_FMAC(s[25], b_, 9, sa); }
            { const float b_ = bv[1]; RW_FMAC(s[26], b_, 10, sa); }
            { const float b_ = bv[1]; RW_FMAC(s[27], b_, 11, sa); }
            { const float b_ = bv[1]; RW_FMAC(s[28], b_, 12, sa); }
            { const float b_ = bv[1]; RW_FMAC(s[29], b_, 13, sa); }
            { const float b_ = bv[1]; RW_FMAC(s[30], b_, 14, sa); }
            { const float b_ = bv[1]; RW_FMAC(s[31], b_, 15, sa); }
            { const float b_ = bv[2]; RW_FMAC(s[32], b_, 0, sa); }
            { const float b_ = bv[2]; RW_FMAC(s[33], b_, 1, sa); }
            { const float b_ = bv[2]; RW_FMAC(s[34], b_, 2, sa); }
            { const float b_ = bv[2]; RW_FMAC(s[35], b_, 3, sa); }
            { const float b_ = bv[2]; RW_FMAC(s[36], b_, 4, sa); }
            { const float b_ = bv[2]; RW_FMAC(s[37], b_, 5, sa); }
            { const float b_ = bv[2]; RW_FMAC(s[38], b_, 6, sa); }
            { const float b_ = bv[2]; RW_FMAC(s[39], b_, 7, sa); }
            { const float b_ = bv[2]; RW_FMAC(s[40], b_, 8, sa); }
            { const float b_ = bv[2]; RW_FMAC(s[41], b_, 9, sa); }
            { const float b_ = bv[2]; RW_FMAC(s[42], b_, 10, sa); }
            { const float b_ = bv[2]; RW_FMAC(s[43], b_, 11, sa); }
            { const float b_ = bv[2]; RW_FMAC(s[44], b_, 12, sa); }
            { const float b_ = bv[2]; RW_FMAC(s[45], b_, 13, sa); }
            { const float b_ = bv[2]; RW_FMAC(s[46], b_, 14, sa); }
            { const float b_ = bv[2]; RW_FMAC(s[47], b_, 15, sa); }
            { const float b_ = bv[3]; RW_FMAC(s[48], b_, 0, sa); }
            { const float b_ = bv[3]; RW_FMAC(s[49], b_, 1, sa); }
            { const float b_ = bv[3]; RW_FMAC(s[50], b_, 2, sa); }
            { const float b_ = bv[3]; RW_FMAC(s[51], b_, 3, sa); }
            { const float b_ = bv[3]; RW_FMAC(s[52], b_, 4, sa); }
            { const float b_ = bv[3]; RW_FMAC(s[53], b_, 5, sa); }
            { const float b_ = bv[3]; RW_FMAC(s[54], b_, 6, sa); }
            { const float b_ = bv[3]; RW_FMAC(s[55], b_, 7, sa); }
            { const float b_ = bv[3]; RW_FMAC(s[56], b_, 8, sa); }
            { const float b_ = bv[3]; RW_FMAC(s[57], b_, 9, sa); }
            { const float b_ = bv[3]; RW_FMAC(s[58], b_, 10, sa); }
            { const float b_ = bv[3]; RW_FMAC(s[59], b_, 11, sa); }
            { const float b_ = bv[3]; RW_FMAC(s[60], b_, 12, sa); }
            { const float b_ = bv[3]; RW_FMAC(s[61], b_, 13, sa); }
            { const float b_ = bv[3]; RW_FMAC(s[62], b_, 14, sa); }
            { const float b_ = bv[3]; RW_FMAC(s[63], b_, 15, sa); }
            float y0 = 0.f, y1 = 0.f, y2 = 0.f, y3 = 0.f, y4 = 0.f, y5 = 0.f, y6 = 0.f, y7 = 0.f;
            { const float a_ = rv[0]; RW_FMAC(y0, a_, 0, s[0]); }
            { const float a_ = rv[0]; RW_FMAC(y1, a_, 1, s[1]); }
            { const float a_ = rv[0]; RW_FMAC(y2, a_, 2, s[2]); }
            { const float a_ = rv[0]; RW_FMAC(y3, a_, 3, s[3]); }
            { const float a_ = rv[0]; RW_FMAC(y4, a_, 4, s[4]); }
            { const float a_ = rv[0]; RW_FMAC(y5, a_, 5, s[5]); }
            { const float a_ = rv[0]; RW_FMAC(y6, a_, 6, s[6]); }
            { const float a_ = rv[0]; RW_FMAC(y7, a_, 7, s[7]); }
            { const float a_ = rv[0]; RW_FMAC(y0, a_, 8, s[8]); }
            { const float a_ = rv[0]; RW_FMAC(y1, a_, 9, s[9]); }
            { const float a_ = rv[0]; RW_FMAC(y2, a_, 10, s[10]); }
            { const float a_ = rv[0]; RW_FMAC(y3, a_, 11, s[11]); }
            { const float a_ = rv[0]; RW_FMAC(y4, a_, 12, s[12]); }
            { const float a_ = rv[0]; RW_FMAC(y5, a_, 13, s[13]); }
            { const float a_ = rv[0]; RW_FMAC(y6, a_, 14, s[14]); }
            { const float a_ = rv[0]; RW_FMAC(y7, a_, 15, s[15]); }
            { const float a_ = rv[1]; RW_FMAC(y0, a_, 0, s[16]); }
            { const float a_ = rv[1]; RW_FMAC(y1, a_, 1, s[17]); }
            { const float a_ = rv[1]; RW_FMAC(y2, a_, 2, s[18]); }
            { const float a_ = rv[1]; RW_FMAC(y3, a_, 3, s[19]); }
            { const float a_ = rv[1]; RW_FMAC(y4, a_, 4, s[20]); }
            { const float a_ = rv[1]; RW_FMAC(y5, a_, 5, s[21]); }
            { const float a_ = rv[1]; RW_FMAC(y6, a_, 6, s[22]); }
            { const float a_ = rv[1]; RW_FMAC(y7, a_, 7, s[23]); }
            { const float a_ = rv[1]; RW_FMAC(y0, a_, 8, s[24]); }
            { const float a_ = rv[1]; RW_FMAC(y1, a_, 9, s[25]); }
            { const float a_ = rv[1]; RW_FMAC(y2, a_, 10, s[26]); }
            { const float a_ = rv[1]; RW_FMAC(y3, a_, 11, s[27]); }
            { const float a_ = rv[1]; RW_FMAC(y4, a_, 12, s[28]); }
            { const float a_ = rv[1]; RW_FMAC(y5, a_, 13, s[29]); }
            { const float a_ = rv[1]; RW_FMAC(y6, a_, 14, s[30]); }
            { const float a_ = rv[1]; RW_FMAC(y7, a_, 15, s[31]); }
            { const float a_ = rv[2]; RW_FMAC(y0, a_, 0, s[32]); }
            { const float a_ = rv[2]; RW_FMAC(y1, a_, 1, s[33]); }
            { const float a_ = rv[2]; RW_FMAC(y2, a_, 2, s[34]); }
            { const float a_ = rv[2]; RW_FMAC(y3, a_, 3, s[35]); }
            { const float a_ = rv[2]; RW_FMAC(y4, a_, 4, s[36]); }
            { const float a_ = rv[2]; RW_FMAC(y5, a_, 5, s[37]); }
            { const float a_ = rv[2]; RW_FMAC(y6, a_, 6, s[38]); }
            { const float a_ = rv[2]; RW_FMAC(y7, a_, 7, s[39]); }
            { const float a_ = rv[2]; RW_FMAC(y0, a_, 8, s[40]); }
            { const float a_ = rv[2]; RW_FMAC(y1, a_, 9, s[41]); }
            { const float a_ = rv[2]; RW_FMAC(y2, a_, 10, s[42]); }
            { const float a_ = rv[2]; RW_FMAC(y3, a_, 11, s[43]); }
            { const float a_ = rv[2]; RW_FMAC(y4, a_, 12, s[44]); }
            { const float a_ = rv[2]; RW_FMAC(y5, a_, 13, s[45]); }
            { const float a_ = rv[2]; RW_FMAC(y6, a_, 14, s[46]); }
            { const float a_ = rv[2]; RW_FMAC(y7, a_, 15, s[47]); }
            { const float a_ = rv[3]; RW_FMAC(y0, a_, 0, s[48]); }
            { const float a_ = rv[3]; RW_FMAC(y1, a_, 1, s[49]); }
            { const float a_ = rv[3]; RW_FMAC(y2, a_, 2, s[50]); }
            { const float a_ = rv[3]; RW_FMAC(y3, a_, 3, s[51]); }
            { const float a_ = rv[3]; RW_FMAC(y4, a_, 4, s[52]); }
            { const float a_ = rv[3]; RW_FMAC(y5, a_, 5, s[53]); }
            { const float a_ = rv[3]; RW_FMAC(y6, a_, 6, s[54]); }
            { const float a_ = rv[3]; RW_FMAC(y7, a_, 7, s[55]); }
            { const float a_ = rv[3]; RW_FMAC(y0, a_, 8, s[56]); }
            { const float a_ = rv[3]; RW_FMAC(y1, a_, 9, s[57]); }
            { const float a_ = rv[3]; RW_FMAC(y2, a_, 10, s[58]); }
            { const float a_ = rv[3]; RW_FMAC(y3, a_, 11, s[59]); }
            { const float a_ = rv[3]; RW_FMAC(y4, a_, 12, s[60]); }
            { const float a_ = rv[3]; RW_FMAC(y5, a_, 13, s[61]); }
            { const float a_ = rv[3]; RW_FMAC(y6, a_, 14, s[62]); }
            { const float a_ = rv[3]; RW_FMAC(y7, a_, 15, s[63]); }
            yo[i * 64] = ((y0 + y1) + (y2 + y3)) + ((y4 + y5) + (y6 + y7));
            wv = wn; av = an; bv = bn; rv = rnv;
        }
    }
    float* o = RPQ + (cs * 2 + kind) * 4096;
    if (kind) {
#pragma unroll
        for (int k = 0; k < 64; ++k) o[k * 64 + lane] = s[k];
    } else {
        bf16_t* ph = (bf16_t*)o;
        const int ks = lane >> 5, rem = lane & 31, jj = 4 * (rem >> 4) + (rem & 3), g = (rem >> 2) & 3;
#pragma unroll
        for (int k2 = 0; k2 < 64; ++k2) { const int mt = k2 >> 4, r = k2 & 15; const int idx = (((mt * 2 + ks) * 64 + g * 16 + r) * 8 + jj);
            ph[idx] = f2bf(s[k2]); }
    }
}

#endif
struct RwBPre { bf16x8 ah[8]; f32x4 qv[4]; };
__device__ __forceinline__ void rwB_load(RwBPre& o, const float* RPQ, size_t cb, int lane, int vt) {
    const bf16x8* ph = (const bf16x8*)(RPQ + (cb * 2 + 0) * 4096);
#pragma unroll
    for (int t = 0; t < 8; ++t) o.ah[t] = ph[t * 64 + lane];
    const float* qt = RPQ + (cb * 2 + 1) * 4096 + (16 * vt + (lane & 15)) * 64 + 4 * (lane >> 4);
#pragma unroll
    for (int mt = 0; mt < 4; ++mt) o.qv[mt] = *(const f32x4*)(qt + 16 * mt);
}
__device__ __forceinline__ void rwB_step(f32x4 (&acc)[4], const RwBPre& c, bf16_t* so) {
    asm volatile("s_nop 15\n\ts_nop 3" : "+v"(acc[0]), "+v"(acc[1]), "+v"(acc[2]), "+v"(acc[3]));
    bf16x8 bh[2], bl[2];
#pragma unroll
    for (int ks = 0; ks < 2; ++ks) { u32x4 wh, wl;
#pragma unroll
        for (int jp = 0; jp < 4; ++jp) { const float v0 = acc[2 * ks + (jp >> 1)][(2 * jp) & 3], v1 = acc[2 * ks + (jp >> 1)][((2 * jp) & 3) + 1];
            const unsigned hh = cvtpk_bf16(v0, v1); wh[jp] = hh;
            wl[jp] = cvtpk_bf16(v0 - __uint_as_float(hh << 16), v1 - __uint_as_float(hh & 0xffff0000u)); }
        { u32x2 s0_ = {wh[0], wh[1]}, s1_ = {wh[2], wh[3]}; *(u32x2*)(so + 16 * (2 * ks)) = s0_; *(u32x2*)(so + 16 * (2 * ks + 1)) = s1_; }
        bh[ks] = *reinterpret_cast<bf16x8*>(&wh); bl[ks] = *reinterpret_cast<bf16x8*>(&wl); }
#pragma unroll
    for (int mt = 0; mt < 4; ++mt) { f32x4 n = c.qv[mt];
#pragma unroll
        for (int ks = 0; ks < 2; ++ks) {
            n = __builtin_amdgcn_mfma_f32_16x16x32_bf16(c.ah[mt * 2 + ks], bh[ks], n, 0, 0, 0);
            n = __builtin_amdgcn_mfma_f32_16x16x32_bf16(c.ah[mt * 2 + ks], bl[ks], n, 0, 0, 0); }
        acc[mt] = n; }
}
__device__ void rwkv_passB_wave(const Params& p, int gwave) {
    const float* RPQ = (const float*)(p.ws + WS_RPQ); bf16_t* RS0 = (bf16_t*)(p.ws + WS_RS0);
    const int lane = tidx() & 63;
    const int stream = gwave >> 2, vt = gwave & 3, db = stream >> 2, h = stream & 3;
    f32x4 acc[4];
#pragma unroll
    for (int mt = 0; mt < 4; ++mt) acc[mt] = (f32x4){0.f, 0.f, 0.f, 0.f};
    const size_t cb0 = (size_t)db * 260 * 4 + h;
    bf16_t* so0 = RS0 + (16 * vt + (lane & 15)) * 64 + 4 * (lane >> 4);
    RwBPre c0, c1, c2, c3;
    rwB_load(c0, RPQ, cb0 + 0, lane, vt); rwB_load(c1, RPQ, cb0 + 4, lane, vt); rwB_load(c2, RPQ, cb0 + 8, lane, vt);
#pragma unroll 1
    for (int q = 0; q < 260; q += 4) {
        rwB_load(c3, RPQ, cb0 + 4 * (size_t)(q + 3), lane, vt);
        rwB_step(acc, c0, so0 + (cb0 + 4 * (size_t)q) * 8192);
        rwB_load(c0, RPQ, cb0 + 4 * (size_t)(q + 4 < 260 ? q + 4 : 259), lane, vt);
        rwB_step(acc, c1, so0 + (cb0 + 4 * (size_t)(q + 1)) * 8192);
        rwB_load(c1, RPQ, cb0 + 4 * (size_t)(q + 5 < 260 ? q + 5 : 259), lane, vt);
        rwB_step(acc, c2, so0 + (cb0 + 4 * (size_t)(q + 2)) * 8192);
        rwB_load(c2, RPQ, cb0 + 4 * (size_t)(q + 6 < 260 ? q + 6 : 259), lane, vt);
        rwB_step(acc, c3, so0 + (cb0 + 4 * (size_t)(q + 3)) * 8192);
    }
}

__device__ void rwkv_passC_unit(const Params& p, int L, int item) {
    const bf16_t* RS0 = (const bf16_t*)(p.ws + WS_RS0); const float* RY = (const float*)(p.ws + WS_RY);
    const bf16_t* RWPH = (const bf16_t*)(p.ws + WS_RWP); bf16_t* MIX = (bf16_t*)(p.ws + WS_MIX);
    const int lane = tidx() & 63, wid = wave_id(), h = wid & 3, sh = wid >> 2, fr = lane & 15, g = lane >> 4;
    const int b = item / 260, j = item % 260;
    const int row0 = rw_chunk_row0(0, b, j);
    const int qf = j, qb = j < 4 ? 3 - j : 263 - j;
    f32x4 acc[2][4];
#pragma unroll
    for (int d = 0; d < 2; ++d) {
        const size_t cs = ((size_t)(d * 2 + b) * 260 + (d ? qb : qf)) * 4 + h;
        const bf16_t* s0 = RS0 + cs * 8192 + fr * 64 + 8 * g;
        const float* rab = RY + (cs * 2 + 0) * 4096 + 8 * g;
        const float* y1b = RY + (cs * 2 + 1) * 4096 + fr * 64;
        bf16x8 bf[4][2];
#pragma unroll
        for (int nt = 0; nt < 4; ++nt)
#pragma unroll
            for (int ks = 0; ks < 2; ++ks) bf[nt][ks] = *(const bf16x8*)(s0 + nt * 1024 + 32 * ks);
#pragma unroll
        for (int m2 = 0; m2 < 2; ++m2) {
            const int ro = 32 * sh + 16 * m2;
            const int ta = d ? 63 - (ro + fr) : ro + fr;
            bf16x8 af[2];
#pragma unroll
            for (int ks = 0; ks < 2; ++ks) { const f32x4 a = *(const f32x4*)(rab + ta * 64 + 32 * ks), c = *(const f32x4*)(rab + ta * 64 + 32 * ks + 4);
                u32x4 w = {cvtpk_bf16(a[0], a[1]), cvtpk_bf16(a[2], a[3]), cvtpk_bf16(c[0], c[1]), cvtpk_bf16(c[2], c[3])}; af[ks] = *reinterpret_cast<bf16x8*>(&w); }
#pragma unroll
            for (int nt = 0; nt < 4; ++nt) {
                f32x4 a_;
#pragma unroll
                for (int r = 0; r < 1; ++r) { const f32x4 yv = *(const f32x4*)(y1b + nt * 1024 + (d ? 60 - (ro + 4 * g) : ro + 4 * g));
                    if (d) { a_[0] = yv[3] + acc[m2][nt][0]; a_[1] = yv[2] + acc[m2][nt][1]; a_[2] = yv[1] + acc[m2][nt][2]; a_[3] = yv[0] + acc[m2][nt][3]; } else a_ = yv; }
                a_ = __builtin_amdgcn_mfma_f32_16x16x32_bf16(af[0], bf[nt][0], a_, 0, 0, 0);
                a_ = __builtin_amdgcn_mfma_f32_16x16x32_bf16(af[1], bf[nt][1], a_, 0, 0, 0);
                acc[m2][nt] = a_;
            }
        }
    }
    float lw_[4], lb_[4];
#pragma unroll
    for (int nt = 0; nt < 4; ++nt) { const int c = h * 64 + 16 * nt + fr; lw_[nt] = p.rwkv_ln_w[L * 256 + c]; lb_[nt] = p.rwkv_ln_b[L * 256 + c]; }
#pragma unroll
    for (int m2 = 0; m2 < 2; ++m2)
#pragma unroll
        for (int r = 0; r < 4; ++r) {
            const int row = row0 + 32 * sh + 16 * m2 + 4 * g + r;
            const float mu = row16_sum((acc[m2][0][r] + acc[m2][1][r]) + (acc[m2][2][r] + acc[m2][3][r])) * (1.f / 64.f);
            float dv[4], sq = 0.f;
#pragma unroll
            for (int nt = 0; nt < 4; ++nt) { dv[nt] = acc[m2][nt][r] - mu; sq += dv[nt] * dv[nt]; }
            const float rs = rsqrtf(row16_sum(sq) * (1.f / 64.f) + 64e-5f);
            const bf16_t* rw = RWPH + (size_t)row * 9 * 256 + h * 64 + fr;
            bf16_t* mo = MIX + (size_t)row * 1024 + 768 + h * 64 + fr;
#pragma unroll
            for (int nt = 0; nt < 4; ++nt) { const float yn = dv[nt] * rs * lw_[nt] + lb_[nt];
                mo[16 * nt] = f2bf((yn + bf2f(rw[3 * 256 + 16 * nt])) * bf2f(rw[4 * 256 + 16 * nt])); }
        }
}

constexpr int UT_TS = 72;
constexpr int UT_AT = 0, UT_RT = 9216, UT_BT = 18432, UT_KT = 27648, UT_BHT = 36864, UT_KHT = 46080, UT_VTT = 55296;
constexpr int UT_MAK = UT_AT, UT_NRB = UT_BT, UT_NRK = UT_KT;
constexpr int UT_RF = 64512, UT_MAB = UT_RF + 16384, UT_XT = UT_MAB + 16384, UT_XS = 68, UT_EC = UT_XT + 128 * UT_XS * 4, UT_GT = UT_EC + 256;
constexpr int UT_TD = UT_GT + 2048;
static_assert(UT_TD + 4096 <= LDS_MISC, "UT LDS map");
__device__ __forceinline__ bf16x8 ut_cvt8(const float* p) { const f32x4 a = *(const f32x4*)p, b = *(const f32x4*)(p + 4);
    u32x4 w = {cvtpk_bf16(a[0], a[1]), cvtpk_bf16(a[2], a[3]), cvtpk_bf16(b[0], b[1]), cvtpk_bf16(b[2], b[3])}; return *reinterpret_cast<bf16x8*>(&w); }

#ifndef UT_WR
#define UT_WR 15
#endif
__device__ void rwkv_ut_unit(const Params& p, int unit) {
    const bf16_t* RWPH = (const bf16_t*)(p.ws + WS_RWP); const float* RWPW = (const float*)(p.ws + WS_RWPW); float* RPQ = (float*)(p.ws + WS_RPQ); float* RY = (float*)(p.ws + WS_RY);
    const int d = unit / 520, b = (unit / 260) & 1, q = unit % 260;
    const int row0 = rw_chunk_row0(d, b, q);
    bf16_t* AT = (bf16_t*)(smem + UT_AT); bf16_t* RT = (bf16_t*)(smem + UT_RT); bf16_t* BT = (bf16_t*)(smem + UT_BT); bf16_t* KT = (bf16_t*)(smem + UT_KT);
    bf16_t* BHT = (bf16_t*)(smem + UT_BHT); bf16_t* KHT = (bf16_t*)(smem + UT_KHT); bf16_t* VTT = (bf16_t*)(smem + UT_VTT);
    bf16_t* MAK = (bf16_t*)(smem + UT_MAK); bf16_t* NRB = (bf16_t*)(smem + UT_NRB); bf16_t* NRK = (bf16_t*)(smem + UT_NRK);
    float* RF = (float*)(smem + UT_RF); float* MAB = (float*)(smem + UT_MAB); float* XT = (float*)(smem + UT_XT); float* EC = (float*)(smem + UT_EC); float* GT = (float*)(smem + UT_GT);
    float* TD = (float*)(smem + UT_TD);
    float lw[8]; unsigned short ukk[8], ubd[8], ukd[8], ur[8], uvv[8];
#define UT_LOAD0(hh) { const int tid_ = tidx(), k_ = tid_ & 63, tg_ = tid_ >> 6; const int kp_ = (hh) * 64 + ((k_ & 15) << 2) + (k_ >> 4); \
    _Pragma("unroll") for (int j = 0; j < 8; ++j) { const int t_ = tg_ * 8 + j, row_ = row0 + (d ? 63 - t_ : t_); \
        const bf16_t* rp = RWPH + (size_t)row_ * 9 * 256 + kp_; \
        lw[j] = RWPW[(size_t)row_ * 512 + d * 256 + kp_]; ukk[j] = rp[2 * 256]; ubd[j] = rp[(7 + d) * 256]; ukd[j] = rp[(5 + d) * 256]; ur[j] = rp[0]; \
        uvv[j] = RWPH[((size_t)row_ * 9 + 1) * 256 + (hh) * 64 + k_]; } }
    UT_LOAD0(0)
#pragma unroll 1
    for (int h = 0; h < 4; ++h) {
        const size_t cs = ((size_t)(d * 2 + b) * 260 + q) * 4 + h;
        __syncthreads();
        {
            const int tid = tidx(), k = tid & 63, tg = tid >> 6;
            float cum[8]; float run = 0.f;
#pragma unroll
            for (int j = 0; j < 8; ++j) { lw[j] = __logf(lw[j]); run += lw[j]; cum[j] = run; }
            GT[tg * 64 + k] = run;
            __syncthreads();
            float off = 0.f, tot = 0.f;
#pragma unroll
            for (int g2 = 0; g2 < 8; ++g2) { const float gv = GT[g2 * 64 + k]; tot += gv; if (g2 < tg) off += gv; }
            if (tg == 0) EC[k] = __expf(tot);
#pragma unroll
            for (int j = 0; j < 8; ++j) { const int t = tg * 8 + j;
                const float ct = off + cum[j], cm = ct - lw[j];
                const float e_t = __expf(ct), e_m = __expf(cm), e_i = __expf(-ct), e_c = __expf(tot - ct);
                const float vkk_ = bf2f(ukk[j]), vbd_ = bf2f(ubd[j]), vkd_ = bf2f(ukd[j]), vr_ = bf2f(ur[j]);
                const float at = -vkk_ * e_m, rt = vr_ * e_t;
                AT[t * UT_TS + k] = f2bf(at); RT[t * UT_TS + k] = f2bf(rt); RF[t * 64 + k] = rt; XT[k * UT_XS + t] = at;
                BT[t * UT_TS + k] = f2bf(vbd_ * e_i); KT[t * UT_TS + k] = f2bf(vkd_ * e_i);
                BHT[k * UT_TS + t] = f2bf(vbd_ * e_c); KHT[k * UT_TS + t] = f2bf(vkd_ * e_c);
                VTT[k * UT_TS + t] = uvv[j]; }
        }
        if (h < 3) UT_LOAD0(h + 1)
        __syncthreads();
        const int tid = tidx(), lane = tid & 63, w = tid >> 6, fr = lane & 15, g = lane >> 4;
        {
            const bf16_t* Asrc = (w < 4 ? AT : RT) + (16 * (w & 3) + fr) * UT_TS + 8 * g;
            const bf16x8 a0 = *(const bf16x8*)Asrc, a1 = *(const bf16x8*)(Asrc + 32);
            f32x4 acc[8];
#pragma unroll
            for (int nt = 0; nt < 8; ++nt) { const bf16_t* Bsrc = (nt < 4 ? BT : KT) + (16 * (nt & 3) + fr) * UT_TS + 8 * g;
                f32x4 c = {0.f, 0.f, 0.f, 0.f};
                c = __builtin_amdgcn_mfma_f32_16x16x32_bf16(a0, *(const bf16x8*)Bsrc, c, 0, 0, 0);
                c = __builtin_amdgcn_mfma_f32_16x16x32_bf16(a1, *(const bf16x8*)(Bsrc + 32), c, 0, 0, 0);
                acc[nt] = c; }
            __syncthreads();
#pragma unroll
            for (int nt = 0; nt < 8; ++nt)
#pragma unroll
                for (int r = 0; r < 4; ++r) { const int t = 16 * (w & 3) + 4 * g + r, i = 16 * (nt & 3) + fr;
                    if (w < 4) { const float v = i < t ? acc[nt][r] : 0.f;
                        if (nt < 4) MAB[t * 64 + i] = v; else MAK[t * UT_TS + i] = f2bf(v); }
                    else { const float v = i <= t ? acc[nt][r] : 0.f;
                        if (nt < 4) NRB[t * UT_TS + i] = f2bf(v); else NRK[t * UT_TS + i] = f2bf(v); } }
        }
        __syncthreads();
        {
            const int mt = w >> 1;
            const bf16_t* Asrc = MAK + (16 * mt + fr) * UT_TS + 8 * g;
            const bf16x8 a0 = *(const bf16x8*)Asrc, a1 = *(const bf16x8*)(Asrc + 32);
#pragma unroll
            for (int n2 = 0; n2 < 2; ++n2) { const int nt = 2 * (w & 1) + n2; const bf16_t* Bsrc = VTT + (16 * nt + fr) * UT_TS + 8 * g;
                f32x4 c = {0.f, 0.f, 0.f, 0.f};
                c = __builtin_amdgcn_mfma_f32_16x16x32_bf16(a0, *(const bf16x8*)Bsrc, c, 0, 0, 0);
                c = __builtin_amdgcn_mfma_f32_16x16x32_bf16(a1, *(const bf16x8*)(Bsrc + 32), c, 0, 0, 0);
                *(f32x4*)(XT + (64 + 16 * nt + fr) * UT_XS + 16 * mt + 4 * g) = c; }
            if (w == 0) {
                const float* mb = MAB + (16 * g) * 64 + 16 * g;
                float x[16];
#pragma unroll
                for (int t = 0; t < 16; ++t) { float s_ = (t == fr) ? 1.f : 0.f;
#pragma unroll
                    for (int i = 0; i < t; ++i) s_ = fmaf(mb[t * 64 + i], x[i], s_);
                    x[t] = s_; }
#pragma unroll
                for (int t = 0; t < 16; ++t) TD[(g * 16 + t) * 16 + fr] = x[t];
            }
        }
        __syncthreads();
        {
            const float* xr = XT + (16 * w + fr) * UT_XS + 4 * g;
            f32x4 X[4];
#pragma unroll
            for (int I = 0; I < 4; ++I) {
                f32x4 acc = *(const f32x4*)(xr + 16 * I);
#pragma unroll
                for (int J = 0; J < I; ++J) { const f32x4 m = *(const f32x4*)(MAB + (16 * I + fr) * 64 + 16 * J + 4 * g);
#pragma unroll
                    for (int mm = 0; mm < 4; ++mm) acc = __builtin_amdgcn_mfma_f32_16x16x4f32(m[mm], X[J][mm], acc, 0, 0, 0); }
                const f32x4 tq = *(const f32x4*)(TD + (I * 16 + fr) * 16 + 4 * g);
                f32x4 xi = {0.f, 0.f, 0.f, 0.f};
#pragma unroll
                for (int mm = 0; mm < 4; ++mm) xi = __builtin_amdgcn_mfma_f32_16x16x4f32(tq[mm], acc[mm], xi, 0, 0, 0);
                X[I] = xi;
            }
#pragma unroll
            for (int I = 0; I < 4; ++I) *(f32x4*)(XT + (16 * w + fr) * UT_XS + 16 * I + 4 * g) = X[I];
        }
        __syncthreads();
        {
            const int mt = w & 3, og = w >> 2;
            const bf16_t* Ah = BHT + (16 * mt + fr) * UT_TS + 8 * g; const bf16_t* Ak = KHT + (16 * mt + fr) * UT_TS + 8 * g;
            const bf16_t* An = NRB + (16 * mt + fr) * UT_TS + 8 * g; const bf16_t* Am = NRK + (16 * mt + fr) * UT_TS + 8 * g;
            const bf16x8 ah0 = *(const bf16x8*)Ah, ah1 = *(const bf16x8*)(Ah + 32), an0 = *(const bf16x8*)An, an1 = *(const bf16x8*)(An + 32);
            if (og == 0) {
                float* ra = RY + (cs * 2 + 0) * 4096;
#pragma unroll
                for (int nt = 0; nt < 4; ++nt) { const float* xb = XT + (16 * nt + fr) * UT_XS + 8 * g;
                    const bf16x8 b0 = ut_cvt8(xb), b1 = ut_cvt8(xb + 32);
                    f32x4 pc = {0.f, 0.f, 0.f, 0.f}, rc = {0.f, 0.f, 0.f, 0.f};
                    pc = __builtin_amdgcn_mfma_f32_16x16x32_bf16(ah0, b0, pc, 0, 0, 0); pc = __builtin_amdgcn_mfma_f32_16x16x32_bf16(ah1, b1, pc, 0, 0, 0);
                    rc = __builtin_amdgcn_mfma_f32_16x16x32_bf16(b0, an0, rc, 0, 0, 0); rc = __builtin_amdgcn_mfma_f32_16x16x32_bf16(b1, an1, rc, 0, 0, 0);
                    { const int o_ = (16 * mt + fr) * 64 + 16 * nt + 4 * g; const f32x4 rf = *(const f32x4*)(RF + o_);
                      f32x4 ov = {rc[0] + rf[0], rc[1] + rf[1], rc[2] + rf[2], rc[3] + rf[3]}; if (UT_WR & 4) *(f32x4*)(ra + o_) = ov; }
#pragma unroll
                    for (int r = 0; r < 4; ++r) { const int rr = 16 * mt + 4 * g + r, k = 16 * nt + fr;
                        const float pv = pc[r] + (rr == k ? EC[rr] : 0.f);
                        const int ks = k >> 5, rem = k & 31, jj = 4 * (rem >> 4) + (rem & 3), gg = (rem >> 2) & 3;
                        ((bf16_t*)MAB)[(((rr >> 4) * 2 + ks) * 64 + gg * 16 + (rr & 15)) * 8 + jj] = f2bf(pv);
                    } }
            } else {
                const bf16x8 ak0 = *(const bf16x8*)Ak, ak1 = *(const bf16x8*)(Ak + 32), am0 = *(const bf16x8*)Am, am1 = *(const bf16x8*)(Am + 32);
                float* qo = RPQ + (cs * 2 + 1) * 4096; float* y1 = RY + (cs * 2 + 1) * 4096;
#pragma unroll
                for (int nt = 0; nt < 4; ++nt) { const float* xb = XT + (64 + 16 * nt + fr) * UT_XS + 8 * g; const bf16_t* vb = VTT + (16 * nt + fr) * UT_TS + 8 * g;
                    const bf16x8 z0 = ut_cvt8(xb), z1 = ut_cvt8(xb + 32), v0 = *(const bf16x8*)vb, v1 = *(const bf16x8*)(vb + 32);
                    f32x4 qc = {0.f, 0.f, 0.f, 0.f}, yc = {0.f, 0.f, 0.f, 0.f};
                    qc = __builtin_amdgcn_mfma_f32_16x16x32_bf16(ah0, z0, qc, 0, 0, 0); qc = __builtin_amdgcn_mfma_f32_16x16x32_bf16(ah1, z1, qc, 0, 0, 0);
                    qc = __builtin_amdgcn_mfma_f32_16x16x32_bf16(ak0, v0, qc, 0, 0, 0); qc = __builtin_amdgcn_mfma_f32_16x16x32_bf16(ak1, v1, qc, 0, 0, 0);
                    yc = __builtin_amdgcn_mfma_f32_16x16x32_bf16(an0, z0, yc, 0, 0, 0); yc = __builtin_amdgcn_mfma_f32_16x16x32_bf16(an1, z1, yc, 0, 0, 0);
                    yc = __builtin_amdgcn_mfma_f32_16x16x32_bf16(am0, v0, yc, 0, 0, 0); yc = __builtin_amdgcn_mfma_f32_16x16x32_bf16(am1, v1, yc, 0, 0, 0);
#pragma unroll
                    for (int r = 0; r < 1; ++r) { const int o_ = (16 * nt + fr) * 64 + 16 * mt + 4 * g; if (UT_WR & 2) *(f32x4*)(qo + o_) = qc; if (UT_WR & 8) *(f32x4*)(y1 + o_) = yc; } }
            }
        }
        __syncthreads();
        if (UT_WR & 1) ((u32x4*)(RPQ + (cs * 2 + 0) * 4096))[tid] = ((const u32x4*)MAB)[tid];
    }
}
constexpr int RT_PAR = 0;
constexpr int RT_BS = 72, RT_BBUF = 2 * 80 * RT_BS * 2;
constexpr int RT_B = 36864, RT_LG = RT_B + 2 * RT_BBUF, RT_CNT = RT_LG + 8 * 16 * 80 * 4;
static_assert(RT_CNT + 512 <= LDS_MISC, "router LDS map");
struct RtTile { int row; float rs; const bf16_t* xr; const float* pw; const float* ps; };
__device__ __forceinline__ void rt_tile_init(RtTile& t, const bf16_t* X, const float* par, int tile, int fr, int g) {
    const int row0 = tile * 16, set = row_set(row0); t.row = row0 + fr;
    t.xr = X + (size_t)t.row * 1024 + 8 * g; t.pw = par + (set * 3 + 0) * 1024 + 8 * g; t.ps = par + (set * 3 + 1) * 1024 + 8 * g;
    float ss = 0.f;
#pragma unroll 8
    for (int ks = 0; ks < 32; ++ks) { const f32x4 a = ld4bf(t.xr + 32 * ks), b = ld4bf(t.xr + 32 * ks + 4);
        ss += a[0] * a[0] + a[1] * a[1] + a[2] * a[2] + a[3] * a[3] + b[0] * b[0] + b[1] * b[1] + b[2] * b[2] + b[3] * b[3]; }
    ss += __int_as_float(__builtin_amdgcn_ds_swizzle(__float_as_int(ss), 0x401F));
    { auto rr = __builtin_amdgcn_permlane32_swap(__float_as_uint(ss), __float_as_uint(ss), false, false); ss = __uint_as_float(rr[0]) + __uint_as_float(rr[1]); }
    t.rs = rsqrtf(ss * (1.f / 1024.f) + NORM_EPS);
}
struct RtX { u32x4 u[2]; };
__device__ __forceinline__ void rt_xload(RtX& o, const RtTile& t, int kc) {
#pragma unroll
    for (int s2 = 0; s2 < 2; ++s2) o.u[s2] = *(const u32x4*)(t.xr + 64 * kc + 32 * s2); }
__device__ __forceinline__ void rt_chunk(f32x4 (&acc)[5], const RtTile& t, const RtX& x, bf16_t* H, const bf16_t* Bc, int kc, int fr, int g) {
#pragma unroll
    for (int s2 = 0; s2 < 2; ++s2) { const int ks = 2 * kc + s2;
        const f32x4 w0 = *(const f32x4*)(t.pw + 32 * ks), w1 = *(const f32x4*)(t.pw + 32 * ks + 4), s0 = *(const f32x4*)(t.ps + 32 * ks), s1 = *(const f32x4*)(t.ps + 32 * ks + 4);
        float hv[8];
        { const u32x4 u = x.u[s2];
          const float xa[4] = {__uint_as_float(u[0] << 16), __uint_as_float(u[0] & 0xffff0000u), __uint_as_float(u[1] << 16), __uint_as_float(u[1] & 0xffff0000u)};
          const float xb[4] = {__uint_as_float(u[2] << 16), __uint_as_float(u[2] & 0xffff0000u), __uint_as_float(u[3] << 16), __uint_as_float(u[3] & 0xffff0000u)};
#pragma unroll
          for (int e = 0; e < 4; ++e) { hv[e] = fmaf(xa[e] * t.rs, w0[e], s0[e]); hv[4 + e] = fmaf(xb[e] * t.rs, w1[e], s1[e]); } }
        u32x4 hi, lo;
#pragma unroll
        for (int e = 0; e < 4; ++e) { const unsigned hh = cvtpk_bf16(hv[2 * e], hv[2 * e + 1]); hi[e] = hh;
            lo[e] = cvtpk_bf16(hv[2 * e] - __uint_as_float(hh << 16), hv[2 * e + 1] - __uint_as_float(hh & 0xffff0000u)); }
        *(u32x4*)(H + (size_t)t.row * 1024 + 32 * ks + 8 * g) = hi;
        const bf16x8 ah = *reinterpret_cast<bf16x8*>(&hi), al = *reinterpret_cast<bf16x8*>(&lo);
#pragma unroll
        for (int nt = 0; nt < 5; ++nt) {
            const bf16x8 wh = *(const bf16x8*)(Bc + (16 * nt + fr) * RT_BS + 32 * s2 + 8 * g), wl = *(const bf16x8*)(Bc + (80 + 16 * nt + fr) * RT_BS + 32 * s2 + 8 * g);
            acc[nt] = __builtin_amdgcn_mfma_f32_16x16x32_bf16(ah, wh, acc[nt], 0, 0, 0);
            acc[nt] = __builtin_amdgcn_mfma_f32_16x16x32_bf16(al, wh, acc[nt], 0, 0, 0);
            acc[nt] = __builtin_amdgcn_mfma_f32_16x16x32_bf16(ah, wl, acc[nt], 0, 0, 0); } }
}
__device__ __forceinline__ void rt_pick(const Params& p, int L, const f32x4 (&acc)[5], float* lg, int* lcnt, int row0, int lane, int fr, int g,
                                        int& ea, int& eb, int& pa, int& pb, int& trow) {
    int* EID = (int*)(p.ws + WS_EID); float* GATE = (float*)(p.ws + WS_GATE); const float* bias = (const float*)(smem + RT_PAR) + 2 * 1024;
#pragma unroll
    for (int nt = 0; nt < 5; ++nt)
#pragma unroll
        for (int r = 0; r < 4; ++r) lg[(4 * g + r) * 80 + 16 * nt + fr] = acc[nt][r];
    asm volatile("s_waitcnt lgkmcnt(0)" ::: "memory");
    if (lane < 16) {
        const float* l = lg + lane * 80; trow = row0 + lane;
        float gl[8]; int gi = 0; float gm = -3.0e38f;
#pragma unroll
        for (int j = 0; j < 8; ++j) { gl[j] = l[j] + bias[j]; if (gl[j] > gm) { gm = gl[j]; gi = j; } }
        float gs = 0.f;
#pragma unroll
        for (int j = 0; j < 8; ++j) gs += __expf(gl[j] - gm);
        const float pg = 1.f / gs;
        float e1 = -3.0e38f, e2 = -3.0e38f; int i1 = 0, i2 = 0;
        for (int j = 0; j < 8; ++j) { const float v = l[8 + gi * 8 + j] + bias[8 + gi * 8 + j];
            if (v > e1) { e2 = e1; i2 = i1; e1 = v; i1 = j; } else if (v > e2) { e2 = v; i2 = j; } }
        const float x2 = __expf(e2 - e1);
        const float g0 = pg / (1.f + x2), g1 = pg * x2 / (1.f + x2);
        ea = gi * 8 + i1; eb = gi * 8 + i2;
        EID[trow * 2] = ea; EID[trow * 2 + 1] = eb; GATE[trow * 2] = g0; GATE[trow * 2 + 1] = g1;
        pa = atomicAdd(&lcnt[ea], 1); pb = atomicAdd(&lcnt[eb], 1);
    }
    asm volatile("s_waitcnt lgkmcnt(0)" ::: "memory");
}
__device__ __forceinline__ void ph_norm2_router(const Params& p, int L) {
    unsigned char* ws = p.ws;
    const bf16_t* X = (const bf16_t*)(ws + WS_X); bf16_t* H = (bf16_t*)(ws + WS_H);
    const float* mods = (const float*)(ws + WS_MODS);
    const bf16_t* WRH = (const bf16_t*)(ws + WS_WRH) + (size_t)L * 2 * 80 * 1024; const bf16_t* WRL = WRH + 80 * 1024;
    int* POS = (int*)(ws + WS_POS); int* CNT = (int*)(ws + WS_MISC);
    const int tid = tidx(), lane = tid & 63, wid = tid >> 6, fr = lane & 15, g = lane >> 4;
    float* par = (float*)(smem + RT_PAR); float* lg = (float*)(smem + RT_LG) + wid * (16 * 80); int* lcnt = (int*)(smem + RT_CNT);
    bf16_t* Bs = (bf16_t*)(smem + RT_B);
    __syncthreads();
    for (int i = tid; i < 3 * 1024; i += NTHREADS) { const int set = i >> 10, c = i & 1023; const float* md = mods + (L * 3 + set) * 6144;
        par[(set * 3 + 0) * 1024 + c] = p.norm2_w[L * 1024 + c] * (1.f + md[4 * 1024 + c]); par[(set * 3 + 1) * 1024 + c] = md[3 * 1024 + c]; }
    if (tid < 72) par[2 * 1024 + tid] = tid < 8 ? p.moe_b_rg[L * 8 + tid] : p.moe_b_re[L * 64 + tid - 8];
    constexpr int NTILE = NTOK / 16;
    const int G = gridDim.x, tbase = NTILE / G, trem = NTILE % G, bx = bidx();
    const int t_lo = bx * tbase + (bx < trem ? bx : trem), t_hi = t_lo + tbase + (bx < trem ? 1 : 0);
    for (int t0 = t_lo; t0 < t_hi; t0 += 9) {
        const int tA = t0 + wid, tB = t0 + 8;
        const bool hasA = tA < t_hi && wid < 8, hasB = (wid == 0) && tB < t_hi;
        if (tid < 64) lcnt[tid] = 0;
        RtTile A, B;
        rt_tile_init(A, X, par, hasA ? tA : t0, fr, g);
        if (hasB) rt_tile_init(B, X, par, tB, fr, g); else B = A;
        f32x4 accA[5], accB[5];
#pragma unroll
        for (int nt = 0; nt < 5; ++nt) { accA[nt] = (f32x4){0.f, 0.f, 0.f, 0.f}; accB[nt] = (f32x4){0.f, 0.f, 0.f, 0.f}; }
        u32x4 st[3];
#pragma unroll
        for (int i = 0; i < 3; ++i) { const int idx = tid + 512 * i; if (idx < 1280) { const int part = idx / 640, rem = idx % 640, o = rem >> 3, c8 = rem & 7;
            st[i] = *(const u32x4*)((part ? WRL : WRH) + (size_t)o * 1024 + c8 * 8); } }
        RtX xa, xb, xan, xbn; rt_xload(xa, A, 0); if (hasB) rt_xload(xb, B, 0);
#pragma unroll 1
        for (int kc = 0; kc < 16; ++kc) {
            bf16_t* Bc = Bs + (kc & 1) * (RT_BBUF / 2);
#pragma unroll
            for (int i = 0; i < 3; ++i) { const int idx = tid + 512 * i; if (idx < 1280) { const int part = idx / 640, rem = idx % 640, o = rem >> 3, c8 = rem & 7;
                *(u32x4*)(Bc + (part * 80 + o) * RT_BS + c8 * 8) = st[i]; } }
            __syncthreads();
            const int kn = kc < 15 ? kc + 1 : 15;
#pragma unroll
            for (int i = 0; i < 3; ++i) { const int idx = tid + 512 * i; if (idx < 1280) { const int part = idx / 640, rem = idx % 640, o = rem >> 3, c8 = rem & 7;
                st[i] = *(const u32x4*)((part ? WRL : WRH) + (size_t)o * 1024 + kn * 64 + c8 * 8); } }
            rt_xload(xan, A, kn); if (hasB) rt_xload(xbn, B, kn);
            if (hasA) rt_chunk(accA, A, xa, H, Bc, kc, fr, g);
            if (hasB) rt_chunk(accB, B, xb, H, Bc, kc, fr, g);
            xa = xan; xb = xbn;
        }
        int eaA = 0, ebA = 0, paA = 0, pbA = 0, trA = 0, eaB = 0, ebB = 0, paB = 0, pbB = 0, trB = 0;
        if (hasA) rt_pick(p, L, accA, lg, lcnt, tA * 16, lane, fr, g, eaA, ebA, paA, pbA, trA);
        if (hasB) rt_pick(p, L, accB, lg, lcnt, tB * 16, lane, fr, g, eaB, ebB, paB, pbB, trB);
        __syncthreads();
        if (tid < 64) { const int c = lcnt[tid]; lcnt[64 + tid] = c > 0 ? atomicAdd(&CNT[tid * 16], c) : 0; }
        __syncthreads();
        if (hasA && lane < 16) { POS[trA * 2] = lcnt[64 + eaA] + paA; POS[trA * 2 + 1] = lcnt[64 + ebA] + pbA; }
        if (hasB && lane < 16) { POS[trB * 2] = lcnt[64 + eaB] + paB; POS[trB * 2 + 1] = lcnt[64 + ebB] + pbB; }
        __syncthreads();
    }
}

constexpr int MOE_TBL = 131072;
__device__ __forceinline__ void moe_table(const Params& p) {
    int* tb = (int*)(smem + MOE_TBL); const int* CNT = (const int*)(p.ws + WS_MISC);
    __syncthreads();
    if (tidx() < 64) {
        const int e = tidx(), cnt = CNT[e * 16], pd = (cnt + 255) / 256 * 256;
        const int incl = (int)wave_scan_incl((float)pd);
        tb[e] = incl - pd; tb[64 + e] = pd; tb[576 + e] = cnt; if (e == 63) tb[128] = incl / 256;
        for (int t = (incl - pd) >> 8; t < (incl >> 8); ++t) tb[192 + t] = e; }
    __syncthreads();
}
__device__ __forceinline__ void ph_slots(const Params& p) {
    unsigned char* ws = p.ws;
    const int* EID = (const int*)(ws + WS_EID); const int* POS = (const int*)(ws + WS_POS); int* SLOT = (int*)(ws + WS_SLOT);
    const bf16_t* H = (const bf16_t*)(ws + WS_H); bf16_t* HG = (bf16_t*)(ws + WS_HG);
    const int* CNT = (const int*)(ws + WS_MISC);
    moe_table(p);
    const int* tb = (const int*)(smem + MOE_TBL);
    const int lane = tidx() & 63, gw = bidx() * 8 + wave_id(), nw = gridDim.x * 8;
    for (int i0 = gw * 4; i0 < NTOK * 2; i0 += nw * 4) {
        int sl[4]; u32x4 a[4], b[4];
#pragma unroll
        for (int q = 0; q < 4; ++q) sl[q] = tb[EID[i0 + q]] + POS[i0 + q];
#pragma unroll
        for (int q = 0; q < 4; ++q) { const u32x4* src = (const u32x4*)(H + (size_t)((i0 + q) >> 1) * 1024); a[q] = src[lane]; b[q] = src[64 + lane]; }
#pragma unroll
        for (int q = 0; q < 4; ++q) { if (lane == 0) SLOT[i0 + q] = sl[q]; u32x4* dst = (u32x4*)(HG + (size_t)sl[q] * 1024); dst[lane] = a[q]; dst[64 + lane] = b[q]; }
    }
    for (int e = 0; e < 64; ++e) {
        const int c = tb[e] + tb[576 + e], n = tb[64 + e] - tb[576 + e];
        const unsigned z0 = (unsigned)tidx() >> 20;
        for (int r = gw; r < n; r += nw) { u32x4* dst = (u32x4*)(HG + (size_t)(c + r) * 1024); dst[lane] = (u32x4){z0, z0, z0, z0}; dst[64 + lane] = (u32x4){z0, z0, z0, z0}; }
    }
}
struct UnitsMoe1 { const bf16_t* W13; bf16_t* HM; const int* tb; int bid, nb, nunit;
    struct Info { size_t a; const bf16_t* b; bf16_t* o; };
    __device__ __forceinline__ bool get(int i, Info& u) const { const int t0 = bid + i * nb; if (t0 >= nunit) return false; const int t = xcd_remap(t0, nunit), rt = t >> 2, pn = t & 3; const int e = __builtin_amdgcn_readfirstlane(tb[192 + rt]);
        u.a = (size_t)rt * 256 * 1024; u.b = W13 + ((size_t)e * 1024 + pn * 256) * 1024; u.o = HM + (size_t)rt * 256 * 512 + pn * 128; return true; }
    __device__ __forceinline__ void epi(const f32x4 (&acc)[2][2][4][2], const Info& u, int wr, int wc, int fr, int fq) const { EpiSwiglu e{u.o}; e(acc, wr, wc, fr, fq); } };
__device__ __forceinline__ void ph_moe1(const Params& p) {
    unsigned char* ws = p.ws;
    moe_table(p);
    const int* tb = (const int*)(smem + MOE_TBL);
    UnitsMoe1 un{(const bf16_t*)(ws + WS_W13), (bf16_t*)(ws + WS_HMID), tb, bidx(), (int)gridDim.x, tb[128] * 4};
    gemm_stream<1024, 1024, 1024>((const bf16_t*)(ws + WS_HG), un);
}
struct UnitsMoe2 { const bf16_t* W2; bf16_t* YE; const int* tb; int bid, nb, nunit;
    struct Info { size_t a; const bf16_t* b; bf16_t* o; };
    __device__ __forceinline__ bool get(int i, Info& u) const { const int t0 = bid + i * nb; if (t0 >= nunit) return false; const int t = xcd_remap(t0, nunit), rt = t >> 2, pn = t & 3; const int e = __builtin_amdgcn_readfirstlane(tb[192 + rt]);
        u.a = (size_t)rt * 256 * 512; u.b = W2 + ((size_t)e * 1024 + pn * 256) * 512; u.o = YE + (size_t)rt * 256 * 1024 + pn * 256; return true; }
    __device__ __forceinline__ void epi(const f32x4 (&acc)[2][2][4][2], const Info& u, int wr, int wc, int fr, int fq) const { EpiBf16Store e{u.o, 1024}; e(acc, wr, wc, fr, fq); } };
__device__ __forceinline__ void ph_moe2(const Params& p) {
    unsigned char* ws = p.ws;
    moe_table(p);
    const int* tb = (const int*)(smem + MOE_TBL);
    UnitsMoe2 un{(const bf16_t*)(ws + WS_W2), (bf16_t*)(ws + WS_YEXP), tb, bidx(), (int)gridDim.x, tb[128] * 4};
    gemm_stream<512, 512, 512>((const bf16_t*)(ws + WS_HMID), un);
}

__device__ __forceinline__ void ph_final(const Params& p) {
    unsigned char* ws = p.ws;
    const bf16_t* X = (const bf16_t*)(ws + WS_X); const float* mods = (const float*)(ws + WS_MODS);
    const int* SLOT = (const int*)(ws + WS_SLOT); const float* GATE = (const float*)(ws + WS_GATE); const bf16_t* YE = (const bf16_t*)(ws + WS_YEXP);
    const int lane = tidx() & 63, gw = bidx() * 8 + wave_id(), nw = gridDim.x * 8;
    float* par = (float*)smem;
    __syncthreads();
    for (int i = tidx(); i < 3 * 1024; i += NTHREADS) { const int k = i >> 10, c = i & 1023; par[i] = k < 2 ? mods[(3 * 3 + k) * 6144 + 5 * 1024 + c] : p.final_norm_w[c]; }
    __syncthreads();
    for (int row = gw; row < NLAT; row += nw) {
        const int set = row_set(row);
        const float* g2 = par + set * 1024;
        const int s0 = SLOT[row * 2], s1 = SLOT[row * 2 + 1]; const float ga = GATE[row * 2], gb = GATE[row * 2 + 1];
        f32x4 v[4]; float ss = 0.f;
#pragma unroll
        for (int i = 0; i < 4; ++i) { const int col = i * 256 + lane * 4;
            v[i] = ld4bf(X + (size_t)row * 1024 + col);
            const u32x2 ya = *(const u32x2*)(YE + (size_t)s0 * 1024 + col), yb = *(const u32x2*)(YE + (size_t)s1 * 1024 + col);
            const f32x4 gg = *(const f32x4*)(g2 + col);
            v[i][0] += gg[0] * (ga * __uint_as_float(ya[0] << 16) + gb * __uint_as_float(yb[0] << 16));
            v[i][1] += gg[1] * (ga * __uint_as_float(ya[0] & 0xffff0000u) + gb * __uint_as_float(yb[0] & 0xffff0000u));
            v[i][2] += gg[2] * (ga * __uint_as_float(ya[1] << 16) + gb * __uint_as_float(yb[1] << 16));
            v[i][3] += gg[3] * (ga * __uint_as_float(ya[1] & 0xffff0000u) + gb * __uint_as_float(yb[1] & 0xffff0000u));
            ss += v[i][0] * v[i][0] + v[i][1] * v[i][1] + v[i][2] * v[i][2] + v[i][3] * v[i][3]; }
        ss = wave_sum(ss);
        const float rs = rsqrtf(ss * (1.f / 1024.f) + NORM_EPS);
#pragma unroll
        for (int i = 0; i < 4; ++i) { const int col = i * 256 + lane * 4; const f32x4 w = *(const f32x4*)(par + 2048 + col);
            f32x4 o; o[0] = v[i][0] * rs * w[0]; o[1] = v[i][1] * rs * w[1]; o[2] = v[i][2] * rs * w[2]; o[3] = v[i][3] * rs * w[3];
            *(f32x4*)(p.out + (size_t)row * 1024 + col) = o; }
    }
}
struct WQ { unsigned* ctr; int pend; };
__device__ __forceinline__ void wq_init(WQ& q, unsigned* ctr) { q.ctr = ctr; q.pend = 0; if (tidx() == 0) q.pend = (int)__hip_atomic_fetch_add(ctr, 1u, __ATOMIC_RELAXED, __HIP_MEMORY_SCOPE_AGENT); }
__device__ __forceinline__ int wq_next(WQ& q) {
    volatile LAS int* slot = (volatile LAS int*)(LAS unsigned char*)(smem + LDS_MISC + 32);
    __syncthreads();
    if (tidx() == 0) { *slot = q.pend; q.pend = (int)__hip_atomic_fetch_add(q.ctr, 1u, __ATOMIC_RELAXED, __HIP_MEMORY_SCOPE_AGENT); }
    __syncthreads();
    return __builtin_amdgcn_readfirstlane(*slot);
}
__device__ __forceinline__ unsigned* wq_ctr(const Params& p, int L, int k) { return (unsigned*)(p.ws + WS_MISC) + 1024 + L * 16 + k; }

__device__ __forceinline__ void ph_mixA(const Params& p, int L) {
    unsigned char* ws = p.ws;
    const bf16_t* U = (const bf16_t*)(ws + WS_U); const bf16_t* W = (const bf16_t*)(ws + WS_WUP) + (size_t)L * UPW * UPK; bf16_t* QU = (bf16_t*)(ws + WS_QKVUP);
    constexpr int NS = SSD_UNITS, NR = RW_UNITS_PREP, NG = 130 * 6;
    WQ wq; wq_init(wq, wq_ctr(p, L, 0));
    int u = wq_next(wq);
    for (; u < NS; u = wq_next(wq)) QREP(1) { QSYNC ssd_pass1_unit(p, L, u); }
    for (; u < NS + NG; u = wq_next(wq)) QREP(3) { const int v = u - NS, pm = v / 6, pn = v % 6; QSYNC
        ARowLin<UW> ar{(size_t)pm * 256 * UW + U_QD};
        EpiBf16Store ep{QU + (size_t)pm * 256 * UPW + pn * 256, UPW};
        gemm256<UPK, UPK>(U, ar, W + (size_t)pn * 256 * UPK, ep);
    }
    for (; u < NS + NG + NR; u = wq_next(wq)) QREP(2) { QSYNC rwkv_prep_unit(p, L, u - NS - NG); }
}
__device__ __forceinline__ void ph_mixB(const Params& p, int L) {
    constexpr int NA = RW_UNITS, NM = NTOK / 32, NSC = (2 * 2 * 6 * 128 * 64) / NTHREADS;
    WQ wq; wq_init(wq, wq_ctr(p, L, 1));
    int u = wq_next(wq);
#if RW_UT
    for (; u < NA; u = wq_next(wq)) QREP(4) rwkv_ut_unit(p, u);
#else
    for (; u < NA; u = wq_next(wq)) rwkv_passA_unit(p, u);
#endif
    for (; u < NA + NM; u = wq_next(wq)) ph_mla_prep_rows(p, (u - NA) * 32, (u - NA) * 32 + 32, wave_id(), 8);
    for (; u < NA + NM + NSC; u = wq_next(wq)) ssd_scan_range(p, (u - NA - NM) * NTHREADS + tidx(), 0x40000000);
}
__device__ __forceinline__ void ph_mixD(const Params& p, int L) {
    unsigned char* ws = p.ws;
    const bf16_t* Q = (const bf16_t*)(ws + WS_Q); const bf16_t* Kb = (const bf16_t*)(ws + WS_K); const bf16_t* Vb = (const bf16_t*)(ws + WS_V); bf16_t* MIX = (bf16_t*)(ws + WS_MIX);
    unsigned* flag = (unsigned*)(ws + WS_MISC) + 1200 + L;
    if (bidx() < 64 && wave_id() == 0) {
        rwkv_passB_wave(p, ((bidx() & 7) + 8 * (bidx() >> 5)) * 4 + ((bidx() >> 3) & 3));
        asm volatile("s_waitcnt vmcnt(0)" ::: "memory");
        __builtin_amdgcn_fence(__ATOMIC_RELEASE, "agent");
        asm volatile("s_waitcnt vmcnt(0)" ::: "memory");
        if ((tidx() & 63) == 0) __hip_atomic_fetch_add(flag, 1u, __ATOMIC_RELAXED, __HIP_MEMORY_SCOPE_AGENT);
    }
    constexpr int NS = SSD_UNITS, NA = 768, NC = 12, NR = RW_UNITS / 2;
    WQ wq; wq_init(wq, wq_ctr(p, L, 3));
    int u = wq_next(wq);
    for (; u < NS; u = wq_next(wq)) QREP(7) { QSYNC ssd_pass3_unit(p, L, u); }
#ifdef PROBE_ATT
    for (int rep = 0; rep <= PROBE_ATT; ++rep) { const int samet = (rep < PROBE_ATT) && PROBE_ATT_SAME;
      for (int a = bidx(); a < NA + NC; a += gridDim.x) {
        int b, h, row0, seq;
        if (a < NA) { b = a / 384; h = (a / 64) % 6; row0 = b * SEQ + (a % 64) * 256; seq = KEYS; }
        else { const int c = a - NA; b = c / 6; h = c % 6; row0 = NLAT + b * CTXL; seq = CTXL; }
        __syncthreads();
        att::attn_body(Q + (size_t)row0 * 576 + h * 96, Kb + (size_t)(b * 6 + h) * KEYS * 96, Vb + (size_t)(b * 6 + h) * KEYS * 64,
                       MIX + (size_t)row0 * 1024 + 384 + h * 64, seq, (char*)smem, samet); } }
    u += NA + NC;
#define wq_next(c) (wq_next(c) + NA + NC)
#else
    for (; u < NS + NA + NC; u = wq_next(wq)) { const int a = u - NS;
        int b, h, row0, seq;
        if (a < NA) {
            volatile LAS int* slot2 = (volatile LAS int*)(LAS unsigned char*)(smem + LDS_MISC + 48);
            __syncthreads();
            if (tidx() == 0) { int r = 0; const int x0 = bidx() & 7;
                for (int kx = 0; kx < 8; ++kx) { const int x = (x0 + kx) & 7; const unsigned n = __hip_atomic_fetch_add(wq_ctr(p, L, 8 + x), 1u, __ATOMIC_RELAXED, __HIP_MEMORY_SCOPE_AGENT);
                    if (n < 96u) { r = x * 96 + (int)n; break; } }
                *slot2 = r; }
            __syncthreads();
            const int e = __builtin_amdgcn_readfirstlane(*slot2), x = e / 96, n = e % 96, hd = 4 * (n >> 5) + (x >> 1), qt = 32 * (x & 1) + (n & 31);
            b = hd / 6; h = hd % 6; row0 = b * SEQ + qt * 256; seq = KEYS; }
        else { const int c = a - NA; b = c / 6; h = c % 6; row0 = NLAT + b * CTXL; seq = CTXL; }
        att::attn_body(Q + (size_t)row0 * 576 + h * 96, Kb + (size_t)(b * 6 + h) * KEYS * 96, Vb + (size_t)(b * 6 + h) * KEYS * 64,
                       MIX + (size_t)row0 * 1024 + 384 + h * 64, seq, (char*)smem);
    }
#endif
    if (u < NS + NA + NC + NR) {
        if (tidx() == 0) { unsigned sp = 0;
            while (__hip_atomic_load(flag, __ATOMIC_RELAXED, __HIP_MEMORY_SCOPE_AGENT) < 64u) { __builtin_amdgcn_s_sleep(2); if (++sp > (1u << 22)) break; }
            __builtin_amdgcn_fence(__ATOMIC_ACQUIRE, "agent");
            asm volatile("s_waitcnt vmcnt(0)" ::: "memory"); }
        __syncthreads();
    }
    for (; u < NS + NA + NC + NR; u = wq_next(wq)) rwkv_passC_unit(p, L, u - NS - NA - NC);
#ifdef PROBE_ATT
#undef wq_next
#endif
}

__device__ __forceinline__ void ph_moe_convert(const Params& p, int L) {
    constexpr int G = 4, NI = (MOE_CV_N13 + MOE_CV_N2) / G;
    WQ wq; wq_init(wq, wq_ctr(p, L, 4));
    for (int it = wq_next(wq); it < NI; it = wq_next(wq))
#pragma unroll 1
        for (int u = it * G; u < it * G + G; ++u) moe_convert_tile(p, L, u);
}
constexpr int PH_PER_LAYER = 10, PH_TOTAL = 2 + 4 * PH_PER_LAYER;
typedef const __attribute__((address_space(4))) Params* KParams;
__device__ __forceinline__ KParams kp_launder() { KParams q = (KParams)__builtin_amdgcn_kernarg_segment_ptr(); asm volatile("" : "+s"(q)); return q; }
#ifndef PROBE_REP_PH
#define PROBE_REP_PH (-1)
#define PROBE_REP_N 1
#endif
#define PHASE(k, call) do { if (lo <= (k) && (k) < hi) { const int nrep_ = (PROBE_REP_PH >= 0 && (k) >= 1 && ((k) - 1) % PH_PER_LAYER == PROBE_REP_PH && (k) < PH_TOTAL - 1) ? PROBE_REP_N : 1; \
    for (int rep_ = 0; rep_ < nrep_; ++rep_) { { const Params p = *(const Params*)kp_launder(); call; } if ((k) + 1 < hi) xcd_barrier(bar); \
        if (nrep_ > 1) { if (bidx() == 0 && tidx() < 64) ((unsigned*)(p_.ws + WS_MISC))[1024 + tidx()] = 0u; xcd_barrier(bar); } } } } while (0)
__global__ void __launch_bounds__(NTHREADS, 2) mega(Params p_) {
    volatile LAS unsigned* st = (volatile LAS unsigned*)(LAS unsigned char*)(smem + LDS_MISC);
    if (threadIdx.x < 4) st[threadIdx.x] = 0u;
    __syncthreads();
    const int lo = (int)p_.ph_lo, hi = (int)p_.ph_hi;
    XcdBarrier bar; bar.bar = (unsigned*)(p_.ws + WS_BAR); bar.x = 0; bar.st = st;
    if (hi - lo > 1) bar = xcd_barrier_post((unsigned*)(p_.ws + WS_BAR), st);
    PHASE(0, ph_prologue(p));
#ifdef PROBE_DUP
#define DUP(k, idx, call) do { if ((idx) == PROBE_DUP) { xcd_barrier(bar); if (bidx() == 0 && tidx() < 64) ((unsigned*)(p_.ws + WS_MISC))[1024 + tidx()] = 0u; xcd_barrier(bar); { const Params p = *(const Params*)kp_launder(); call; } xcd_barrier(bar); } } while (0)
#else
#define DUP(k, idx, call) do { } while (0)
#endif
    for (int L = 0; L < DEPTH; ++L) {
        const int pb = 1 + PH_PER_LAYER * L;
        PHASE(pb + 0, ph_norm1(p, L));
        PHASE(pb + 1, ph_gemm_in(p, L)); DUP(pb + 1, 1, ph_gemm_in(p, L));
        PHASE(pb + 2, ph_mixA(p, L)); DUP(pb + 2, 2, ph_mixA(p, L));
        PHASE(pb + 3, ph_mixB(p, L)); DUP(pb + 3, 3, ph_mixB(p, L));
        PHASE(pb + 4, ph_mixD(p, L)); DUP(pb + 4, 4, ph_mixD(p, L));
        PHASE(pb + 5, (ph_gemm_out(p, L), ph_moe_convert(p, L)));
        PHASE(pb + 6, ph_norm2_router(p, L));
        PHASE(pb + 7, ph_slots(p)); DUP(pb + 7, 8, ph_slots(p));
        PHASE(pb + 8, ph_moe1(p)); DUP(pb + 8, 9, ph_moe1(p));
        PHASE(pb + 9, ph_moe2(p)); DUP(pb + 9, 10, ph_moe2(p));
    }
    PHASE(PH_TOTAL - 1, ph_final(p));
#ifdef PROBE_PH
    for (int r = 0; r < PROBE_N; ++r) { xcd_barrier(bar); if (bidx() == 0 && tidx() < 64) ((unsigned*)(p_.ws + WS_MISC))[1024 + tidx()] = 0u; xcd_barrier(bar); const Params p = *(const Params*)kp_launder(); const int L = 3;
        if (PROBE_PH == 0) ph_norm1(p, L); if (PROBE_PH == 1) ph_gemm_in(p, L); if (PROBE_PH == 2) ph_mixA(p, L); if (PROBE_PH == 3) ph_mixB(p, L);
        if (PROBE_PH == 5) ph_mixD(p, L); if (PROBE_PH == 7) ph_gemm_out(p, L);
        if (PROBE_PH == 8) ph_norm2_router(p, L); if (PROBE_PH == 9) ph_slots(p); if (PROBE_PH == 10) ph_moe1(p); if (PROBE_PH == 11) ph_moe2(p);
        if (PROBE_PH == 12) ph_moe_convert(p, L); if (PROBE_PH == 13) ph_prologue(p);
        if (PROBE_PH == 14) { for (int u = bidx(); u < SSD_UNITS; u += gridDim.x) { __syncthreads(); ssd_pass1_unit(p, L, u); } }
        if (PROBE_PH == 15) { for (int u = bidx(); u < RW_UNITS_PREP; u += gridDim.x) { __syncthreads(); rwkv_prep_unit(p, L, u); } }
        if (PROBE_PH == 16) { for (int u = bidx(); u < SSD_UNITS; u += gridDim.x) { __syncthreads(); ssd_pass3_unit(p, L, u); } }
        if (PROBE_PH == 17) { for (int u = bidx(); u < RW_UNITS / 2; u += gridDim.x) { __syncthreads(); rwkv_passC_unit(p, L, u); } }
        if (PROBE_PH == 18) { ph_mla_prep_rows(p, 0, NTOK, bidx() * 8 + wave_id(), gridDim.x * 8); }
        if (PROBE_PH == 19) { ssd_scan_range(p, bidx() * NTHREADS + tidx(), gridDim.x * NTHREADS); }
        if (PROBE_PH == 20) { for (int u = bidx(); u < RW_UNITS; u += gridDim.x) { __syncthreads(); rwkv_ut_unit(p, u); } } }
#endif
}

extern "C" void kernel_launch(void* const* d_in, const int* in_sizes, int n_in, void* d_out, int out_size, void* d_ws, size_t ws_size, hipStream_t stream) {
    static int grid = 0;
    if (grid == 0) {
        if (n_in != 39 || in_sizes[0] != NLAT * DM || out_size != NLAT * DM || ws_size < WS_END) {
            fprintf(stderr, "kernel_launch: shape mismatch: n_in %d in0 %d out %d ws %zu (need %zu)\n", n_in, n_in > 0 ? in_sizes[0] : -1, out_size, ws_size, (size_t)WS_END); grid = -1; return; }
        int dev = 0, cus = 0, per_cu = 0;
        if (hipGetDevice(&dev) != hipSuccess || hipDeviceGetAttribute(&cus, hipDeviceAttributeMultiprocessorCount, dev) != hipSuccess) { fprintf(stderr, "kernel_launch: device query failed\n"); grid = -1; return; }
        if (hipFuncSetAttribute((const void*)mega, hipFuncAttributeMaxDynamicSharedMemorySize, LDS_BYTES) != hipSuccess) { fprintf(stderr, "kernel_launch: hipFuncSetAttribute failed\n"); grid = -1; return; }
        if (hipOccupancyMaxActiveBlocksPerMultiprocessor(&per_cu, (const void*)mega, NTHREADS, LDS_BYTES) != hipSuccess || per_cu < 1)
            fprintf(stderr, "kernel_launch: occupancy query reports %d workgroups per CU\n", per_cu);
        (void)hipGetLastError();
        grid = cus;
    }
    if (grid < 0) return;
    if (hipMemsetAsync((char*)d_ws + WS_BAR, 0, 32768, stream) != hipSuccess) { fprintf(stderr, "kernel_launch: memset failed\n"); return; }
    Params p{};
    { const float** pp = (const float**)&p; for (int i = 0; i < 39; ++i) pp[i] = (const float*)d_in[i]; }
    p.out = (float*)d_out; p.ws = (unsigned char*)d_ws;
#if MK_MULTI
    for (int k = 0; k < PH_TOTAL; ++k) {
        p.ph_lo = k; p.ph_hi = k + 1;
        hipLaunchKernelGGL(mega, dim3(grid), dim3(NTHREADS), LDS_BYTES, stream, p);
    }
#else
    p.ph_lo = 0; p.ph_hi = PH_TOTAL;
    hipLaunchKernelGGL(mega, dim3(grid), dim3(NTHREADS), LDS_BYTES, stream, p);
#endif
    const hipError_t le = hipPeekAtLastError();
    if (le != hipSuccess) fprintf(stderr, "kernel_launch: launch failed: %s\n", hipGetErrorName(le));
}
```
